# Optimizing an MI355X kernel written in HIP

```python
import math
import jax, jax.numpy as jnp
from jax import lax
import numpy as np

D_MODEL = 1024
BATCH = 16
SEQ = 256
DEPTH = 2
DEC_BATCH = 2
DEC_SEQ = 4096
PAST_LEN = 256

GRID_W = 64
Q_BLOCK = 128
D_MIX = D_MODEL
DIFF_HEADS = 4
DIFF_HEAD_DIM = 32
DIFF_V_DIM = 2 * DIFF_HEAD_DIM
DIFF_W = DIFF_HEADS * DIFF_V_DIM
S5_CH = 16
S5_W = D_MIX // 4
S5_GROUPS = S5_W // S5_CH
S5_STATE = 64
MLA_HEADS = 8
MLA_NOPE = 64
MLA_ROPE = 32
MLA_V = 64
MLA_Q_RANK = D_MODEL // 4
MLA_KV_RANK = D_MODEL // 8
MLA_W = MLA_HEADS * MLA_V
FFN_HIDDEN = ((8 * D_MODEL + 3 * 256 - 1) // (3 * 256)) * 256
IN_SIZES = (DIFF_HEADS * 2 * DIFF_HEAD_DIM, DIFF_HEADS * 2 * DIFF_HEAD_DIM, DIFF_W,
            S5_W, MLA_Q_RANK, MLA_KV_RANK, MLA_ROPE)
IN_W = sum(IN_SIZES)
IN_OFFSETS = tuple(sum(IN_SIZES[:i + 1]) for i in range(len(IN_SIZES) - 1))
ALPHA = (2 * DEPTH) ** 0.25
BETA = (8 * DEPTH) ** -0.25
LN_EPS = 1e-5
RMS_EPS = 1e-6
ROPE_BASE = 10000.0

kernel_name = "hybrid_diff_s5_mla_prefix_dit_step"

F32 = jnp.float32


def layer_norm(x, g, b):
    xf = x.astype(F32)
    mu = jnp.mean(xf, -1, keepdims=True)
    var = jnp.mean(jnp.square(xf - mu), -1, keepdims=True)
    return ((xf - mu) * lax.rsqrt(var + LN_EPS) * g.astype(F32) + b.astype(F32)).astype(x.dtype)


def rms_norm(x, g):
    xf = x.astype(F32)
    y = xf * lax.rsqrt(jnp.mean(xf * xf, -1, keepdims=True) + RMS_EPS) * g.astype(F32)
    return y.astype(x.dtype)


def grid_rope_tables(length, dim):
    rows = length // GRID_W
    row = jnp.repeat(jnp.arange(rows, dtype=F32), GRID_W)
    col = jnp.tile(jnp.arange(GRID_W, dtype=F32), rows)
    n_freq = dim // 4
    inv = ROPE_BASE ** (-jnp.arange(n_freq, dtype=F32) / n_freq)
    ang = jnp.concatenate([row[:, None] * inv, col[:, None] * inv], -1)
    return jnp.cos(ang), jnp.sin(ang)


def apply_rope(x, cos, sin):
    half = x.shape[-1] // 2
    xf = x.astype(F32)
    x1, x2 = xf[..., :half], xf[..., half:]
    shp = (1, cos.shape[0]) + (1,) * (x.ndim - 3) + (half,)
    cs, sn = cos.reshape(shp), sin.reshape(shp)
    return jnp.concatenate([x1 * cs - x2 * sn, x2 * cs + x1 * sn], -1).astype(x.dtype)


def over_query_blocks(fn, *qs):
    b, length = qs[0].shape[:2]
    nb = length // Q_BLOCK
    blocks = tuple(jnp.swapaxes(q.reshape((b, nb, Q_BLOCK) + q.shape[2:]), 0, 1) for q in qs)
    out = lax.map(lambda blk: fn(*blk), blocks)
    out = jnp.swapaxes(out, 0, 1)
    return out.reshape((b, length) + out.shape[3:])


def diff_attention(q, k, v, lam, norm_g, lam_init):
    scale = DIFF_HEAD_DIM ** -0.5

    def block(qb):
        s = jnp.einsum('bqhcd,bkhcd->bhcqk', qb, k).astype(F32) * scale
        p = jax.nn.softmax(s, axis=-1)
        a = p[:, :, 0] - lam * p[:, :, 1]
        return jnp.einsum('bhqk,bkhd->bqhd', a.astype(v.dtype), v)

    o = over_query_blocks(block, q)
    o = rms_norm(o, norm_g) * (1.0 - lam_init)
    return o.reshape(o.shape[0], o.shape[1], DIFF_W)


def mla_attention(q_nope, q_rope, k_nope, k_rope, v):
    scale = (MLA_NOPE + MLA_ROPE) ** -0.5

    def block(qn, qr):
        s = (jnp.einsum('bqhd,bkhd->bhqk', qn, k_nope)
             + jnp.einsum('bqhd,bkd->bhqk', qr, k_rope)).astype(F32) * scale
        p = jax.nn.softmax(s, axis=-1)
        return jnp.einsum('bhqk,bkhd->bqhd', p.astype(v.dtype), v)

    o = over_query_blocks(block, q_nope, q_rope)
    return o.reshape(o.shape[0], o.shape[1], MLA_W)


def s5_discretize(lam_re, lam_im, log_dt, b_re, b_im):
    lam_re, lam_im = lam_re.astype(F32), lam_im.astype(F32)
    b_re, b_im = b_re.astype(F32), b_im.astype(F32)
    dt = jnp.exp(log_dt.astype(F32))[:, None]
    mag = jnp.exp(lam_re * dt)
    ang = lam_im * dt
    a_re, a_im = mag * jnp.cos(ang), mag * jnp.sin(ang)
    den = lam_re * lam_re + lam_im * lam_im
    n_re, n_im = a_re - 1.0, a_im
    f_re = ((n_re * lam_re + n_im * lam_im) / den)[..., None]
    f_im = ((n_im * lam_re - n_re * lam_im) / den)[..., None]
    return a_re, a_im, f_re * b_re - f_im * b_im, f_re * b_im + f_im * b_re


def _complex_affine_combine(e1, e2):
    a1r, a1i, b1r, b1i = e1
    a2r, a2i, b2r, b2i = e2
    return (a2r * a1r - a2i * a1i, a2r * a1i + a2i * a1r,
            a2r * b1r - a2i * b1i + b2r, a2r * b1i + a2i * b1r + b2i)


def diag_scan(a_re, a_im, bu_re, bu_im, h0):
    if h0 is not None:
        h0_re, h0_im = h0
        bu_re = bu_re.at[:, 0].add(a_re * h0_re - a_im * h0_im)
        bu_im = bu_im.at[:, 0].add(a_re * h0_im + a_im * h0_re)
    ar = jnp.broadcast_to(a_re, bu_re.shape)
    ai = jnp.broadcast_to(a_im, bu_im.shape)
    _, _, h_re, h_im = lax.associative_scan(_complex_affine_combine, (ar, ai, bu_re, bu_im), axis=1)
    return h_re, h_im


def s5_mixer(u, lam_re, lam_im, log_dt, b_re, b_im, c_re, c_im, d_skip, w_glu, h0):
    bsz, length = u.shape[:2]
    uf = u.astype(F32).reshape(bsz, length, S5_GROUPS, S5_CH)
    y = uf * d_skip.astype(F32)
    finals = []
    for d in range(2):
        ar, ai, bbr, bbi = s5_discretize(lam_re[d], lam_im[d], log_dt[d], b_re[d], b_im[d])
        bu_re = jnp.einsum('blgh,gph->blgp', uf, bbr)
        bu_im = jnp.einsum('blgh,gph->blgp', uf, bbi)
        if d == 1:
            bu_re, bu_im = bu_re[:, ::-1], bu_im[:, ::-1]
        init = None if h0 is None else (h0[:, d, :, :, 0].astype(F32), h0[:, d, :, :, 1].astype(F32))
        h_re, h_im = diag_scan(ar, ai, bu_re, bu_im, init)
        if h0 is None:
            finals.append(jnp.stack([h_re[:, -1], h_im[:, -1]], -1))
        if d == 1:
            h_re, h_im = h_re[:, ::-1], h_im[:, ::-1]
        y = y + (jnp.einsum('gnp,blgp->blgn', c_re[d].astype(F32), h_re)
                 - jnp.einsum('gnp,blgp->blgn', c_im[d].astype(F32), h_im))
    y = jax.nn.gelu(y.reshape(bsz, length, S5_W))
    y = y * jax.nn.sigmoid(y @ w_glu.astype(F32))
    final = jnp.stack(finals, 1).astype(u.dtype) if h0 is None else None
    return y.astype(u.dtype), final


def token_mixer(h, lw, lam, lam_init, ctx):
    bsz, length, _ = h.shape
    z = h @ lw['w_in']
    dq, dk, dv, u, q_lat, kv_lat, k_rope = jnp.split(z, list(IN_OFFSETS), axis=-1)
    dq = dq.reshape(bsz, length, DIFF_HEADS, 2, DIFF_HEAD_DIM)
    dk = dk.reshape(bsz, length, DIFF_HEADS, 2, DIFF_HEAD_DIM)
    dv = dv.reshape(bsz, length, DIFF_HEADS, DIFF_V_DIM)
    ckv = rms_norm(kv_lat, lw['mla_kv_norm_g'])
    q = (rms_norm(q_lat, lw['mla_q_norm_g']) @ lw['mla_w_uq']).reshape(
        bsz, length, MLA_HEADS, MLA_NOPE + MLA_ROPE)
    q_nope, q_rope = q[..., :MLA_NOPE], q[..., MLA_NOPE:]
    if ctx is None:
        dk_all, dv_all, ckv_all, kr_all, h0 = dk, dv, ckv, k_rope, None
    else:
        c_k, c_v, c_ckv, c_kr, h0 = ctx
        cos_d, sin_d = grid_rope_tables(length, DIFF_HEAD_DIM)
        dq = apply_rope(dq, cos_d, sin_d)
        dk = apply_rope(dk, cos_d, sin_d)
        cos_m, sin_m = grid_rope_tables(length, MLA_ROPE)
        q_rope = apply_rope(q_rope, cos_m, sin_m)
        k_rope = apply_rope(k_rope, cos_m, sin_m)
        ctx_len = c_k.shape[1]
        dk_all = jnp.concatenate([dk, c_k.reshape(bsz, ctx_len, DIFF_HEADS, 2, DIFF_HEAD_DIM)], 1)
        dv_all = jnp.concatenate([dv, c_v], 1)
        ckv_all = jnp.concatenate([ckv, c_ckv], 1)
        kr_all = jnp.concatenate([k_rope, c_kr], 1)
    n_keys = ckv_all.shape[1]
    k_nope = (ckv_all @ lw['mla_w_uk']).reshape(bsz, n_keys, MLA_HEADS, MLA_NOPE)
    v_mla = (ckv_all @ lw['mla_w_uv']).reshape(bsz, n_keys, MLA_HEADS, MLA_V)

    diff_out = diff_attention(dq, dk_all, dv_all, lam, lw['diff_norm_g'], lam_init)
    s5_out, s5_final = s5_mixer(u, lw['s5_lam_re'], lw['s5_lam_im'], lw['s5_log_dt'],
                                lw['s5_b_re'], lw['s5_b_im'], lw['s5_c_re'], lw['s5_c_im'],
                                lw['s5_d'], lw['s5_w_glu'], h0)
    mla_out = mla_attention(q_nope, q_rope, k_nope, kr_all, v_mla)
    out = jnp.concatenate([diff_out, s5_out, mla_out], -1) @ lw['w_out']
    if ctx is None:
        new_ctx = (dk.reshape(bsz, length, DIFF_HEADS, 2 * DIFF_HEAD_DIM), dv, ckv, k_rope, s5_final)
        return out, new_ctx
    return out, None


def trunk_layer(x, cond, lw, layer_idx, ctx):
    mods = jax.nn.silu(cond) @ lw['w_ada'] + lw['b_ada']
    sh1, sc1, g1, sh2, sc2, g2 = jnp.split(mods[:, None, :], 6, axis=-1)
    lam_init = 0.8 - 0.6 * math.exp(-0.3 * layer_idx)
    lam = (jnp.exp(jnp.sum(lw['diff_lq1'].astype(F32) * lw['diff_lk1'].astype(F32)))
           - jnp.exp(jnp.sum(lw['diff_lq2'].astype(F32) * lw['diff_lk2'].astype(F32))) + lam_init)
    h = x * (1 + sc1) + sh1
    mix, new_ctx = token_mixer(h, lw, lam, lam_init, ctx)
    x = layer_norm(ALPHA * x + g1 * mix, lw['ln1_g'], lw['ln1_b'])
    h = x * (1 + sc2) + sh2
    f = (jax.nn.silu(h @ lw['ffn_w_gate']) * (h @ lw['ffn_w_up'])) @ lw['ffn_w_down']
    x = layer_norm(ALPHA * x + g2 * f, lw['ln2_g'], lw['ln2_b'])
    return x, new_ctx


def setup_inputs(seed: int = 0) -> dict:
    key = jax.random.key(seed)
    ks = iter(jax.random.split(key, 48))

    def nrm(shape, s=1.0):
        return jax.random.normal(next(ks), shape, F32) * s

    G, P = S5_GROUPS, S5_STATE
    lam_im_base = jnp.pi * jnp.arange(P, dtype=F32)
    return {
        'x_prompt': nrm((BATCH, SEQ, D_MODEL)),
        'x_sample': nrm((DEC_BATCH, DEC_SEQ, D_MODEL)),
        'c': nrm((DEC_BATCH, D_MODEL)),
        'cache_diff_k': nrm((DEC_BATCH, DEPTH, PAST_LEN, DIFF_HEADS, 2 * DIFF_HEAD_DIM)),
        'cache_diff_v': nrm((DEC_BATCH, DEPTH, PAST_LEN, DIFF_HEADS, DIFF_V_DIM)),
        'cache_mla_ckv': nrm((DEC_BATCH, DEPTH, PAST_LEN, MLA_KV_RANK)),
        'cache_mla_krope': nrm((DEC_BATCH, DEPTH, PAST_LEN, MLA_ROPE)),
        'state_s5': nrm((DEC_BATCH, DEPTH, 2, G, P, 2), 0.1),
        'c_ctx': nrm((D_MODEL,)),
        'w_ada': nrm((DEPTH, D_MODEL, 6 * D_MODEL), 0.5 * D_MODEL ** -0.5),
        'b_ada': nrm((DEPTH, 6 * D_MODEL), 0.02),
        'w_in': nrm((DEPTH, D_MODEL, IN_W), D_MODEL ** -0.5),
        'w_out': nrm((DEPTH, D_MIX, D_MODEL), BETA * D_MIX ** -0.5),
        'diff_lq1': nrm((DEPTH, DIFF_HEAD_DIM), 0.1),
        'diff_lk1': nrm((DEPTH, DIFF_HEAD_DIM), 0.1),
        'diff_lq2': nrm((DEPTH, DIFF_HEAD_DIM), 0.1),
        'diff_lk2': nrm((DEPTH, DIFF_HEAD_DIM), 0.1),
        'diff_norm_g': 1.0 + nrm((DEPTH, DIFF_V_DIM), 0.02),
        's5_lam_re': -0.5 + nrm((DEPTH, 2, G, P), 0.01),
        's5_lam_im': lam_im_base + nrm((DEPTH, 2, G, P), 0.01),
        's5_log_dt': jax.random.uniform(next(ks), (DEPTH, 2, G), F32, math.log(1e-3), math.log(1e-1)),
        's5_b_re': nrm((DEPTH, 2, G, P, S5_CH), (2 * S5_CH) ** -0.5),
        's5_b_im': nrm((DEPTH, 2, G, P, S5_CH), (2 * S5_CH) ** -0.5),
        's5_c_re': nrm((DEPTH, 2, G, S5_CH, P), S5_STATE ** -0.5),
        's5_c_im': nrm((DEPTH, 2, G, S5_CH, P), S5_STATE ** -0.5),
        's5_d': nrm((DEPTH, G, S5_CH)),
        's5_w_glu': nrm((DEPTH, S5_W, S5_W), S5_W ** -0.5),
        'mla_q_norm_g': 1.0 + nrm((DEPTH, MLA_Q_RANK), 0.02),
        'mla_w_uq': nrm((DEPTH, MLA_Q_RANK, MLA_HEADS * (MLA_NOPE + MLA_ROPE)), MLA_Q_RANK ** -0.5),
        'mla_kv_norm_g': 1.0 + nrm((DEPTH, MLA_KV_RANK), 0.02),
        'mla_w_uk': nrm((DEPTH, MLA_KV_RANK, MLA_HEADS * MLA_NOPE), MLA_KV_RANK ** -0.5),
        'mla_w_uv': nrm((DEPTH, MLA_KV_RANK, MLA_HEADS * MLA_V), MLA_KV_RANK ** -0.5),
        'ln1_g': 1.0 + nrm((DEPTH, D_MODEL), 0.02),
        'ln1_b': nrm((DEPTH, D_MODEL), 0.02),
        'ln2_g': 1.0 + nrm((DEPTH, D_MODEL), 0.02),
        'ln2_b': nrm((DEPTH, D_MODEL), 0.02),
        'ffn_w_gate': nrm((DEPTH, D_MODEL, FFN_HIDDEN), D_MODEL ** -0.5),
        'ffn_w_up': nrm((DEPTH, D_MODEL, FFN_HIDDEN), D_MODEL ** -0.5),
        'ffn_w_down': nrm((DEPTH, FFN_HIDDEN, D_MODEL), BETA * FFN_HIDDEN ** -0.5),
    }


def reference(x_prompt, x_sample, c, cache_diff_k, cache_diff_v, cache_mla_ckv, cache_mla_krope,
              state_s5, c_ctx, w_ada, b_ada, w_in, w_out, diff_lq1, diff_lk1, diff_lq2, diff_lk2,
              diff_norm_g, s5_lam_re, s5_lam_im, s5_log_dt, s5_b_re, s5_b_im, s5_c_re, s5_c_im,
              s5_d, s5_w_glu, mla_q_norm_g, mla_w_uq, mla_kv_norm_g, mla_w_uk, mla_w_uv,
              ln1_g, ln1_b, ln2_g, ln2_b, ffn_w_gate, ffn_w_up, ffn_w_down):
    stacked = {
        'w_ada': w_ada, 'b_ada': b_ada, 'w_in': w_in, 'w_out': w_out,
        'diff_lq1': diff_lq1, 'diff_lk1': diff_lk1, 'diff_lq2': diff_lq2, 'diff_lk2': diff_lk2,
        'diff_norm_g': diff_norm_g,
        's5_lam_re': s5_lam_re, 's5_lam_im': s5_lam_im, 's5_log_dt': s5_log_dt,
        's5_b_re': s5_b_re, 's5_b_im': s5_b_im, 's5_c_re': s5_c_re, 's5_c_im': s5_c_im,
        's5_d': s5_d, 's5_w_glu': s5_w_glu,
        'mla_q_norm_g': mla_q_norm_g, 'mla_w_uq': mla_w_uq, 'mla_kv_norm_g': mla_kv_norm_g,
        'mla_w_uk': mla_w_uk, 'mla_w_uv': mla_w_uv,
        'ln1_g': ln1_g, 'ln1_b': ln1_b, 'ln2_g': ln2_g, 'ln2_b': ln2_b,
        'ffn_w_gate': ffn_w_gate, 'ffn_w_up': ffn_w_up, 'ffn_w_down': ffn_w_down,
    }
    cond_ctx = jnp.broadcast_to(c_ctx, (x_prompt.shape[0], D_MODEL))
    y_prompt = x_prompt
    ks, vs, ckvs, krs, sts = [], [], [], [], []
    for l in range(DEPTH):
        lw = {name: arr[l] for name, arr in stacked.items()}
        y_prompt, (k_l, v_l, ckv_l, kr_l, st_l) = trunk_layer(y_prompt, cond_ctx, lw, l, None)
        ks.append(k_l); vs.append(v_l); ckvs.append(ckv_l); krs.append(kr_l); sts.append(st_l)
    y_sample = x_sample
    for l in range(DEPTH):
        lw = {name: arr[l] for name, arr in stacked.items()}
        ctx = (cache_diff_k[:, l], cache_diff_v[:, l], cache_mla_ckv[:, l], cache_mla_krope[:, l],
               state_s5[:, l])
        y_sample, _ = trunk_layer(y_sample, c, lw, l, ctx)
    new_diff_k = jnp.stack(ks, 1)
    new_diff_v = jnp.stack(vs, 1)
    new_mla_ckv = jnp.stack(ckvs, 1)
    new_mla_krope = jnp.stack(krs, 1)
    new_s5_state = jnp.stack(sts, 1)
    return (y_prompt, y_sample, new_diff_k, new_diff_v, new_mla_ckv, new_mla_krope, new_s5_state)
```

```cpp
#include <hip/hip_runtime.h>
#include <hip/hip_cooperative_groups.h>
#include <cstdio>
namespace cg = cooperative_groups;

#ifndef REP_K
#define REP_K -1
#endif
#ifndef REP_SUB
#define REP_SUB 0
#endif

typedef unsigned short u16;
typedef __bf16 bf2_t __attribute__((ext_vector_type(2)));
typedef float f2_t __attribute__((ext_vector_type(2)));
using bf16x8 = __attribute__((ext_vector_type(8))) short;
using f32x16 = __attribute__((ext_vector_type(16))) float;
using f32x4 = __attribute__((ext_vector_type(4))) float;
#define DI __device__ __forceinline__

DI unsigned pk2(float a, float b) { f2_t v = {a, b}; return __builtin_bit_cast(unsigned, __builtin_convertvector(v, bf2_t)); }
DI u16 f2bf(float a) { return (u16)(pk2(a, 0.f) & 0xffffu); }
DI float bf2f(u16 v) { return __uint_as_float(((unsigned)v) << 16); }
#define MFMA32(a, b, c) __builtin_amdgcn_mfma_f32_32x32x16_bf16((a), (b), (c), 0, 0, 0)
#define MFMA16(a, b, c) __builtin_amdgcn_mfma_f32_16x16x32_bf16((a), (b), (c), 0, 0, 0)

constexpr int TC = 4096, TD = 8192, TA = 12288, KA = 12800;
constexpr int NPH = 22;
constexpr int LDS_BYTES = 147456 + 16;
constexpr int NT = 512;
constexpr float ALPHA = 1.41421356237309515f;
constexpr float LOG2E = 1.44269504088896341f;
constexpr float QS_D = 0.17677669529663689f * LOG2E;
constexpr float QS_M = 0.10206207261596575f * LOG2E;
constexpr size_t O_DK = 12582912, O_DV = 14680064, O_CKV = 16777216, O_KR = 17825792, O_S5 = 18087936;

constexpr size_t al256(size_t x) { return (x + 255) & ~(size_t)255; }
constexpr size_t OFF_bar = 0;
constexpr size_t OFF_Wt_in = OFF_bar + al256(16384);
constexpr size_t OFF_Wt_out = OFF_Wt_in + al256(2ull*1572864*2);
constexpr size_t OFF_Wt_uq = OFF_Wt_out + al256(2ull*1048576*2);
constexpr size_t OFF_Wt_ukv = OFF_Wt_uq + al256(2ull*196608*2);
constexpr size_t OFF_Wt_glu = OFF_Wt_ukv + al256(2ull*262144*2);
constexpr size_t OFF_Wt_gu = OFF_Wt_glu + al256(2ull*65536*2);
constexpr size_t OFF_Wt_dn = OFF_Wt_gu + al256(2ull*5767168*2);
constexpr size_t OFF_mods = OFF_Wt_dn + al256(2ull*2883584*2);
constexpr size_t OFF_rope = OFF_mods + al256(2ull*3*6144*4);
constexpr size_t OFF_s5a = OFF_rope + al256(4096ull*16*8);
constexpr size_t OFF_s5bre = OFF_s5a + al256(4096ull*8);
constexpr size_t OFF_s5bim = OFF_s5bre + al256(4096ull*16*4);
constexpr size_t OFF_H = OFF_s5bim + al256(4096ull*16*4);
constexpr size_t OFF_CC = OFF_H + al256((size_t)TA*1024*2);
constexpr size_t OFF_Qd = OFF_CC + al256((size_t)TA*1024*2);
constexpr size_t OFF_Kd = OFF_Qd + al256((size_t)TA*256*2);
constexpr size_t OFF_VdT = OFF_Kd + al256((size_t)KA*256*2);
constexpr size_t OFF_QLN = OFF_VdT + al256((size_t)KA*256*2);
constexpr size_t OFF_CKV = OFF_QLN + al256((size_t)TA*256*2);
constexpr size_t OFF_KR = OFF_CKV + al256((size_t)KA*256*2);
constexpr size_t OFF_YG = OFF_KR + al256((size_t)KA*32*2);
constexpr size_t OFF_U = OFF_YG + al256((size_t)TA*256*2);
constexpr size_t OFF_QL = OFF_U + al256((size_t)TA*256*4);
constexpr size_t OFF_KVL = OFF_QL + al256((size_t)TA*256*4);
constexpr size_t OFF_FIN = OFF_KVL + al256((size_t)TA*128*4);
constexpr size_t OFF_CIN = OFF_FIN + al256(384ull*2*16*64*8);
constexpr size_t OFF_XCH = OFF_CIN + al256(384ull*2*16*64*8);
constexpr size_t OFF_Qm = OFF_XCH + al256(4ull*48*256*4*8);
constexpr size_t OFF_Km = OFF_Qm + al256((size_t)TA*768*2);
constexpr size_t OFF_VmT = OFF_Km + al256((size_t)KA*512*2);
constexpr size_t OFF_ODIFF = OFF_VmT + al256((size_t)KA*512*2);
constexpr size_t WS_END = OFF_ODIFF + al256((size_t)TA*512*4);
constexpr size_t OFF_ACT = OFF_Qm;
static_assert(OFF_ACT + (size_t)TA * 2816 * 2 <= WS_END, "ACT alias region too small");
static_assert(WS_END <= 268435456ull, "workspace exceeds 256 MiB");

struct Params {
  const float *x_prompt, *x_sample, *c, *cache_k, *cache_v, *cache_ckv, *cache_kr, *state_s5, *c_ctx;
  const float *w_ada, *b_ada, *w_in, *w_out, *lq1, *lk1, *lq2, *lk2, *diff_g;
  const float *s5_lre, *s5_lim, *s5_ldt, *s5_bre, *s5_bim, *s5_cre, *s5_cim, *s5_d, *w_glu;
  const float *q_g, *w_uq, *kv_g, *w_uk, *w_uv, *ln1g, *ln1b, *ln2g, *ln2b, *w_gate, *w_up, *w_down;
  float* out;
  char* ws;
  DI unsigned* bar() const { return (unsigned*)(ws + OFF_bar); }
  DI u16* Wt_in() const { return (u16*)(ws + OFF_Wt_in); }
  DI u16* Wt_out() const { return (u16*)(ws + OFF_Wt_out); }
  DI u16* Wt_uq() const { return (u16*)(ws + OFF_Wt_uq); }
  DI u16* Wt_ukv() const { return (u16*)(ws + OFF_Wt_ukv); }
  DI u16* Wt_glu() const { return (u16*)(ws + OFF_Wt_glu); }
  DI u16* Wt_gu() const { return (u16*)(ws + OFF_Wt_gu); }
  DI u16* Wt_dn() const { return (u16*)(ws + OFF_Wt_dn); }
  DI float* mods() const { return (float*)(ws + OFF_mods); }
  DI float2* rope() const { return (float2*)(ws + OFF_rope); }
  DI float2* s5a() const { return (float2*)(ws + OFF_s5a); }
  DI float* s5bre() const { return (float*)(ws + OFF_s5bre); }
  DI float* s5bim() const { return (float*)(ws + OFF_s5bim); }
  DI u16* H() const { return (u16*)(ws + OFF_H); }
  DI u16* CC() const { return (u16*)(ws + OFF_CC); }
  DI u16* Qd() const { return (u16*)(ws + OFF_Qd); }
  DI u16* Kd() const { return (u16*)(ws + OFF_Kd); }
  DI u16* VdT() const { return (u16*)(ws + OFF_VdT); }
  DI u16* QLN() const { return (u16*)(ws + OFF_QLN); }
  DI u16* CKV() const { return (u16*)(ws + OFF_CKV); }
  DI u16* KR() const { return (u16*)(ws + OFF_KR); }
  DI u16* YG() const { return (u16*)(ws + OFF_YG); }
  DI float* U() const { return (float*)(ws + OFF_U); }
  DI float* QL() const { return (float*)(ws + OFF_QL); }
  DI float* KVL() const { return (float*)(ws + OFF_KVL); }
  DI float2* FIN() const { return (float2*)(ws + OFF_FIN); }
  DI float2* CIN() const { return (float2*)(ws + OFF_CIN); }
  DI float2* XCH() const { return (float2*)(ws + OFF_XCH); }
  DI u16* Qm() const { return (u16*)(ws + OFF_Qm); }
  DI u16* Km() const { return (u16*)(ws + OFF_Km); }
  DI u16* VmT() const { return (u16*)(ws + OFF_VmT); }
  DI float* ODIFF() const { return (float*)(ws + OFF_ODIFF); }
  DI u16* ACT() const { return (u16*)(ws + OFF_ACT); }
};

DI int tidx() { int t = threadIdx.x; asm volatile("" : "+v"(t)); return t; }
DI int tok_cond(int t) { return t < TC ? 0 : 1 + ((t - TC) >> 12); }
DI int tok_pos(int t) { return t < TC ? (t & 255) : ((t - TC) & 4095); }
DI int tok_key(int t) { return t < TC ? t : TC + ((t - TC) >> 12) * 4352 + ((t - TC) & 4095); }
DI float wave_sum(float v) {
#pragma unroll
  for (int o = 32; o; o >>= 1) v += __shfl_xor(v, o);
  return v;
}
DI int crow(int reg, int h) { return (reg & 3) + 8 * (reg >> 2) + 4 * h; }
DI void lds_fence() { asm volatile("s_waitcnt lgkmcnt(0)" ::: "memory"); }
DI float sigmoidf(float x) { return 1.f / (1.f + __expf(-x)); }

DI void sincos_d(double x, float& s, float& c) {
  const double TWO_PI = 6.283185307179586476925;
  double k = rint(x / TWO_PI);
  double r = x - k * TWO_PI;
  double r2 = r * r, ss = 1.0, cc = 1.0;
#pragma unroll
  for (int n = 13; n >= 1; --n) {
    ss = 1.0 - r2 * (1.0 / (double)((2 * n) * (2 * n + 1))) * ss;
    cc = 1.0 - r2 * (1.0 / (double)((2 * n - 1) * (2 * n))) * cc;
  }
  s = (float)(r * ss); c = (float)cc;
}

#define LAS __attribute__((address_space(3)))
DI int lds_byte(int r, int c) { int st = (r >> 4) * 2 + (c >> 5), rr = r & 15, cc = c & 31, ob = rr * 64 + cc * 2; return st * 1024 + (ob ^ (((ob >> 9) & 1) << 5)); }
DI void stage_rc(int b, int& R, int& C) { int st = b / 1024, sb = b % 1024, swz = sb ^ (((sb >> 9) & 1) << 5); R = (st >> 1) * 16 + swz / 64; C = (st & 1) * 32 + (swz % 64) / 2; }
DI void tile_order(int L, int nM, int nN, int& pm, int& pn) {
  const int nwg = nM * nN; int wgid = L;
  { const int q = nwg / 8, r = nwg % 8, xcd = wgid % 8, off = wgid / 8; wgid = (xcd < r ? xcd * (q + 1) : r * (q + 1) + (xcd - r) * q) + off; }
  const int nig = 8 * nN, gid = wgid / nig, fm = gid * 8, gsz = min(nM - fm, 8);
  pm = fm + ((wgid % nig) % gsz); pn = (wgid % nig) / gsz;
}
template <int MT, class Epi>
DI void gemm256(const u16* A, const u16* Bt, int Kc, int brow, int bcol, char* smem, Epi epi, bool prestaged = false, bool has_next = false, int nbrow = 0, int nbcol = 0) {
  constexpr int HTB = 16384;
  const int K = Kc;
  LAS char* lds = (LAS char*)smem;
  const int tid = tidx(), wid = tid >> 6, lane = tid & 63, wr = wid >> 2, wc = wid & 3, fr = lane & 15, fq = lane >> 4;
  unsigned voff[2];
#pragma unroll
  for (int i = 0; i < 2; ++i) { int R, C; stage_rc(tid * 16 + i * 8192, R, C); voff[i] = (unsigned)(R * K + C) * 2u; }
  const unsigned ldsw = (unsigned)wid * 1024u;
  const int aoff = lds_byte(wr * (16 * MT) + fr, fq * 8), boff = lds_byte(wc * 32 + fr, fq * 8);
  const char* Ab = (const char*)(A + (size_t)brow * K);
  const char* Bb = (const char*)(Bt + (size_t)bcol * K);
  const size_t hstepA = (size_t)(32 * MT) * K * 2, hstepB = (size_t)128 * K * 2;
#define G_SA(b, h) (((b) * 2 + (h)) * HTB)
#define G_SB(b, h) ((4 + (b) * 2 + (h)) * HTB)
#define G_STAGE_(bufoff, gbase, hh, kt, hs) do { const char* _g = (gbase) + (hh) * (hs) + (size_t)(kt) * 128; _Pragma("unroll") for (int _i = 0; _i < 2; ++_i) \
    __builtin_amdgcn_global_load_lds((const unsigned*)(_g + voff[_i]), (LAS unsigned*)(lds + (bufoff) + ldsw + _i * 8192), 16, 0, 0); } while (0)
#define G_LDA(dst, b, h) do { _Pragma("unroll") for (int m = 0; m < MT; ++m) _Pragma("unroll") for (int k = 0; k < 2; ++k) dst[m][k] = *(const LAS bf16x8*)(lds + G_SA(b, h) + aoff + m * 2048 + k * 1024); } while (0)
#define G_LDB(dst, b, h) do { _Pragma("unroll") for (int n = 0; n < 2; ++n) _Pragma("unroll") for (int k = 0; k < 2; ++k) dst[n][k] = *(const LAS bf16x8*)(lds + G_SB(b, h) + boff + n * 2048 + k * 1024); } while (0)
#define G_MMA(ai, bj, At, Bq) do { __builtin_amdgcn_s_setprio(1); _Pragma("unroll") for (int m = 0; m < MT; ++m) _Pragma("unroll") for (int n = 0; n < 2; ++n) _Pragma("unroll") for (int k = 0; k < 2; ++k) \
    acc[ai][bj][m][n] = MFMA16(At[m][k], Bq[n][k], acc[ai][bj][m][n]); __builtin_amdgcn_s_setprio(0); } while (0)
#define WAIT_V(n) asm volatile("s_waitcnt vmcnt(" #n ")" ::: "memory")
#define WAIT_L(n) asm volatile("s_waitcnt lgkmcnt(" #n ")" ::: "memory")
#define BAR __builtin_amdgcn_s_barrier()
#define SCHED __builtin_amdgcn_sched_barrier(0)
  f32x4 acc[2][2][MT][2];
#pragma unroll
  for (int a = 0; a < 2; ++a)
#pragma unroll
    for (int b = 0; b < 2; ++b)
#pragma unroll
      for (int m = 0; m < MT; ++m)
#pragma unroll
        for (int n = 0; n < 2; ++n) acc[a][b][m][n] = f32x4{0.f, 0.f, 0.f, 0.f};
  bf16x8 At[MT][2], B0[2][2], B1[2][2];
  const int nt = K / 64;
  if (!prestaged) {
    G_STAGE_(G_SB(0, 0), Bb, 0, 0, hstepB); G_STAGE_(G_SA(0, 0), Ab, 0, 0, hstepA);
    G_STAGE_(G_SB(0, 1), Bb, 1, 0, hstepB); G_STAGE_(G_SA(0, 1), Ab, 1, 0, hstepA);
  }
  if (wr == 1) BAR;
  WAIT_V(4); BAR;
  G_STAGE_(G_SB(1, 0), Bb, 0, 1, hstepB); G_STAGE_(G_SA(1, 0), Ab, 0, 1, hstepA); G_STAGE_(G_SB(1, 1), Bb, 1, 1, hstepB);
  WAIT_V(6); BAR;
  for (int t = 0; t < nt - 2; t += 2) {
    G_LDB(B0, 0, 0); SCHED; G_LDA(At, 0, 0); G_STAGE_(G_SA(1, 1), Ab, 1, t + 1, hstepA);
    if (MT == 4) WAIT_L(8); else WAIT_L(4); BAR; WAIT_L(0); G_MMA(0, 0, At, B0); BAR; SCHED;
    G_LDB(B1, 0, 1); G_STAGE_(G_SB(0, 0), Bb, 0, t + 2, hstepB);
    BAR; WAIT_L(0); G_MMA(0, 1, At, B1); BAR;
    G_LDA(At, 0, 1); G_STAGE_(G_SA(0, 0), Ab, 0, t + 2, hstepA);
    BAR; WAIT_L(0); G_MMA(1, 0, At, B0); BAR; SCHED;
    G_STAGE_(G_SB(0, 1), Bb, 1, t + 2, hstepB);
    WAIT_V(6); BAR; G_MMA(1, 1, At, B1); BAR;
    G_LDB(B0, 1, 0); SCHED; G_LDA(At, 1, 0); G_STAGE_(G_SA(0, 1), Ab, 1, t + 2, hstepA);
    if (MT == 4) WAIT_L(8); else WAIT_L(4); BAR; WAIT_L(0); G_MMA(0, 0, At, B0); BAR; SCHED;
    G_LDB(B1, 1, 1); G_STAGE_(G_SB(1, 0), Bb, 0, t + 3, hstepB);
    BAR; WAIT_L(0); G_MMA(0, 1, At, B1); BAR;
    G_LDA(At, 1, 1); G_STAGE_(G_SA(1, 0), Ab, 0, t + 3, hstepA);
    BAR; WAIT_L(0); G_MMA(1, 0, At, B0); BAR; SCHED;
    G_STAGE_(G_SB(1, 1), Bb, 1, t + 3, hstepB);
    WAIT_V(6); BAR; G_MMA(1, 1, At, B1); BAR;
  }
  { G_LDB(B0, 0, 0); G_LDA(At, 0, 0); G_STAGE_(G_SA(1, 1), Ab, 1, nt - 1, hstepA);
    BAR; WAIT_L(0); G_MMA(0, 0, At, B0); BAR;
    G_LDB(B1, 0, 1); BAR; WAIT_L(0); G_MMA(0, 1, At, B1); BAR;
    G_LDA(At, 0, 1); WAIT_V(4); BAR; WAIT_L(0); G_MMA(1, 0, At, B0); G_MMA(1, 1, At, B1); BAR; }
  { G_LDB(B0, 1, 0); G_LDA(At, 1, 0); WAIT_V(2); BAR; WAIT_L(0); G_MMA(0, 0, At, B0); BAR;
    G_LDB(B1, 1, 1); WAIT_V(0); BAR; WAIT_L(0); G_MMA(0, 1, At, B1); BAR;
    G_LDA(At, 1, 1); BAR; WAIT_L(0); G_MMA(1, 0, At, B0); G_MMA(1, 1, At, B1); BAR; }
  if (wr == 0) BAR;
  if (has_next) {
    const char* Ab2 = (const char*)(A + (size_t)nbrow * K); const char* Bb2 = (const char*)(Bt + (size_t)nbcol * K);
    G_STAGE_(G_SB(0, 0), Bb2, 0, 0, hstepB); G_STAGE_(G_SA(0, 0), Ab2, 0, 0, hstepA);
    G_STAGE_(G_SB(0, 1), Bb2, 1, 0, hstepB); G_STAGE_(G_SA(0, 1), Ab2, 1, 0, hstepA);
  }
  epi(acc, brow + wr * (16 * MT), bcol + wc * 32, fr, fq);
}

DI void transpose_strip(const float* src, int N, int k0, int n0, u16* dst, int ldd, int mode, int rowoff, float* tl) {
  const int tid = tidx(), c = tid & 63, r0 = tid >> 6;
  float v[4][8];
#pragma unroll
  for (int q = 0; q < 4; ++q)
#pragma unroll
    for (int i = 0; i < 8; ++i) {
      const int n = n0 + 64 * q + c;
      v[q][i] = (n < N) ? src[(size_t)(k0 + r0 + 8 * i) * N + n] : 0.f;
    }
#pragma unroll
  for (int q = 0; q < 4; ++q)
#pragma unroll
    for (int i = 0; i < 8; ++i) tl[q * 4160 + (r0 + 8 * i) * 65 + c] = v[q][i];
  __syncthreads();
  const int nl = tid >> 3, kq = tid & 7;
#pragma unroll
  for (int q = 0; q < 4; ++q) {
    const int n = n0 + 64 * q + nl;
    if (n < N) {
      int drow = (mode == 0) ? (n + rowoff) : ((n >> 4) * 32 + (n & 15) + (mode == 2 ? 16 : 0));
      unsigned pk[4];
#pragma unroll
      for (int j = 0; j < 4; ++j) pk[j] = pk2(tl[q * 4160 + (8 * kq + 2 * j) * 65 + nl], tl[q * 4160 + (8 * kq + 2 * j + 1) * 65 + nl]);
      *(uint4*)(dst + (size_t)drow * ldd + k0 + 8 * kq) = make_uint4(pk[0], pk[1], pk[2], pk[3]);
    }
  }
  __syncthreads();
}

constexpr int WJ_IN = 16 * 6, WJ_UQ = 4 * 3, WJ_UK = 2 * 2, WJ_UV = 2 * 2, WJ_GLU = 4 * 1, WJ_OUT = 16 * 4, WJ_G = 16 * 11, WJ_U = 16 * 11, WJ_D = 44 * 4;
constexpr int WJ_EARLY = WJ_IN + WJ_UQ + WJ_UK + WJ_UV + WJ_GLU, WJ_ALL = WJ_EARLY + WJ_OUT + WJ_G + WJ_U + WJ_D;
DI void weight_job(const Params& p, int l, int j, float* tl) {
  if (j < WJ_IN) { transpose_strip(p.w_in + (size_t)l * 1024 * 1440, 1440, (j % 16) * 64, (j / 16) * 256, p.Wt_in() + (size_t)l * 1572864, 1024, 0, 0, tl); return; }
  j -= WJ_IN;
  if (j < WJ_UQ) { transpose_strip(p.w_uq + (size_t)l * 196608, 768, (j % 4) * 64, (j / 4) * 256, p.Wt_uq() + (size_t)l * 196608, 256, 0, 0, tl); return; }
  j -= WJ_UQ;
  if (j < WJ_UK) { transpose_strip(p.w_uk + (size_t)l * 65536, 512, (j % 2) * 64, (j / 2) * 256, p.Wt_ukv() + (size_t)l * 262144, 256, 0, 0, tl); return; }
  j -= WJ_UK;
  if (j < WJ_UV) { transpose_strip(p.w_uv + (size_t)l * 65536, 512, (j % 2) * 64, (j / 2) * 256, p.Wt_ukv() + (size_t)l * 262144, 256, 0, 512, tl); return; }
  j -= WJ_UV;
  if (j < WJ_GLU) { transpose_strip(p.w_glu + (size_t)l * 65536, 256, (j % 4) * 64, (j / 4) * 256, p.Wt_glu() + (size_t)l * 65536, 256, 0, 0, tl); return; }
  j -= WJ_GLU;
  if (j < WJ_OUT) { transpose_strip(p.w_out + (size_t)l * 1048576, 1024, (j % 16) * 64, (j / 16) * 256, p.Wt_out() + (size_t)l * 1048576, 1024, 0, 0, tl); return; }
  j -= WJ_OUT;
  if (j < WJ_G) { transpose_strip(p.w_gate + (size_t)l * 2883584, 2816, (j % 16) * 64, (j / 16) * 256, p.Wt_gu() + (size_t)l * 5767168, 1024, 1, 0, tl); return; }
  j -= WJ_G;
  if (j < WJ_U) { transpose_strip(p.w_up + (size_t)l * 2883584, 2816, (j % 16) * 64, (j / 16) * 256, p.Wt_gu() + (size_t)l * 5767168, 1024, 2, 0, tl); return; }
  j -= WJ_U;
  transpose_strip(p.w_down + (size_t)l * 2883584, 1024, (j % 44) * 64, (j / 44) * 256, p.Wt_dn() + (size_t)l * 2883584, 2816, 0, 0, tl);
}
template <class F>
DI void idle_block_jobs(int n, int first_idle, F f) {
  const int G = gridDim.x, nidle = G - first_idle;
  if (nidle > 0) { if ((int)blockIdx.x >= first_idle) for (int e = blockIdx.x - first_idle; e < n; e += nidle) f(e); }
  else for (int e = blockIdx.x; e < n; e += G) f(e);
}

DI void phase_pre1(const Params& p, char* smem) {
  const int tid = tidx();
  float* tl = (float*)smem;
  constexpr int N_T = WJ_EARLY + WJ_OUT, N_MODS = 192, N_ROPE = 128, N_S5 = 8, N_ZP = 32;
  for (int it = blockIdx.x; it < N_T + N_MODS + N_ROPE + N_S5 + N_ZP; it += gridDim.x) {
    if (it >= N_T + N_MODS + N_ROPE + N_S5) {
      const int zj = it - (N_T + N_MODS + N_ROPE + N_S5);
#pragma unroll
      for (int i = 0; i < 2; ++i) { const int c = tid + NT * i, row = zj * 64 + (c >> 4), ch = c & 15; *(uint4*)(p.Wt_ukv() + (size_t)row * 256 + 128 + ch * 8) = make_uint4(0, 0, 0, 0); }
      continue;
    }
    if (it >= N_MODS && it < N_MODS + N_T) { weight_job(p, 0, it - N_MODS, tl); continue; }
    if (it < N_MODS) {
      const int j = it, l = j / 96, cg0 = (j % 96) * 64;
      float* sil = (float*)smem;
      float* red = sil + 3072;
      for (int i = tid; i < 3072; i += NT) {
        int ci = i >> 10, k = i & 1023;
        float cv = (ci == 0) ? p.c_ctx[k] : p.c[(ci - 1) * 1024 + k];
        sil[i] = cv * sigmoidf(cv);
      }
      __syncthreads();
      const int w = tid >> 6, lane = tid & 63, n = cg0 + lane;
      float a0 = 0.f, a1 = 0.f, a2 = 0.f;
      const float* wp = p.w_ada + (size_t)l * 1024 * 6144 + n;
#pragma unroll 32
      for (int k = w * 128; k < w * 128 + 128; ++k) {
        float wv = wp[(size_t)k * 6144];
        a0 += sil[k] * wv; a1 += sil[1024 + k] * wv; a2 += sil[2048 + k] * wv;
      }
      red[(w * 3 + 0) * 64 + lane] = a0; red[(w * 3 + 1) * 64 + lane] = a1; red[(w * 3 + 2) * 64 + lane] = a2;
      __syncthreads();
      if (tid < 192) {
        int ci = tid >> 6, ln = tid & 63;
        float sm = 0.f;
#pragma unroll
        for (int ww = 0; ww < 8; ++ww) sm += red[(ww * 3 + ci) * 64 + ln];
        p.mods()[(size_t)(l * 3 + ci) * 6144 + cg0 + ln] = sm + p.b_ada[l * 6144 + cg0 + ln];
      }
      __syncthreads();
      continue;
    }
    int j = it - N_MODS - N_T;
    if (j < N_ROPE) {
      int idx = j * NT + tid, pos = idx >> 4, i = idx & 15, f = i & 7;
      double v = 1.0;
      for (int q = 0; q < (f >> 1); ++q) v *= 0.1;
      if (f & 1) v *= 0.31622776601683794;
      float inv = (float)v;
      float ang = (float)((i < 8) ? (pos >> 6) : (pos & 63)) * inv;
      float sn, cs; sincos_d((double)ang, sn, cs);
      p.rope()[idx] = make_float2(cs, sn);
      continue;
    }
    j -= N_ROPE;
    {
      int e = j * NT + tid;
      float lre = p.s5_lre[e], lim = p.s5_lim[e], dt = expf(p.s5_ldt[e >> 6]);
      float mag = expf(lre * dt), ang = lim * dt, sn, cs;
      sincos_d((double)ang, sn, cs);
      float are = mag * cs, aim = mag * sn;
      float den = lre * lre + lim * lim, nre = are - 1.f, nim = aim;
      float fre = (nre * lre + nim * lim) / den, fim = (nim * lre - nre * lim) / den;
      p.s5a()[e] = make_float2(are, aim);
#pragma unroll
      for (int ch = 0; ch < 16; ++ch) {
        float br = p.s5_bre[(size_t)e * 16 + ch], bi = p.s5_bim[(size_t)e * 16 + ch];
        p.s5bre()[(size_t)e * 16 + ch] = fre * br - fim * bi;
        p.s5bim()[(size_t)e * 16 + ch] = fre * bi + fim * br;
      }
    }
  }
}

DI void store_h(const Params& p, int t, int lm, int scc, int shc, const float* v, int lane) {
  const float* mb = p.mods() + (size_t)(lm * 3 + tok_cond(t)) * 6144;
#pragma unroll
  for (int j = 0; j < 4; ++j) {
    int col = lane * 4 + 256 * j;
    float4 sc = *(const float4*)(mb + scc * 1024 + col), sh = *(const float4*)(mb + shc * 1024 + col);
    uint2 o;
    o.x = pk2(v[4 * j] * (1.f + sc.x) + sh.x, v[4 * j + 1] * (1.f + sc.y) + sh.y);
    o.y = pk2(v[4 * j + 2] * (1.f + sc.z) + sh.z, v[4 * j + 3] * (1.f + sc.w) + sh.w);
    *(uint2*)(p.H() + (size_t)t * 1024 + col) = o;
  }
}

DI void phase_pre2(const Params& p) {
  const int lane = tidx() & 63, w = tidx() >> 6;
  for (int it = blockIdx.x; it < TA / 8; it += gridDim.x) {
    int t = it * 8 + w;
    const float* xr = (t < TC) ? p.x_prompt + (size_t)t * 1024 : p.x_sample + (size_t)(t - TC) * 1024;
    float v[16];
#pragma unroll
    for (int j = 0; j < 4; ++j) { float4 x = *(const float4*)(xr + lane * 4 + 256 * j); v[4 * j] = x.x; v[4 * j + 1] = x.y; v[4 * j + 2] = x.z; v[4 * j + 3] = x.w; }
    store_h(p, t, 0, 1, 0, v, lane);
  }
}

DI void phase_ln(const Params& p, int l, int which) {
  const int lane = tidx() & 63, w = tidx() >> 6;
  const float* gp = (which == 1 ? p.ln1g : p.ln2g) + l * 1024;
  const float* bp = (which == 1 ? p.ln1b : p.ln2b) + l * 1024;
  for (int it = blockIdx.x; it < TA / 8; it += gridDim.x) {
    int t = it * 8 + w;
    float* xr = p.out + (size_t)t * 1024;
    float v[16]; float s = 0.f;
#pragma unroll
    for (int j = 0; j < 4; ++j) { float4 x = *(const float4*)(xr + lane * 4 + 256 * j); v[4 * j] = x.x; v[4 * j + 1] = x.y; v[4 * j + 2] = x.z; v[4 * j + 3] = x.w; s += x.x + x.y + x.z + x.w; }
    float mean = wave_sum(s) * (1.f / 1024.f);
    float q = 0.f;
#pragma unroll
    for (int i = 0; i < 16; ++i) { float d = v[i] - mean; q += d * d; }
    float rs = rsqrtf(wave_sum(q) * (1.f / 1024.f) + 1e-5f);
#pragma unroll
    for (int j = 0; j < 4; ++j) {
      int col = lane * 4 + 256 * j;
      float4 g = *(const float4*)(gp + col), b = *(const float4*)(bp + col);
      v[4 * j] = (v[4 * j] - mean) * rs * g.x + b.x; v[4 * j + 1] = (v[4 * j + 1] - mean) * rs * g.y + b.y;
      v[4 * j + 2] = (v[4 * j + 2] - mean) * rs * g.z + b.z; v[4 * j + 3] = (v[4 * j + 3] - mean) * rs * g.w + b.w;
      *(float4*)(xr + col) = make_float4(v[4 * j], v[4 * j + 1], v[4 * j + 2], v[4 * j + 3]);
    }
    if (which == 1) store_h(p, t, l, 4, 3, v, lane);
    else if (l + 1 < 2) store_h(p, t, l + 1, 1, 0, v, lane);
  }
}

typedef f32x4 Acc256[2][2][4][2];
typedef f32x4 Acc128[2][2][2][2];

#define XB_TMO      128
#define XB_XCNT(j)  (256  + 64 * (j))
#define XB_XSUB(j)  (1280 + 64 * (j))
#define XB_XGEN(j)  (2304 + 64 * (j))
#define XB_TOP      3328
#define XB_TOPGEN   3392
#define XCD_BAR_WORDS 3456
#define XB_SPIN_CAP (1u << 18)
DI unsigned xb_ld(unsigned* p) { return __hip_atomic_load(p, __ATOMIC_RELAXED, __HIP_MEMORY_SCOPE_AGENT); }
DI unsigned xb_add(unsigned* p, unsigned v) { return __hip_atomic_fetch_add(p, v, __ATOMIC_RELAXED, __HIP_MEMORY_SCOPE_AGENT); }
DI unsigned xb_xcc_id() { return (unsigned)__builtin_amdgcn_s_getreg((3 << 11) | 20) & 0xFu; }
#define XB_SPIN(cond, bar) do { unsigned _sp = 0; while (cond) { __builtin_amdgcn_s_sleep(1); \
    if ((++_sp & 255u) == 0u) { if (xb_ld(&(bar)[XB_TMO])) break; if (_sp > XB_SPIN_CAP) { atomicAdd(&(bar)[XB_TMO], 1u); break; } } } } while (0)
struct XcdBarrier { unsigned* bar; unsigned x; volatile LAS unsigned* st; };
DI XcdBarrier xcd_barrier_post(unsigned* bar, volatile LAS unsigned* st) {
  XcdBarrier b; b.bar = bar; b.x = xb_xcc_id(); b.st = st;
  if (threadIdx.x == 0) (void)xb_add(&bar[XB_XCNT(b.x)], 1u);
  return b;
}
DI void xcd_barrier_complete(unsigned* bar, unsigned x, unsigned& nloc, unsigned& nx) {
  const unsigned G = gridDim.x * gridDim.y * gridDim.z;
  unsigned sum, cnt, mine, sp = 0u;
  for (;;) {
    sum = 0u; cnt = 0u; mine = 0u;
#pragma unroll
    for (unsigned j = 0; j < 16; ++j) { const unsigned c = xb_ld(&bar[XB_XCNT(j)]); sum += c; cnt += (c > 0u) ? 1u : 0u; mine = (j == x) ? c : mine; }
    if (sum == G) break;
    __builtin_amdgcn_s_sleep(1);
    if ((++sp & 255u) == 0u) { if (xb_ld(&bar[XB_TMO])) break; if (sp > XB_SPIN_CAP) { atomicAdd(&bar[XB_TMO], 1u); break; } }
  }
  nloc = mine > 0u ? mine : 1u; nx = cnt > 0u ? cnt : 1u;
}
DI void xcd_barrier(const XcdBarrier& b) {
  asm volatile("s_waitcnt vmcnt(0)" ::: "memory");
  __syncthreads();
  if (threadIdx.x == 0) {
    unsigned* bar = b.bar;
    __builtin_amdgcn_s_waitcnt(0);
    unsigned nloc = b.st[0], nx = b.st[1];
    if (nloc == 0u) { xcd_barrier_complete(bar, b.x, nloc, nx); b.st[0] = nloc; b.st[1] = nx; }
    const unsigned old = xb_add(&bar[XB_XSUB(b.x)], 1u);
    const unsigned gen = old / nloc;
    if (old + 1u == (gen + 1u) * nloc) {
      __builtin_amdgcn_fence(__ATOMIC_RELEASE, "agent");
      asm volatile("s_waitcnt vmcnt(0)" ::: "memory");
      const unsigned og = xb_add(&bar[XB_TOP], 1u);
      const unsigned tg = og / nx;
      if (og + 1u == (tg + 1u) * nx) xb_add(&bar[XB_TOPGEN], 1u);
      else XB_SPIN(xb_ld(&bar[XB_TOPGEN]) == tg, bar);
      __builtin_amdgcn_fence(__ATOMIC_ACQUIRE, "agent");
      xb_add(&bar[XB_XGEN(b.x)], 1u);
      asm volatile("s_waitcnt vmcnt(0)" ::: "memory");
    } else {
      XB_SPIN(xb_ld(&bar[XB_XGEN(b.x)]) == gen, bar);
      __builtin_amdgcn_fence(__ATOMIC_ACQUIRE, "agent");
      asm volatile("s_waitcnt vmcnt(0)" ::: "memory");
    }
  }
  __syncthreads();
}

DI void phase_a(const Params& p, int l, char* smem) {
  constexpr int NG = 48 * 5;
  bool pre = false;
  for (int it = blockIdx.x; it < NG + 256 + 200; it += gridDim.x) {
    if (it >= NG + 256) {
      const int zj = it - NG - 256, tid = tidx();
#pragma unroll
      for (int i = 0; i < 2; ++i) { const int c = tid + NT * i, row = zj * 64 + (c >> 4), ch = c & 15; *(uint4*)(p.CKV() + (size_t)row * 256 + 128 + ch * 8) = make_uint4(0, 0, 0, 0); }
      continue;
    }
    if (it < NG) {
      int pm, pn, npm = 0, npn = 0; tile_order(it, 48, 5, pm, pn);
      const bool hn = (it + (int)gridDim.x) < NG; if (hn) tile_order(it + gridDim.x, 48, 5, npm, npn);
      auto epi = [&](Acc256& acc, int r0, int c0, int fr, int fq) __attribute__((always_inline)) {
#pragma unroll
        for (int ai = 0; ai < 2; ++ai)
#pragma unroll
          for (int bj = 0; bj < 2; ++bj) {
            const int colbase = c0 + bj * 128;
            if (colbase >= 1440) continue;
            const int cb = colbase >> 5;
#pragma unroll
            for (int m = 0; m < 4; ++m) {
              const int rowb = r0 + ai * 128 + m * 16 + fq * 4;
              const bool ctx = rowb < TC;
              const f32x4 a0 = acc[ai][bj][m][0], a1 = acc[ai][bj][m][1];
              if (cb < 16 || cb == 44) {
#pragma unroll
                for (int j = 0; j < 4; ++j) {
                  const int row = rowb + j;
                  float v0 = a0[j], v1 = a1[j];
                  const float raw0 = v0, raw1 = v1;
                  if (!ctx) {
                    float2 cs = p.rope()[tok_pos(row) * 16 + fr];
                    float t0 = v0 * cs.x - v1 * cs.y, t1 = v1 * cs.x + v0 * cs.y;
                    v0 = t0; v1 = t1;
                  }
                  if (cb < 8) {
                    u16* q = p.Qd() + (size_t)row * 256 + colbase + fr;
                    q[0] = f2bf(v0 * QS_D); q[16] = f2bf(v1 * QS_D);
                  } else if (cb < 16) {
                    const int cc = colbase - 256 + fr;
                    if (ctx) { float* o = p.out + O_DK + ((size_t)((row >> 8) * 2 + l) * 256 + (row & 255)) * 256 + cc; o[0] = raw0; o[16] = raw1; }
                    u16* k = p.Kd() + (size_t)tok_key(row) * 256 + cc;
                    k[0] = f2bf(v0); k[16] = f2bf(v1);
                  } else {
                    if (ctx) { float* o = p.out + O_KR + ((size_t)((row >> 8) * 2 + l) * 256 + (row & 255)) * 32 + fr; o[0] = raw0; o[16] = raw1; }
                    u16* k = p.KR() + (size_t)tok_key(row) * 32 + fr;
                    k[0] = f2bf(v0); k[16] = f2bf(v1);
                  }
                }
              } else if (cb < 24) {
                const int cc = colbase - 512 + fr;
                if (ctx) {
#pragma unroll
                  for (int j = 0; j < 4; ++j) {
                    float* o = p.out + O_DV + ((size_t)(((rowb + j) >> 8) * 2 + l) * 256 + ((rowb + j) & 255)) * 256 + cc;
                    o[0] = a0[j]; o[16] = a1[j];
                  }
                }
                const size_t key = tok_key(rowb);
                *(uint2*)(p.VdT() + (size_t)cc * KA + key) = make_uint2(pk2(a0[0], a0[1]), pk2(a0[2], a0[3]));
                *(uint2*)(p.VdT() + (size_t)(cc + 16) * KA + key) = make_uint2(pk2(a1[0], a1[1]), pk2(a1[2], a1[3]));
              } else {
                float* dst; int ld, c2;
                if (cb < 32) { dst = p.U(); ld = 256; c2 = colbase - 768 + fr; }
                else if (cb < 40) { dst = p.QL(); ld = 256; c2 = colbase - 1024 + fr; }
                else { dst = p.KVL(); ld = 128; c2 = colbase - 1280 + fr; }
#pragma unroll
                for (int j = 0; j < 4; ++j) { float* o = dst + (size_t)(rowb + j) * ld + c2; o[0] = a0[j]; o[16] = a1[j]; }
              }
              SCHED;
            }
          }
      };
      gemm256<4>(p.H(), p.Wt_in() + (size_t)l * 1572864, 1024, pm * 256, pn * 256, smem, epi, pre, hn, npm * 256, npn * 256); pre = hn;
    } else {
      const int tid = tidx();
      const int ci = (it - NG) * 2 + (tid >> 8), t8 = tid & 255, b = ci >> 8, j = ci & 255;
      const size_t key = TC + b * 4352 + 4096 + j;
      const size_t src = (size_t)((b * 2 + l) * 256 + j);
      p.Kd()[key * 256 + t8] = f2bf(p.cache_k[src * 256 + t8]);
      p.VdT()[(size_t)t8 * KA + key] = f2bf(p.cache_v[src * 256 + t8]);
      if (t8 < 128) p.CKV()[key * 256 + t8] = f2bf(p.cache_ckv[src * 128 + t8]);
      if (t8 < 32) p.KR()[key * 32 + t8] = f2bf(p.cache_kr[src * 32 + t8]);
    }
  }
}

DI void s5_bu_to_lds(const Params& p, int e0, int tok0, int g, char* img, int lane) {
  const int n = lane & 15, q4 = lane >> 4;
  bf16x8 af[2];
#pragma unroll
  for (int mt = 0; mt < 2; ++mt) {
    uint4 z = make_uint4(0, 0, 0, 0);
    if (q4 < 2) {
      const float* up = p.U() + (size_t)(tok0 + 16 * mt + n) * 256 + g * 16 + 8 * q4;
      float4 x = *(const float4*)up, y = *(const float4*)(up + 4);
      z = make_uint4(pk2(x.x, x.y), pk2(x.z, x.w), pk2(y.x, y.y), pk2(y.z, y.w));
    }
    af[mt] = __builtin_bit_cast(bf16x8, z);
  }
#pragma unroll
  for (int nt = 0; nt < 8; ++nt) {
    uint4 z = make_uint4(0, 0, 0, 0);
    if (q4 < 2) {
      const float* bp = ((nt < 4) ? p.s5bre() : p.s5bim()) + (size_t)(e0 + 16 * (nt & 3) + n) * 16 + 8 * q4;
      float4 x = *(const float4*)bp, y = *(const float4*)(bp + 4);
      z = make_uint4(pk2(x.x, x.y), pk2(x.z, x.w), pk2(y.x, y.y), pk2(y.z, y.w));
    }
    const bf16x8 bfr = __builtin_bit_cast(bf16x8, z);
#pragma unroll
    for (int mt = 0; mt < 2; ++mt) {
      f32x4 d = {0.f, 0.f, 0.f, 0.f};
      d = MFMA16(af[mt], bfr, d);
#pragma unroll
      for (int reg = 0; reg < 4; ++reg) *(float*)(img + (16 * mt + 4 * q4 + reg) * 528 + (16 * nt + n) * 4) = d[reg];
    }
  }
}

DI void s5_pass1(const Params& p, int l, int witem, char* img) {
  const int lane = tidx() & 63;
  int d, g, c, nch, qbase, cbase;
  if (witem < 8192) { c = witem & 127; g = (witem >> 7) & 15; d = (witem >> 11) & 1; int b = witem >> 12; nch = 128; qbase = TC + b * 4096; cbase = 128 + b * 128; }
  else { int x = witem - 8192; c = x & 7; g = (x >> 3) & 15; d = (x >> 7) & 1; int b = x >> 8; nch = 8; qbase = b * 256; cbase = b * 8; }
  const int e0 = ((l * 2 + d) * 16 + g) * 64;
  const int tok0 = qbase + (d ? (nch - 1 - c) : c) * 32;
  s5_bu_to_lds(p, e0, tok0, g, img, lane);
  lds_fence();
  const float2 a = p.s5a()[e0 + lane];
  float hr = 0.f, hi = 0.f;
#pragma unroll 4
  for (int j = 0; j < 32; ++j) {
    const int row = d ? (31 - j) : j;
    const float bur = *(const float*)(img + row * 528 + lane * 4), bui = *(const float*)(img + row * 528 + 256 + lane * 4);
    float nr = a.x * hr - a.y * hi + bur, ni = a.x * hi + a.y * hr + bui;
    hr = nr; hi = ni;
  }
  p.FIN()[(size_t)(((cbase + c) * 2 + d) * 16 + g) * 64 + lane] = make_float2(hr, hi);
  lds_fence();
}

DI void s5_carry(const Params& p, int l, int witem) {
  const int lane = tidx() & 63;
  int g, d, b, nch, cbase; bool isctx;
  if (witem < 64) { g = witem & 15; d = (witem >> 4) & 1; b = witem >> 5; nch = 128; cbase = 128 + b * 128; isctx = false; }
  else { int x = witem - 64; g = x & 15; d = (x >> 4) & 1; b = x >> 5; nch = 8; cbase = b * 8; isctx = true; }
  const int e = ((l * 2 + d) * 16 + g) * 64 + lane;
  const float2 a = p.s5a()[e];
  float tr = a.x, ti = a.y;
#pragma unroll
  for (int s = 0; s < 5; ++s) { float nr = tr * tr - ti * ti, ni = 2.f * tr * ti; tr = nr; ti = ni; }
  float hr = 0.f, hi = 0.f;
  if (!isctx) { const float* s = p.state_s5 + ((size_t)(((b * 2 + l) * 2 + d) * 16 + g) * 64 + lane) * 2; hr = s[0]; hi = s[1]; }
  const size_t base = (size_t)((cbase * 2 + d) * 16 + g) * 64 + lane;
  if (isctx) {
    float2 f[8];
#pragma unroll
    for (int i = 0; i < 8; ++i) f[i] = p.FIN()[base + (size_t)i * 2048];
#pragma unroll
    for (int i = 0; i < 8; ++i) {
      p.CIN()[base + (size_t)i * 2048] = make_float2(hr, hi);
      float nr = tr * hr - ti * hi + f[i].x, ni = tr * hi + ti * hr + f[i].y;
      hr = nr; hi = ni;
    }
  } else {
    for (int c = 0; c < 128; c += 32) {
      float2 f[32];
#pragma unroll
      for (int i = 0; i < 32; ++i) f[i] = p.FIN()[base + (size_t)(c + i) * 2048];
#pragma unroll
      for (int i = 0; i < 32; ++i) {
        p.CIN()[base + (size_t)(c + i) * 2048] = make_float2(hr, hi);
        float nr = tr * hr - ti * hi + f[i].x, ni = tr * hi + ti * hr + f[i].y;
        hr = nr; hi = ni;
      }
    }
  }
  if (isctx) {
    float* o = p.out + O_S5 + ((size_t)(((b * 2 + l) * 2 + d) * 16 + g) * 64 + lane) * 2;
    o[0] = hr; o[1] = hi;
  }
}

DI float gelu_tanh(float x) {
  float z = 0.7978845608028654f * (x + 0.044715f * x * x * x);
  float t = 1.f - 2.f / (1.f + __expf(2.f * z));
  return 0.5f * x * (1.f + t);
}

DI void s5_pass3(const Params& p, int l, int witem, char* img) {
  const int lane = tidx() & 63;
  int tc, g, b, nch, qbase, cbase;
  if (witem < 4096) { tc = witem & 127; g = (witem >> 7) & 15; b = witem >> 11; nch = 128; qbase = TC + b * 4096; cbase = 128 + b * 128; }
  else { int x = witem - 4096; tc = x & 7; g = (x >> 3) & 15; b = x >> 7; nch = 8; qbase = b * 256; cbase = b * 8; }
  const int tok0 = qbase + tc * 32;
  f32x4 acc0 = {0.f, 0.f, 0.f, 0.f}, acc1 = {0.f, 0.f, 0.f, 0.f};
  const int n = lane & 15, q4 = lane >> 4;
#pragma unroll 1
  for (int d = 0; d < 2; ++d) {
    const int pc = d ? (nch - 1 - tc) : tc;
    const int e0 = ((l * 2 + d) * 16 + g) * 64;
    s5_bu_to_lds(p, e0, tok0, g, img, lane);
    lds_fence();
    const float2 a = p.s5a()[e0 + lane];
    const float2 h0 = p.CIN()[(size_t)(((cbase + pc) * 2 + d) * 16 + g) * 64 + lane];
    float hr = h0.x, hi = h0.y;
#pragma unroll 4
    for (int j = 0; j < 32; ++j) {
      const int row = d ? (31 - j) : j;
      const float bur = *(const float*)(img + row * 528 + lane * 4), bui = *(const float*)(img + row * 528 + 256 + lane * 4);
      float nr = a.x * hr - a.y * hi + bur, ni = a.x * hi + a.y * hr + bui;
      hr = nr; hi = ni;
      *(u16*)(img + row * 528 + lane * 2) = f2bf(hr);
      *(u16*)(img + row * 528 + 128 + lane * 2) = f2bf(hi);
    }
    lds_fence();
#pragma unroll
    for (int s = 0; s < 4; ++s) {
      const float* cp = ((s < 2) ? p.s5_cre : p.s5_cim) + ((size_t)(((l * 2 + d) * 16 + g) * 16 + n)) * 64 + 32 * (s & 1) + 8 * q4;
      float4 c0 = *(const float4*)cp, c1 = *(const float4*)(cp + 4);
      const float sg = (s < 2) ? 1.f : -1.f;
      bf16x8 bfrag = __builtin_bit_cast(bf16x8, make_uint4(pk2(sg * c0.x, sg * c0.y), pk2(sg * c0.z, sg * c0.w), pk2(sg * c1.x, sg * c1.y), pk2(sg * c1.z, sg * c1.w)));
      bf16x8 a0 = *(const bf16x8*)(img + (n) * 528 + (32 * s + 8 * q4) * 2);
      bf16x8 a1 = *(const bf16x8*)(img + (16 + n) * 528 + (32 * s + 8 * q4) * 2);
      acc0 = MFMA16(a0, bfrag, acc0);
      acc1 = MFMA16(a1, bfrag, acc1);
    }
    lds_fence();
  }
  const float dsk = p.s5_d[(l * 16 + g) * 16 + n];
#pragma unroll
  for (int reg = 0; reg < 4; ++reg) {
    const int row0 = 4 * q4 + reg, row1 = 16 + 4 * q4 + reg;
    const float u0 = p.U()[(size_t)(tok0 + row0) * 256 + g * 16 + n], u1 = p.U()[(size_t)(tok0 + row1) * 256 + g * 16 + n];
    p.YG()[(size_t)(tok0 + row0) * 256 + g * 16 + n] = f2bf(gelu_tanh(u0 * dsk + acc0[reg]));
    p.YG()[(size_t)(tok0 + row1) * 256 + g * 16 + n] = f2bf(gelu_tanh(u1 * dsk + acc1[reg]));
  }
}

DI void phase_b(const Params& p, int l, char* smem) {
  for (int it = blockIdx.x; it < 96; it += gridDim.x) {
    const int pm = it;
    auto epi = [&](Acc128& acc, int r0, int c0, int fr, int fq) __attribute__((always_inline)) {
      const int tid = tidx(), wid = tid >> 6, wr = wid >> 2, wc = wid & 3, brow = pm * 128;
      const bool ctx = brow < TC;
      float* part = (float*)(smem + 98304);
      float* stat = part + 1024;
      int rb2 = wr * 32 + fq * 4; asm volatile("" : "+v"(rb2));
#pragma unroll
      for (int ai = 0; ai < 2; ++ai)
#pragma unroll
        for (int m = 0; m < 2; ++m)
#pragma unroll
          for (int j = 0; j < 4; ++j) {
            const float v0 = acc[ai][0][m][0][j], v1 = acc[ai][0][m][1][j];
            float s2 = v0 * v0 + v1 * v1;
#pragma unroll
            for (int o = 1; o < 16; o <<= 1) s2 += __shfl_xor(s2, o);
            if (fr == 0) part[(rb2 + ai * 64 + m * 16 + j) * 4 + wc] = s2;
          }
      __syncthreads();
      if (tid < 128) stat[tid] = rsqrtf((part[tid * 4] + part[tid * 4 + 1] + part[tid * 4 + 2] + part[tid * 4 + 3]) * (1.f / 128.f) + 1e-6f);
      __syncthreads();
      int rb4 = wr * 32 + fq * 4; asm volatile("" : "+v"(rb4));
      const int kc = wc * 32 + fr;
      const float g0 = p.kv_g[l * 128 + kc], g1 = p.kv_g[l * 128 + kc + 16];
#pragma unroll
      for (int ai = 0; ai < 2; ++ai)
#pragma unroll
        for (int m = 0; m < 2; ++m)
#pragma unroll
          for (int j = 0; j < 4; ++j) {
            const int rowl = rb4 + ai * 64 + m * 16 + j, row = brow + rowl;
            const float rs = stat[rowl];
            const float c0v = acc[ai][0][m][0][j] * rs * g0, c1v = acc[ai][0][m][1][j] * rs * g1;
            if (ctx) { float* o = p.out + O_CKV + ((size_t)((row >> 8) * 2 + l) * 256 + (row & 255)) * 128 + kc; o[0] = c0v; o[16] = c1v; }
            u16* ck = p.CKV() + (size_t)tok_key(row) * 256 + kc;
            ck[0] = f2bf(c0v); ck[16] = f2bf(c1v);
            if (wc == 0) {
              float v0 = acc[ai][1][m][0][j], v1 = acc[ai][1][m][1][j];
              if (ctx) { float* o = p.out + O_KR + ((size_t)((row >> 8) * 2 + l) * 256 + (row & 255)) * 32 + fr; o[0] = v0; o[16] = v1; }
              else {
                const float2 cs = p.rope()[tok_pos(row) * 16 + fr];
                const float t0 = v0 * cs.x - v1 * cs.y, t1 = v1 * cs.x + v0 * cs.y;
                v0 = t0; v1 = t1;
              }
              u16* k = p.KR() + (size_t)tok_key(row) * 32 + fr;
              k[0] = f2bf(v0); k[16] = f2bf(v1);
            }
          }
      __syncthreads();
    };
    gemm256<2>(p.H(), p.Wt_in() + (size_t)l * 1572864, 1024, pm * 128, 1280, smem, epi);
  }
  constexpr int NS = 12288 / 8, NR = TA / 8;
  idle_block_jobs(NS + NR, 96, [&](int e) __attribute__((always_inline)) {
    const int lane = tidx() & 63, w = tidx() >> 6;
    if (e < NS) { s5_pass1(p, l, e * 8 + w, smem + w * 16896); return; }
    const int t = (e - NS) * 8 + w;
    float4 x = *(const float4*)(p.QL() + (size_t)t * 256 + lane * 4);
    float rs = rsqrtf(wave_sum(x.x * x.x + x.y * x.y + x.z * x.z + x.w * x.w) * (1.f / 256.f) + 1e-6f);
    float4 g = *(const float4*)(p.q_g + l * 256 + lane * 4);
    uint2 o; o.x = pk2(x.x * rs * g.x, x.y * rs * g.y); o.y = pk2(x.z * rs * g.z, x.w * rs * g.w);
    *(uint2*)(p.QLN() + (size_t)t * 256 + lane * 4) = o;
  });
}

DI void phase_c(const Params& p, int l, char* smem) {
  constexpr int N3 = 50 * 4, N2 = 48 * 3, NCAR = 72;
  for (int it = blockIdx.x; it < N3 + N2 + NCAR; it += gridDim.x) {
    if (it >= N3 + N2) { s5_carry(p, l, (it - N3 - N2) * 8 + (tidx() >> 6)); continue; }
    if (it < N3) {
      int pm, pn; tile_order(it, 50, 4, pm, pn);
      auto epi = [&](Acc256& acc, int r0, int c0, int fr, int fq) __attribute__((always_inline)) {
#pragma unroll
        for (int ai = 0; ai < 2; ++ai)
#pragma unroll
          for (int bj = 0; bj < 2; ++bj) {
            const int colbase = c0 + bj * 128;
#pragma unroll
            for (int m = 0; m < 4; ++m) {
              const int rowb = r0 + ai * 128 + m * 16 + fq * 4;
#pragma unroll
              for (int n = 0; n < 2; ++n) {
                const int col = colbase + n * 16 + fr;
                const f32x4 a = acc[ai][bj][m][n];
                if (colbase < 512) {
#pragma unroll
                  for (int j = 0; j < 4; ++j) p.Km()[(size_t)(rowb + j) * 512 + col] = f2bf(a[j]);
                } else {
                  *(uint2*)(p.VmT() + (size_t)(col - 512) * KA + rowb) = make_uint2(pk2(a[0], a[1]), pk2(a[2], a[3]));
                }
              }
            }
          }
      };
      gemm256<4>(p.CKV(), p.Wt_ukv() + (size_t)l * 262144, 256, pm * 256, pn * 256, smem, epi);
    } else {
      const int j = it - N3;
      int pm, pn; tile_order(j, 48, 3, pm, pn);
      auto epi = [&](Acc256& acc, int r0, int c0, int fr, int fq) __attribute__((always_inline)) {
#pragma unroll
        for (int ai = 0; ai < 2; ++ai)
#pragma unroll
          for (int bj = 0; bj < 2; ++bj) {
            const int colbase = c0 + bj * 128;
            const bool ropecol = ((colbase >> 5) % 3 == 2);
#pragma unroll
            for (int m = 0; m < 4; ++m) {
              const int rowb = r0 + ai * 128 + m * 16 + fq * 4;
              const bool rp = ropecol && (rowb >= TC);
#pragma unroll
              for (int j2 = 0; j2 < 4; ++j2) {
                const int row = rowb + j2;
                float v0 = acc[ai][bj][m][0][j2], v1 = acc[ai][bj][m][1][j2];
                if (rp) {
                  float2 cs = p.rope()[tok_pos(row) * 16 + fr];
                  float t0 = v0 * cs.x - v1 * cs.y, t1 = v1 * cs.x + v0 * cs.y;
                  v0 = t0; v1 = t1;
                }
                u16* q = p.Qm() + (size_t)row * 768 + colbase + fr;
                q[0] = f2bf(v0 * QS_M); q[16] = f2bf(v1 * QS_M);
              }
            }
          }
      };
      gemm256<4>(p.QLN(), p.Wt_uq() + (size_t)l * 196608, 256, pm * 256, pn * 256, smem, epi);
    }
  }
}

template <int DQK, int NQ>
DI void attn_item(const Params& p, int seq, int hs, int qb, char* smem) {
  constexpr int KP = DQK * 2 + 16, KS = 64 * KP, VP = 136, VS = 64 * VP, STG = KS + VS;
  constexpr int NKC = DQK / 8, NKTOT = 64 * NKC, NKL = (NKTOT + NT - 1) / NT, NS = DQK / 16;
  const int tid = tidx(), lane = tid & 63, w = tid >> 6, r = lane & 31, h = lane >> 5;
  int qtok0, key0, Lk;
  if (seq < 16) { qtok0 = seq * 256; key0 = seq * 256; Lk = 256; }
  else { int b = seq - 16; qtok0 = TC + b * 4096; key0 = TC + b * 4352; Lk = 4352; }
  const u16 *qp, *k1, *vt; int qld, k1ld;
  if (DQK == 32) { int head = hs >> 1, c = hs & 1; qp = p.Qd() + head * 64 + c * 32; qld = 256; k1 = p.Kd() + head * 64 + c * 32; k1ld = 256; vt = p.VdT() + (size_t)(head * 64) * KA; }
  else { int hh = hs - 8; qp = p.Qm() + hh * 96; qld = 768; k1 = p.Km() + hh * 64; k1ld = 512; vt = p.VmT() + (size_t)(hh * 64) * KA; }
  const int t0 = qtok0 + qb * (256 * NQ) + w * (32 * NQ) + r;
  bf16x8 qf[NQ][NS];
#pragma unroll
  for (int qi = 0; qi < NQ; ++qi)
#pragma unroll
    for (int s = 0; s < NS; ++s) qf[qi][s] = *(const bf16x8*)(qp + (size_t)(t0 + 32 * qi) * qld + 16 * s + 8 * h);
  uint4 rkA0 = make_uint4(0, 0, 0, 0), rkA1 = make_uint4(0, 0, 0, 0), rvA, rkB0 = make_uint4(0, 0, 0, 0), rkB1 = make_uint4(0, 0, 0, 0), rvB;
  const int key_0 = tid / NKC, ch_0 = tid % NKC, key_1 = (tid + NT) / NKC, ch_1 = (tid + NT) % NKC;
  const bool has0 = tid < NKTOT, has1 = (tid + NT) < NKTOT;
  auto kload = [&](int kb, int key, int ch) __attribute__((always_inline)) {
    return (DQK == 32 || ch < 8) ? *(const uint4*)(k1 + (size_t)(kb + key) * k1ld + ch * 8) : *(const uint4*)(p.KR() + (size_t)(kb + key) * 32 + (ch - 8) * 8);
  };
  auto gload = [&](int kt, uint4& r0, uint4& r1, uint4& rv) __attribute__((always_inline)) {
    const int kb = key0 + kt * 64;
    if (has0) r0 = kload(kb, key_0, ch_0);
    if (NKL > 1) { if (has1) r1 = kload(kb, key_1, ch_1); }
    { int dv = tid >> 3, ch = tid & 7; rv = *(const uint4*)(vt + (size_t)dv * KA + kb + ch * 8); }
  };
  auto lstore = [&](int buf, const uint4& r0, const uint4& r1, const uint4& rv) __attribute__((always_inline)) {
    char* sk = smem + buf * STG; char* sv = sk + KS;
    if (has0) *(uint4*)(sk + key_0 * KP + ch_0 * 16) = r0;
    if (NKL > 1) { if (has1) *(uint4*)(sk + key_1 * KP + ch_1 * 16) = r1; }
    { int dv = tid >> 3, ch = tid & 7; uint2* d = (uint2*)(sv + dv * VP + ch * 16); d[0] = make_uint2(rv.x, rv.y); d[1] = make_uint2(rv.z, rv.w); }
  };
  f32x16 O[NQ][2];
  float m[NQ], lsum[NQ];
#pragma unroll
  for (int qi = 0; qi < NQ; ++qi) {
    m[qi] = 0.f; lsum[qi] = 0.f;
#pragma unroll
    for (int e = 0; e < 16; ++e) { O[qi][0][e] = 0.f; O[qi][1][e] = 0.f; }
  }
  const int nkt = Lk >> 6;
  auto compute = [&](int buf, bool first) __attribute__((always_inline)) {
    const char* sk = smem + buf * STG; const char* sv = sk + KS;
    f32x16 S[NQ][2];
#pragma unroll
    for (int st = 0; st < 2; ++st) {
#pragma unroll
      for (int qi = 0; qi < NQ; ++qi) {
        const float nm = -m[qi];
#pragma unroll
        for (int e = 0; e < 16; ++e) S[qi][st][e] = nm;
      }
#pragma unroll
      for (int s = 0; s < NS; ++s) {
        bf16x8 kf = *(const bf16x8*)(sk + (32 * st + r) * KP + (16 * s + 8 * h) * 2);
#pragma unroll
        for (int qi = 0; qi < NQ; ++qi) S[qi][st] = MFMA32(kf, qf[qi][s], S[qi][st]);
      }
    }
    float psv[NQ];
#pragma unroll
    for (int qi = 0; qi < NQ; ++qi) {
      if (first) {
        float mx = fmaxf(fmaxf(S[qi][0][0], S[qi][0][1]), fmaxf(S[qi][1][0], S[qi][1][1]));
#pragma unroll
        for (int e = 2; e < 16; e += 2) { mx = fmaxf(fmaxf(mx, S[qi][0][e]), S[qi][0][e + 1]); mx = fmaxf(fmaxf(mx, S[qi][1][e]), S[qi][1][e + 1]); }
        {
          const unsigned mb = __float_as_uint(mx);
          auto sw = __builtin_amdgcn_permlane32_swap(mb, mb, false, false);
          mx = fmaxf(__uint_as_float(sw[0]), __uint_as_float(sw[1]));
        }
        m[qi] += mx;
#pragma unroll
        for (int e = 0; e < 16; ++e) { S[qi][0][e] -= mx; S[qi][1][e] -= mx; }
      }
      float ps = 0.f;
#pragma unroll
      for (int st = 0; st < 2; ++st)
#pragma unroll
        for (int e = 0; e < 16; ++e) { const float pe = __builtin_amdgcn_exp2f(S[qi][st][e]); S[qi][st][e] = pe; ps += pe; }
      lsum[qi] += ps;
      psv[qi] = ps;
    }
#pragma unroll
    for (int st = 0; st < 2; ++st)
#pragma unroll
      for (int s2 = 0; s2 < 2; ++s2) {
        bf16x8 pf[NQ];
#pragma unroll
        for (int qi = 0; qi < NQ; ++qi) {
          uint4 pu = make_uint4(pk2(S[qi][st][8 * s2], S[qi][st][8 * s2 + 1]), pk2(S[qi][st][8 * s2 + 2], S[qi][st][8 * s2 + 3]),
                                pk2(S[qi][st][8 * s2 + 4], S[qi][st][8 * s2 + 5]), pk2(S[qi][st][8 * s2 + 6], S[qi][st][8 * s2 + 7]));
          pf[qi] = __builtin_bit_cast(bf16x8, pu);
        }
#pragma unroll
        for (int md = 0; md < 2; ++md) {
          const char* va = sv + (32 * md + r) * VP + (32 * st + 16 * s2 + 4 * h) * 2;
          uint2 lo = *(const uint2*)va, hi = *(const uint2*)(va + 16);
          bf16x8 vf = __builtin_bit_cast(bf16x8, make_uint4(lo.x, lo.y, hi.x, hi.y));
#pragma unroll
          for (int qi = 0; qi < NQ; ++qi) O[qi][md] = MFMA32(vf, pf[qi], O[qi][md]);
        }
      }
#pragma unroll
    for (int qi = 0; qi < NQ; ++qi) {
      if (__builtin_amdgcn_ballot_w64(psv[qi] > 1048576.f) != 0) {
        float dlt = (psv[qi] > 1048576.f) ? __log2f(psv[qi]) : 0.f;
        {
          const unsigned mb = __float_as_uint(dlt);
          auto sw = __builtin_amdgcn_permlane32_swap(mb, mb, false, false);
          dlt = fmaxf(__uint_as_float(sw[0]), __uint_as_float(sw[1]));
        }
        const float alpha = __builtin_amdgcn_exp2f(-dlt);
        m[qi] += dlt; lsum[qi] *= alpha;
#pragma unroll
        for (int e = 0; e < 16; ++e) { O[qi][0][e] *= alpha; O[qi][1][e] *= alpha; }
      }
    }
  };
  constexpr bool DEEP = !(NQ == 2 && DQK == 96);
  if (!DEEP) {
    gload(0, rkA0, rkA1, rvA); lstore(0, rkA0, rkA1, rvA);
    __syncthreads();
    for (int kt = 0; kt < nkt; ++kt) {
      if (kt + 1 < nkt) gload(kt + 1, rkA0, rkA1, rvA);
      compute(kt & 1, kt == 0);
      if (kt + 1 < nkt) lstore((kt + 1) & 1, rkA0, rkA1, rvA);
      __syncthreads();
    }
  } else {
  gload(0, rkA0, rkA1, rvA); lstore(0, rkA0, rkA1, rvA); gload(1, rkA0, rkA1, rvA);
  __syncthreads();
  for (int kt = 0; kt < nkt; kt += 2) {
    if (kt + 2 < nkt) gload(kt + 2, rkB0, rkB1, rvB);
    compute(0, kt == 0);
    lstore(1, rkA0, rkA1, rvA);
    __syncthreads();
    if (kt + 3 < nkt) gload(kt + 3, rkA0, rkA1, rvA);
    compute(1, false);
    if (kt + 2 < nkt) lstore(0, rkB0, rkB1, rvB);
    __syncthreads();
  }
  }
#pragma unroll
  for (int qi = 0; qi < NQ; ++qi) {
    const float inv = 1.f / (lsum[qi] + __shfl_xor(lsum[qi], 32));
    const int t = t0 + 32 * qi;
#pragma unroll
    for (int md = 0; md < 2; ++md)
#pragma unroll
      for (int g4 = 0; g4 < 4; ++g4) {
        const int dv0 = 32 * md + 8 * g4 + 4 * h;
        float o0 = O[qi][md][4 * g4] * inv, o1 = O[qi][md][4 * g4 + 1] * inv, o2 = O[qi][md][4 * g4 + 2] * inv, o3 = O[qi][md][4 * g4 + 3] * inv;
        if (DQK == 32) *(float4*)(p.ODIFF() + (size_t)t * 512 + hs * 64 + dv0) = make_float4(o0, o1, o2, o3);
        else *(uint2*)(p.CC() + (size_t)t * 1024 + 512 + (hs - 8) * 64 + dv0) = make_uint2(pk2(o0, o1), pk2(o2, o3));
      }
  }
}

#define XB_S5CTR(l) (3800 + 64 * (l))
DI void phase_d(const Params& p, int l, char* smem, int sub = 0) {
  constexpr int NAD = 2 * 8 * 16, NAC = 16 * 16, NS = 6144 / 8;
  if (sub != 2) {
    for (int it = blockIdx.x; it < NAD + NAC; it += gridDim.x) {
      if (it < NAD) {
        int hs = it & 15, qb = (it >> 4) & 7, b = it >> 7;
        if (hs < 8) attn_item<32, 2>(p, 16 + b, hs, qb, smem); else attn_item<96, 2>(p, 16 + b, hs, qb, smem);
      } else {
        int j = it - NAD, hs = j & 15, b = j >> 4;
        if (hs < 8) attn_item<32, 1>(p, b, hs, 0, smem); else attn_item<96, 1>(p, b, hs, 0, smem);
      }
    }
  }
  if (sub == 1) return;
  if (sub == 2) {
    for (int it = blockIdx.x; it < NS; it += gridDim.x) s5_pass3(p, l, it * 8 + (tidx() >> 6), smem + (tidx() >> 6) * 16896);
    return;
  }
  volatile unsigned* bw = (volatile unsigned*)(smem + 147456 - 16);
  unsigned* ctr = p.bar() + XB_S5CTR(l);
  for (;;) {
    __syncthreads();
    if (threadIdx.x == 0) *bw = xb_add(ctr, 1u);
    __syncthreads();
    const unsigned e = *bw;
    if (e >= (unsigned)NS) break;
    const int w = tidx() >> 6;
    s5_pass3(p, l, (int)e * 8 + w, smem + w * 16896);
  }
}

DI void phase_e(const Params& p, int l, char* smem) {
  constexpr int NG = 96, NR = TA / 8;
  for (int it = blockIdx.x; it < NG; it += gridDim.x) {
    {
      auto epi = [&](Acc128& acc, int r0, int c0, int fr, int fq) __attribute__((always_inline)) {
#pragma unroll
        for (int ai = 0; ai < 2; ++ai)
#pragma unroll
          for (int bj = 0; bj < 2; ++bj)
#pragma unroll
            for (int m = 0; m < 2; ++m) {
#pragma unroll
              for (int n = 0; n < 2; ++n)
#pragma unroll
                for (int j = 0; j < 4; ++j) {
                  const int row = r0 + ai * 64 + m * 16 + fq * 4 + j, col = c0 + bj * 128 + n * 16 + fr;
                  float y = bf2f(p.YG()[(size_t)row * 256 + col]);
                  p.CC()[(size_t)row * 1024 + 256 + col] = f2bf(y * sigmoidf(acc[ai][bj][m][n][j]));
                }
              SCHED;
            }
      };
      gemm256<2>(p.YG(), p.Wt_glu() + (size_t)l * 65536, 256, it * 128, 0, smem, epi);
    }
  }
  idle_block_jobs(NR, NG, [&](int e) __attribute__((always_inline)) {
    {
      const int lane = tidx() & 63, w = tidx() >> 6;
      const int t = e * 8 + w;
      float a1 = 0.f, a2 = 0.f;
      if (lane < 32) { a1 = p.lq1[l * 32 + lane] * p.lk1[l * 32 + lane]; a2 = p.lq2[l * 32 + lane] * p.lk2[l * 32 + lane]; }
      const float lam_init = 0.8f - 0.6f * expf(-0.3f * (float)l);
      const float lam = expf(wave_sum(a1)) - expf(wave_sum(a2)) + lam_init;
      const float gg = p.diff_g[l * 64 + lane] * (1.f - lam_init);
#pragma unroll
      for (int hd = 0; hd < 4; ++hd) {
        float o0 = p.ODIFF()[(size_t)t * 512 + (2 * hd) * 64 + lane], o1 = p.ODIFF()[(size_t)t * 512 + (2 * hd + 1) * 64 + lane];
        float o = o0 - lam * o1;
        float rs = rsqrtf(wave_sum(o * o) * (1.f / 64.f) + 1e-6f);
        p.CC()[(size_t)t * 1024 + hd * 64 + lane] = f2bf(o * rs * gg);
      }
    }
  });
}


#define XB_LNCNT(i) (3520 + (i))
template <int WHICH>
DI void epi_res_ln(const Params& p, const int l, Acc256& acc, int r0, int c0, int fr, int fq, char* smem, int pm, int pn) {
  const int tid = tidx(), wid = tid >> 6, wr = wid >> 2, wc = wid & 3;
  const int brow = pm * 256, cond = tok_cond(brow), slot = (l * 2 + (WHICH - 1)) * 48 + pm;
  const float* mb = p.mods() + (size_t)(l * 3 + cond) * 6144;
  {
    const float* xb = ((WHICH == 1 && l == 0) ? ((brow < TC) ? p.x_prompt + (size_t)brow * 1024 : p.x_sample + (size_t)(brow - TC) * 1024) : p.out + (size_t)brow * 1024) + c0;
    int rb1 = wr * 64 + fq * 4; asm volatile("" : "+v"(rb1));
    float gt[2][2];
#pragma unroll
    for (int bj = 0; bj < 2; ++bj)
#pragma unroll
      for (int n = 0; n < 2; ++n) gt[bj][n] = mb[(WHICH == 1 ? 2048 : 5120) + c0 + bj * 128 + n * 16 + fr];
#pragma unroll
    for (int ai = 0; ai < 2; ++ai)
#pragma unroll
      for (int m = 0; m < 4; ++m) {
        int zz = 0;
        { constexpr int PA = 0; const int pa = (ai * 4 + m + 7) / 4 % 2, pm4 = (ai * 4 + m + 7) % 4; (void)PA;
          const f32x4 d0 = acc[pa][0][pm4][0], d1 = acc[pa][0][pm4][1], d2 = acc[pa][1][pm4][0], d3 = acc[pa][1][pm4][1];
          asm volatile("" : "+v"(zz) : "v"(d0[0]), "v"(d0[1]), "v"(d0[2]), "v"(d0[3]), "v"(d1[0]), "v"(d1[1]), "v"(d1[2]), "v"(d1[3]),
                                       "v"(d2[0]), "v"(d2[1]), "v"(d2[2]), "v"(d2[3]), "v"(d3[0]), "v"(d3[1]), "v"(d3[2]), "v"(d3[3])); }
#pragma unroll
        for (int j = 0; j < 4; ++j) {
          const int rowl = rb1 + ai * 128 + m * 16 + j;
          const float* xr = xb + (rowl * 1024 + fr + zz);
#pragma unroll
          for (int bj = 0; bj < 2; ++bj)
#pragma unroll
            for (int n = 0; n < 2; ++n) acc[ai][bj][m][n][j] = ALPHA * xr[bj * 128 + n * 16] + gt[bj][n] * acc[ai][bj][m][n][j];
        }
        asm volatile("" ::: "memory"); SCHED;
      }
  }
  float* part = (float*)(smem + 98304);
  float* stat = part + 2048;
  int rb2 = wr * 64 + fq * 4; asm volatile("" : "+v"(rb2));
#pragma unroll
  for (int ai = 0; ai < 2; ++ai)
#pragma unroll
    for (int m = 0; m < 4; ++m)
#pragma unroll
      for (int j = 0; j < 4; ++j) {
        float s1 = 0.f, s2 = 0.f;
#pragma unroll
        for (int bj = 0; bj < 2; ++bj)
#pragma unroll
          for (int n = 0; n < 2; ++n) { const float v = acc[ai][bj][m][n][j]; s1 += v; s2 += v * v; }
#pragma unroll
        for (int o = 1; o < 16; o <<= 1) { s1 += __shfl_xor(s1, o); s2 += __shfl_xor(s2, o); }
        if (fr == 0) {
          const int rowl = rb2 + ai * 128 + m * 16 + j;
          part[(rowl * 4 + wc) * 2] = s1; part[(rowl * 4 + wc) * 2 + 1] = s2;
        }
        asm volatile("" ::: "memory"); SCHED;
      }
  __syncthreads();
  float2* xch = p.XCH() + (size_t)slot * 1024;
  if (tid < 256) {
    float a = 0.f, b = 0.f;
#pragma unroll
    for (int w4 = 0; w4 < 4; ++w4) { a += part[(tid * 4 + w4) * 2]; b += part[(tid * 4 + w4) * 2 + 1]; }
    xch[tid * 4 + pn] = make_float2(a, b);
  }
  asm volatile("s_waitcnt vmcnt(0)" ::: "memory");
  __syncthreads();
  if (tid == 0) {
    unsigned* cnt = p.bar() + XB_LNCNT(slot);
    __builtin_amdgcn_fence(__ATOMIC_RELEASE, "agent");
    asm volatile("s_waitcnt vmcnt(0)" ::: "memory");
    xb_add(cnt, 1u);
    unsigned sp = 0;
    while (xb_ld(cnt) < 4u) { __builtin_amdgcn_s_sleep(1); if (++sp > (1u << 22)) break; }
    __builtin_amdgcn_fence(__ATOMIC_ACQUIRE, "agent");
    asm volatile("s_waitcnt vmcnt(0)" ::: "memory");
  }
  __syncthreads();
  if (tid < 256) {
    float a = 0.f, b = 0.f;
#pragma unroll
    for (int t4 = 0; t4 < 4; ++t4) { const float2 q = xch[tid * 4 + t4]; a += q.x; b += q.y; }
    const float mean = a * (1.f / 1024.f);
    stat[tid * 2] = mean; stat[tid * 2 + 1] = rsqrtf(fmaxf(b * (1.f / 1024.f) - mean * mean, 0.f) + 1e-5f);
  }
  __syncthreads();
  const float* gp = (WHICH == 1 ? p.ln1g : p.ln2g) + l * 1024;
  const float* bp = (WHICH == 1 ? p.ln1b : p.ln2b) + l * 1024;
  const bool hasH = (WHICH == 1) || (l + 1 < 2);
  const float* mh = (WHICH == 1) ? mb : p.mods() + (size_t)((l + 1 < 2 ? l + 1 : l) * 3 + cond) * 6144;
  const int scc = (WHICH == 1) ? 4 : 1, shc = (WHICH == 1) ? 3 : 0;
  int rb4 = wr * 64 + fq * 4; asm volatile("" : "+v"(rb4));
  float gam[2][2], bet[2][2], sc1[2][2], sh1[2][2];
#pragma unroll
  for (int bj = 0; bj < 2; ++bj)
#pragma unroll
    for (int n = 0; n < 2; ++n) {
      const int col = c0 + bj * 128 + n * 16 + fr;
      gam[bj][n] = gp[col]; bet[bj][n] = bp[col];
      sc1[bj][n] = hasH ? 1.f + mh[scc * 1024 + col] : 0.f; sh1[bj][n] = hasH ? mh[shc * 1024 + col] : 0.f;
    }
#pragma unroll
  for (int ai = 0; ai < 2; ++ai)
#pragma unroll
    for (int m = 0; m < 4; ++m) {
#pragma unroll
      for (int j = 0; j < 4; ++j) {
        const int rowl = rb4 + ai * 128 + m * 16 + j, row = brow + rowl;
        const float mean = stat[rowl * 2], rs = stat[rowl * 2 + 1];
#pragma unroll
        for (int bj = 0; bj < 2; ++bj)
#pragma unroll
          for (int n = 0; n < 2; ++n) {
            const int col = c0 + bj * 128 + n * 16 + fr;
            const float x = (acc[ai][bj][m][n][j] - mean) * rs * gam[bj][n] + bet[bj][n];
            p.out[(size_t)row * 1024 + col] = x;
            if (hasH) p.H()[(size_t)row * 1024 + col] = f2bf(x * sc1[bj][n] + sh1[bj][n]);
          }
      }
      asm volatile("" ::: "memory"); SCHED;
    }
  __syncthreads();
}

DI void phase_f(const Params& p, int l, char* smem) {
  for (int it = blockIdx.x; it < 48 * 4; it += gridDim.x) {
    int pm, pn; tile_order(it, 48, 4, pm, pn);
    auto epi = [&](Acc256& acc, int r0, int c0, int fr, int fq) __attribute__((always_inline)) {
      if (l == 0) epi_res_ln<1>(p, 0, acc, r0, c0, fr, fq, smem, pm, pn); else epi_res_ln<1>(p, 1, acc, r0, c0, fr, fq, smem, pm, pn);
    };
    gemm256<4>(p.CC(), p.Wt_out() + (size_t)l * 1048576, 1024, pm * 256, pn * 256, smem, epi);
  }
  if (l == 0)
    idle_block_jobs(WJ_ALL - WJ_EARLY - WJ_OUT, 48 * 4, [&](int e) __attribute__((always_inline)) { weight_job(p, 0, WJ_EARLY + WJ_OUT + e, (float*)smem); });
}

template <int MT, class AccT>
DI void epi_swiglu(const Params& p, AccT& acc, int r0, int c0, int fr, int fq) {
#pragma unroll
  for (int ai = 0; ai < 2; ++ai)
#pragma unroll
    for (int bj = 0; bj < 2; ++bj) {
      const int unit = ((c0 + bj * 128) >> 5) * 16 + fr;
#pragma unroll
      for (int m = 0; m < MT; ++m)
#pragma unroll
        for (int j = 0; j < 4; ++j) {
          const int row = r0 + ai * (32 * MT) + m * 16 + fq * 4 + j;
          float g = acc[ai][bj][m][0][j], u = acc[ai][bj][m][1][j];
          p.ACT()[(size_t)row * 2816 + unit] = f2bf(g * sigmoidf(g) * u);
        }
    }
}
DI void phase_h(const Params& p, int l, char* smem) {
  constexpr int NFULL = 1024, NTOT = 48 * 22;
  bool pre = false;
  for (int it = blockIdx.x; it < NFULL + 2 * (NTOT - NFULL); it += gridDim.x) {
    if (it < NFULL) {
      int pm, pn, npm = 0, npn = 0; tile_order(it, 48, 22, pm, pn);
      const bool hn = (it + (int)gridDim.x) < NFULL; if (hn) tile_order(it + gridDim.x, 48, 22, npm, npn);
      auto epi = [&](Acc256& acc, int r0, int c0, int fr, int fq) __attribute__((always_inline)) { epi_swiglu<4>(p, acc, r0, c0, fr, fq); };
      gemm256<4>(p.H(), p.Wt_gu() + (size_t)l * 5767168, 1024, pm * 256, pn * 256, smem, epi, pre, hn, npm * 256, npn * 256); pre = hn;
    } else {
      const int hidx = it - NFULL;
      int pm, pn; tile_order(NFULL + (hidx >> 1), 48, 22, pm, pn);
      auto epi = [&](Acc128& acc, int r0, int c0, int fr, int fq) __attribute__((always_inline)) { epi_swiglu<2>(p, acc, r0, c0, fr, fq); };
      gemm256<2>(p.H(), p.Wt_gu() + (size_t)l * 5767168, 1024, pm * 256 + (hidx & 1) * 128, pn * 256, smem, epi);
    }
  }
}

DI void phase_i(const Params& p, int l, char* smem) {
  for (int it = blockIdx.x; it < 48 * 4; it += gridDim.x) {
    int pm, pn; tile_order(it, 48, 4, pm, pn);
    auto epi = [&](Acc256& acc, int r0, int c0, int fr, int fq) __attribute__((always_inline)) {
      if (l == 0) epi_res_ln<2>(p, 0, acc, r0, c0, fr, fq, smem, pm, pn); else epi_res_ln<2>(p, 1, acc, r0, c0, fr, fq, smem, pm, pn);
    };
    gemm256<4>(p.ACT(), p.Wt_dn() + (size_t)l * 2883584, 2816, pm * 256, pn * 256, smem, epi);
  }
  if (l == 0)
    idle_block_jobs(WJ_ALL, 48 * 4, [&](int e) __attribute__((always_inline)) { weight_job(p, 1, e, (float*)smem); });
}

#define GSYNC() xcd_barrier(xb)
DI void run_layer(const Params& p, const int l, char* smem, const XcdBarrier& xb, bool last) {
  phase_a(p, l, smem); GSYNC();
#if REP_K == 0
  phase_a(p, l, smem); GSYNC();
#endif
  phase_b(p, l, smem); GSYNC();
#if REP_K == 1
  phase_b(p, l, smem); GSYNC();
#endif
  phase_c(p, l, smem); GSYNC();
#if REP_K == 2
  phase_c(p, l, smem); GSYNC();
#endif
  phase_d(p, l, smem);
#if REP_K == 3
  GSYNC(); phase_d(p, l, smem, REP_SUB);
#endif
  GSYNC();
  phase_e(p, l, smem); GSYNC();
#if REP_K == 4
  phase_e(p, l, smem); GSYNC();
#endif
  phase_f(p, l, smem); GSYNC();
  phase_h(p, l, smem);
#if REP_K == 7
  GSYNC(); phase_h(p, l, smem);
#endif
  GSYNC();
  phase_i(p, l, smem);
  if (!last) GSYNC();
}

__global__ void __launch_bounds__(NT) __attribute__((target("no-packed-fp32-ops"))) mega(Params p) {
  extern __shared__ __attribute__((aligned(16))) char smem[];
  volatile LAS unsigned* xst = (volatile LAS unsigned*)(LAS char*)(smem + LDS_BYTES - 16);
  if (threadIdx.x == 0) { xst[0] = 0u; xst[1] = 0u; xst[2] = 0u; xst[3] = 0u; }
  __syncthreads();
  const XcdBarrier xb = xcd_barrier_post(p.bar(), xst);
  if (p.out == nullptr) cg::this_grid().sync();
  phase_pre1(p, smem); GSYNC();
#if REP_K == 10
  phase_pre1(p, smem); GSYNC();
#endif
  phase_pre2(p); GSYNC();
  run_layer(p, 0, smem, xb, false);
  run_layer(p, 1, smem, xb, true);
}

extern "C" void kernel_launch(void* const* d_in, const int* in_sizes, int n_in, void* d_out, int out_size, void* d_ws, size_t ws_size,
                              hipStream_t stream) {
  static int grid_blocks = 0;
  if (!grid_blocks) {
    int dev = 0, cus = 0, per_cu = 0;
    (void)hipGetDevice(&dev);
    (void)hipDeviceGetAttribute(&cus, hipDeviceAttributeMultiprocessorCount, dev);
    (void)hipFuncSetAttribute((const void*)mega, hipFuncAttributeMaxDynamicSharedMemorySize, LDS_BYTES);
    (void)hipOccupancyMaxActiveBlocksPerMultiprocessor(&per_cu, (const void*)mega, NT, LDS_BYTES);
    if (per_cu < 1) per_cu = 1;
    if (per_cu > 1) per_cu = 1;
    grid_blocks = cus * per_cu;
  }
  Params p{};
  const float** pin = (const float**)&p;
  for (int i = 0; i < 39; ++i) pin[i] = (const float*)d_in[i];
  p.out = (float*)d_out;
  p.ws = (char*)d_ws;
  if (WS_END > ws_size) { fprintf(stderr, "kernel_launch: workspace too small (%zu > %zu)\n", (size_t)WS_END, ws_size); return; }
  (void)hipMemsetAsync(p.ws + OFF_bar, 0, 16384, stream);
  void* args[] = {&p};
  hipError_t e = hipLaunchCooperativeKernel((const void*)mega, dim3(grid_blocks), dim3(NT), args, LDS_BYTES, stream);
  if (e != hipSuccess) fprintf(stderr, "cooperative launch failed: %s (grid %d)\n", hipGetErrorString(e), grid_blocks);
}
```

```cpp
#include <hip/hip_runtime.h>
#include <hip/hip_cooperative_groups.h>
#include <cstdio>
namespace cg = cooperative_groups;

#ifndef REP_K
#define REP_K -1
#endif
#ifndef REP_SUB
#define REP_SUB 0
#endif

typedef unsigned short u16;
typedef __bf16 bf2_t __attribute__((ext_vector_type(2)));
typedef float f2_t __attribute__((ext_vector_type(2)));
using bf16x8 = __attribute__((ext_vector_type(8))) short;
using f32x16 = __attribute__((ext_vector_type(16))) float;
using f32x4 = __attribute__((ext_vector_type(4))) float;
#define DI __device__ __forceinline__

DI unsigned pk2(float a, float b) { f2_t v = {a, b}; return __builtin_bit_cast(unsigned, __builtin_convertvector(v, bf2_t)); }
DI u16 f2bf(float a) { return (u16)(pk2(a, 0.f) & 0xffffu); }
DI float bf2f(u16 v) { return __uint_as_float(((unsigned)v) << 16); }
#define MFMA32(a, b, c) __builtin_amdgcn_mfma_f32_32x32x16_bf16((a), (b), (c), 0, 0, 0)
#define MFMA16(a, b, c) __builtin_amdgcn_mfma_f32_16x16x32_bf16((a), (b), (c), 0, 0, 0)

constexpr int TC = 4096, TD = 8192, TA = 12288, KA = 12800;
constexpr int NPH = 22;
constexpr int LDS_BYTES = 147456 + 16;
constexpr int NT = 512;
constexpr float ALPHA = 1.41421356237309515f;
constexpr float LOG2E = 1.44269504088896341f;
constexpr float QS_D = 0.17677669529663689f * LOG2E;
constexpr float QS_M = 0.10206207261596575f * LOG2E;
constexpr size_t O_DK = 12582912, O_DV = 14680064, O_CKV = 16777216, O_KR = 17825792, O_S5 = 18087936;

constexpr size_t al256(size_t x) { return (x + 255) & ~(size_t)255; }
constexpr size_t OFF_bar = 0;
constexpr size_t OFF_Wt_in = OFF_bar + al256(16384);
constexpr size_t OFF_Wt_out = OFF_Wt_in + al256(2ull*1572864*2);
constexpr size_t OFF_Wt_uq = OFF_Wt_out + al256(2ull*1048576*2);
constexpr size_t OFF_Wt_ukv = OFF_Wt_uq + al256(2ull*196608*2);
constexpr size_t OFF_Wt_glu = OFF_Wt_ukv + al256(2ull*262144*2);
constexpr size_t OFF_Wt_gu = OFF_Wt_glu + al256(2ull*65536*2);
constexpr size_t OFF_Wt_dn = OFF_Wt_gu + al256(2ull*5767168*2);
constexpr size_t OFF_mods = OFF_Wt_dn + al256(2ull*2883584*2);
constexpr size_t OFF_rope = OFF_mods + al256(2ull*3*6144*4);
constexpr size_t OFF_s5a = OFF_rope + al256(4096ull*16*8);
constexpr size_t OFF_s5bre = OFF_s5a + al256(4096ull*8);
constexpr size_t OFF_s5bim = OFF_s5bre + al256(4096ull*16*4);
constexpr size_t OFF_H = OFF_s5bim + al256(4096ull*16*4);
constexpr size_t OFF_CC = OFF_H + al256((size_t)TA*1024*2);
constexpr size_t OFF_Qd = OFF_CC + al256((size_t)TA*1024*2);
constexpr size_t OFF_Kd = OFF_Qd + al256((size_t)TA*256*2);
constexpr size_t OFF_VdT = OFF_Kd + al256((size_t)KA*256*2);
constexpr size_t OFF_QLN = OFF_VdT + al256((size_t)KA*256*2);
constexpr size_t OFF_CKV = OFF_QLN + al256((size_t)TA*256*2);
constexpr size_t OFF_KR = OFF_CKV + al256((size_t)KA*256*2);
constexpr size_t OFF_YG = OFF_KR + al256((size_t)KA*32*2);
constexpr size_t OFF_U = OFF_YG + al256((size_t)TA*256*2);
constexpr size_t OFF_QL = OFF_U + al256((size_t)TA*256*4);
constexpr size_t OFF_KVL = OFF_QL + al256((size_t)TA*256*4);
constexpr size_t OFF_FIN = OFF_KVL + al256((size_t)TA*128*4);
constexpr size_t OFF_CIN = OFF_FIN + al256(384ull*2*16*64*8);
constexpr size_t OFF_XCH = OFF_CIN + al256(384ull*2*16*64*8);
constexpr size_t OFF_Qm = OFF_XCH + al256(4ull*48*256*4*8);
constexpr size_t OFF_Km = OFF_Qm + al256((size_t)TA*768*2);
constexpr size_t OFF_VmT = OFF_Km + al256((size_t)KA*512*2);
constexpr size_t OFF_ODIFF = OFF_VmT + al256((size_t)KA*512*2);
constexpr size_t WS_END = OFF_ODIFF + al256((size_t)TA*512*4);
constexpr size_t OFF_ACT = OFF_Qm;
static_assert(OFF_ACT + (size_t)TA * 2816 * 2 <= WS_END, "ACT alias region too small");
static_assert(WS_END <= 268435456ull, "workspace exceeds 256 MiB");

struct Params {
  const float *x_prompt, *x_sample, *c, *cache_k, *cache_v, *cache_ckv, *cache_kr, *state_s5, *c_ctx;
  const float *w_ada, *b_ada, *w_in, *w_out, *lq1, *lk1, *lq2, *lk2, *diff_g;
  const float *s5_lre, *s5_lim, *s5_ldt, *s5_bre, *s5_bim, *s5_cre, *s5_cim, *s5_d, *w_glu;
  const float *q_g, *w_uq, *kv_g, *w_uk, *w_uv, *ln1g, *ln1b, *ln2g, *ln2b, *w_gate, *w_up, *w_down;
  float* out;
  char* ws;
  DI unsigned* bar() const { return (unsigned*)(ws + OFF_bar); }
  DI u16* Wt_in() const { return (u16*)(ws + OFF_Wt_in); }
  DI u16* Wt_out() const { return (u16*)(ws + OFF_Wt_out); }
  DI u16* Wt_uq() const { return (u16*)(ws + OFF_Wt_uq); }
  DI u16* Wt_ukv() const { return (u16*)(ws + OFF_Wt_ukv); }
  DI u16* Wt_glu() const { return (u16*)(ws + OFF_Wt_glu); }
  DI u16* Wt_gu() const { return (u16*)(ws + OFF_Wt_gu); }
  DI u16* Wt_dn() const { return (u16*)(ws + OFF_Wt_dn); }
  DI float* mods() const { return (float*)(ws + OFF_mods); }
  DI float2* rope() const { return (float2*)(ws + OFF_rope); }
  DI float2* s5a() const { return (float2*)(ws + OFF_s5a); }
  DI float* s5bre() const { return (float*)(ws + OFF_s5bre); }
  DI float* s5bim() const { return (float*)(ws + OFF_s5bim); }
  DI u16* H() const { return (u16*)(ws + OFF_H); }
  DI u16* CC() const { return (u16*)(ws + OFF_CC); }
  DI u16* Qd() const { return (u16*)(ws + OFF_Qd); }
  DI u16* Kd() const { return (u16*)(ws + OFF_Kd); }
  DI u16* VdT() const { return (u16*)(ws + OFF_VdT); }
  DI u16* QLN() const { return (u16*)(ws + OFF_QLN); }
  DI u16* CKV() const { return (u16*)(ws + OFF_CKV); }
  DI u16* KR() const { return (u16*)(ws + OFF_KR); }
  DI u16* YG() const { return (u16*)(ws + OFF_YG); }
  DI float* U() const { return (float*)(ws + OFF_U); }
  DI float* QL() const { return (float*)(ws + OFF_QL); }
  DI float* KVL() const { return (float*)(ws + OFF_KVL); }
  DI float2* FIN() const { return (float2*)(ws + OFF_FIN); }
  DI float2* CIN() const { return (float2*)(ws + OFF_CIN); }
  DI float2* XCH() const { return (float2*)(ws + OFF_XCH); }
  DI u16* Qm() const { return (u16*)(ws + OFF_Qm); }
  DI u16* Km() const { return (u16*)(ws + OFF_Km); }
  DI u16* VmT() const { return (u16*)(ws + OFF_VmT); }
  DI float* ODIFF() const { return (float*)(ws + OFF_ODIFF); }
  DI u16* ACT() const { return (u16*)(ws + OFF_ACT); }
};

DI int tidx() { int t = threadIdx.x; asm volatile("" : "+v"(t)); return t; }
DI int tok_cond(int t) { return t < TC ? 0 : 1 + ((t - TC) >> 12); }
DI int tok_pos(int t) { return t < TC ? (t & 255) : ((t - TC) & 4095); }
DI int tok_key(int t) { return t < TC ? t : TC + ((t - TC) >> 12) * 4352 + ((t - TC) & 4095); }
DI float wave_sum(float v) {
#pragma unroll
  for (int o = 32; o; o >>= 1) v += __shfl_xor(v, o);
  return v;
}
DI float row16_sum(float v) {
  v += __builtin_bit_cast(float, __builtin_amdgcn_update_dpp(0, __builtin_bit_cast(int, v), 0xB1, 0xF, 0xF, true));
  v += __builtin_bit_cast(float, __builtin_amdgcn_update_dpp(0, __builtin_bit_cast(int, v), 0x4E, 0xF, 0xF, true));
  v += __builtin_bit_cast(float, __builtin_amdgcn_update_dpp(0, __builtin_bit_cast(int, v), 0x141, 0xF, 0xF, true));
  v += __builtin_bit_cast(float, __builtin_amdgcn_update_dpp(0, __builtin_bit_cast(int, v), 0x140, 0xF, 0xF, true));
  return v;
}
DI int crow(int reg, int h) { return (reg & 3) + 8 * (reg >> 2) + 4 * h; }
DI void lds_fence() { asm volatile("s_waitcnt lgkmcnt(0)" ::: "memory"); }
DI float sigmoidf(float x) { return 1.f / (1.f + __expf(-x)); }

DI void sincos_d(double x, float& s, float& c) {
  const double TWO_PI = 6.283185307179586476925;
  double k = rint(x / TWO_PI);
  double r = x - k * TWO_PI;
  double r2 = r * r, ss = 1.0, cc = 1.0;
#pragma unroll
  for (int n = 13; n >= 1; --n) {
    ss = 1.0 - r2 * (1.0 / (double)((2 * n) * (2 * n + 1))) * ss;
    cc = 1.0 - r2 * (1.0 / (double)((2 * n - 1) * (2 * n))) * cc;
  }
  s = (float)(r * ss); c = (float)cc;
}

#define LAS __attribute__((address_space(3)))
DI int lds_byte(int r, int c) { int st = (r >> 4) * 2 + (c >> 5), rr = r & 15, cc = c & 31, ob = rr * 64 + cc * 2; return st * 1024 + (ob ^ (((ob >> 9) & 1) << 5)); }
DI void stage_rc(int b, int& R, int& C) { int st = b / 1024, sb = b % 1024, swz = sb ^ (((sb >> 9) & 1) << 5); R = (st >> 1) * 16 + swz / 64; C = (st & 1) * 32 + (swz % 64) / 2; }
DI void tile_order(int L, int nM, int nN, int& pm, int& pn) {
  const int nwg = nM * nN; int wgid = L;
  { const int q = nwg / 8, r = nwg % 8, xcd = wgid % 8, off = wgid / 8; wgid = (xcd < r ? xcd * (q + 1) : r * (q + 1) + (xcd - r) * q) + off; }
  const int nig = 8 * nN, gid = wgid / nig, fm = gid * 8, gsz = min(nM - fm, 8);
  pm = fm + ((wgid % nig) % gsz); pn = (wgid % nig) / gsz;
}
template <int MT, class Epi>
DI void gemm256(const u16* A, const u16* Bt, int Kc, int brow, int bcol, char* smem, Epi epi, bool prestaged = false, bool has_next = false, int nbrow = 0, int nbcol = 0,
                const float* pf_tile = nullptr) {
  constexpr int HTB = 16384;
  const int K = Kc;
  LAS char* lds = (LAS char*)smem;
  const int tid = tidx(), wid = tid >> 6, lane = tid & 63, wr = wid >> 2, wc = wid & 3, fr = lane & 15, fq = lane >> 4;
  unsigned voff[2];
#pragma unroll
  for (int i = 0; i < 2; ++i) { int R, C; stage_rc(tid * 16 + i * 8192, R, C); voff[i] = (unsigned)(R * K + C) * 2u; }
  const unsigned ldsw = (unsigned)wid * 1024u;
  const int aoff = lds_byte(wr * (16 * MT) + fr, fq * 8), boff = lds_byte(wc * 32 + fr, fq * 8);
  const char* Ab = (const char*)(A + (size_t)brow * K);
  const char* Bb = (const char*)(Bt + (size_t)bcol * K);
  const size_t hstepA = (size_t)(32 * MT) * K * 2, hstepB = (size_t)128 * K * 2;
#define G_SA(b, h) (((b) * 2 + (h)) * HTB)
#define G_SB(b, h) ((4 + (b) * 2 + (h)) * HTB)
#define G_STAGE_(bufoff, gbase, hh, kt, hs) do { const char* _g = (gbase) + (hh) * (hs) + (size_t)(kt) * 128; _Pragma("unroll") for (int _i = 0; _i < 2; ++_i) \
    __builtin_amdgcn_global_load_lds((const unsigned*)(_g + voff[_i]), (LAS unsigned*)(lds + (bufoff) + ldsw + _i * 8192), 16, 0, 0); } while (0)
#define G_LDA(dst, b, h) do { _Pragma("unroll") for (int m = 0; m < MT; ++m) _Pragma("unroll") for (int k = 0; k < 2; ++k) dst[m][k] = *(const LAS bf16x8*)(lds + G_SA(b, h) + aoff + m * 2048 + k * 1024); } while (0)
#define G_LDB(dst, b, h) do { _Pragma("unroll") for (int n = 0; n < 2; ++n) _Pragma("unroll") for (int k = 0; k < 2; ++k) dst[n][k] = *(const LAS bf16x8*)(lds + G_SB(b, h) + boff + n * 2048 + k * 1024); } while (0)
#define G_MMA(ai, bj, At, Bq) do { __builtin_amdgcn_s_setprio(1); _Pragma("unroll") for (int m = 0; m < MT; ++m) _Pragma("unroll") for (int n = 0; n < 2; ++n) _Pragma("unroll") for (int k = 0; k < 2; ++k) \
    acc[ai][bj][m][n] = MFMA16(At[m][k], Bq[n][k], acc[ai][bj][m][n]); __builtin_amdgcn_s_setprio(0); } while (0)
#define WAIT_V(n) asm volatile("s_waitcnt vmcnt(" #n ")" ::: "memory")
#define WAIT_L(n) asm volatile("s_waitcnt lgkmcnt(" #n ")" ::: "memory")
#define BAR __builtin_amdgcn_s_barrier()
#define SCHED __builtin_amdgcn_sched_barrier(0)
  f32x4 acc[2][2][MT][2];
#pragma unroll
  for (int a = 0; a < 2; ++a)
#pragma unroll
    for (int b = 0; b < 2; ++b)
#pragma unroll
      for (int m = 0; m < MT; ++m)
#pragma unroll
        for (int n = 0; n < 2; ++n) acc[a][b][m][n] = f32x4{0.f, 0.f, 0.f, 0.f};
  bf16x8 At[MT][2], B0[2][2], B1[2][2];
  const int nt = K / 64;
  if (!prestaged) {
    G_STAGE_(G_SB(0, 0), Bb, 0, 0, hstepB); G_STAGE_(G_SA(0, 0), Ab, 0, 0, hstepA);
    G_STAGE_(G_SB(0, 1), Bb, 1, 0, hstepB); G_STAGE_(G_SA(0, 1), Ab, 1, 0, hstepA);
  }
  if (wr == 1) BAR;
  WAIT_V(4); BAR;
  G_STAGE_(G_SB(1, 0), Bb, 0, 1, hstepB); G_STAGE_(G_SA(1, 0), Ab, 0, 1, hstepA); G_STAGE_(G_SB(1, 1), Bb, 1, 1, hstepB);
  WAIT_V(6); BAR;
  for (int t = 0; t < nt - 2; t += 2) {
    G_LDB(B0, 0, 0); SCHED; G_LDA(At, 0, 0); G_STAGE_(G_SA(1, 1), Ab, 1, t + 1, hstepA);
    if (MT == 4) WAIT_L(8); else WAIT_L(4); BAR; WAIT_L(0); G_MMA(0, 0, At, B0); BAR; SCHED;
    G_LDB(B1, 0, 1); G_STAGE_(G_SB(0, 0), Bb, 0, t + 2, hstepB);
    BAR; WAIT_L(0); G_MMA(0, 1, At, B1); BAR;
    G_LDA(At, 0, 1); G_STAGE_(G_SA(0, 0), Ab, 0, t + 2, hstepA);
    BAR; WAIT_L(0); G_MMA(1, 0, At, B0); BAR; SCHED;
    G_STAGE_(G_SB(0, 1), Bb, 1, t + 2, hstepB);
    WAIT_V(6); BAR; G_MMA(1, 1, At, B1); BAR;
    G_LDB(B0, 1, 0); SCHED; G_LDA(At, 1, 0); G_STAGE_(G_SA(0, 1), Ab, 1, t + 2, hstepA);
    if (MT == 4) WAIT_L(8); else WAIT_L(4); BAR; WAIT_L(0); G_MMA(0, 0, At, B0); BAR; SCHED;
    G_LDB(B1, 1, 1); G_STAGE_(G_SB(1, 0), Bb, 0, t + 3, hstepB);
    BAR; WAIT_L(0); G_MMA(0, 1, At, B1); BAR;
    G_LDA(At, 1, 1); G_STAGE_(G_SA(1, 0), Ab, 0, t + 3, hstepA);
    BAR; WAIT_L(0); G_MMA(1, 0, At, B0); BAR; SCHED;
    G_STAGE_(G_SB(1, 1), Bb, 1, t + 3, hstepB);
    WAIT_V(6); BAR; G_MMA(1, 1, At, B1); BAR;
  }
  { G_LDB(B0, 0, 0); G_LDA(At, 0, 0); G_STAGE_(G_SA(1, 1), Ab, 1, nt - 1, hstepA);
    if (pf_tile) {
#pragma unroll
      for (int i = 0; i < 4; ++i) {
        const int line = tid + 512 * i;
        __builtin_amdgcn_global_load_lds((const unsigned*)(pf_tile + (size_t)(line >> 3) * 1024 + (line & 7) * 32), (LAS unsigned*)(lds + 131072 + (i * 8 + wid) * 256), 4, 0, 0);
      }
    }
    BAR; WAIT_L(0); G_MMA(0, 0, At, B0); BAR;
    G_LDB(B1, 0, 1); BAR; WAIT_L(0); G_MMA(0, 1, At, B1); BAR;
    G_LDA(At, 0, 1); WAIT_V(4); BAR; WAIT_L(0); G_MMA(1, 0, At, B0); G_MMA(1, 1, At, B1); BAR; }
  { G_LDB(B0, 1, 0); G_LDA(At, 1, 0); WAIT_V(2); BAR; WAIT_L(0); G_MMA(0, 0, At, B0); BAR;
    G_LDB(B1, 1, 1); WAIT_V(0); BAR; WAIT_L(0); G_MMA(0, 1, At, B1); BAR;
    G_LDA(At, 1, 1); BAR; WAIT_L(0); G_MMA(1, 0, At, B0); G_MMA(1, 1, At, B1); BAR; }
  if (wr == 0) BAR;
  if (has_next) {
    const char* Ab2 = (const char*)(A + (size_t)nbrow * K); const char* Bb2 = (const char*)(Bt + (size_t)nbcol * K);
    G_STAGE_(G_SB(0, 0), Bb2, 0, 0, hstepB); G_STAGE_(G_SA(0, 0), Ab2, 0, 0, hstepA);
    G_STAGE_(G_SB(0, 1), Bb2, 1, 0, hstepB); G_STAGE_(G_SA(0, 1), Ab2, 1, 0, hstepA);
  }
  epi(acc, brow + wr * (16 * MT), bcol + wc * 32, fr, fq);
}

DI void transpose_strip(const float* src, int N, int k0, int n0, u16* dst, int ldd, int mode, int rowoff, float* tl) {
  const int tid = tidx(), c = tid & 63, r0 = tid >> 6;
  float v[4][8];
#pragma unroll
  for (int q = 0; q < 4; ++q)
#pragma unroll
    for (int i = 0; i < 8; ++i) {
      const int n = n0 + 64 * q + c;
      v[q][i] = (n < N) ? src[(size_t)(k0 + r0 + 8 * i) * N + n] : 0.f;
    }
#pragma unroll
  for (int q = 0; q < 4; ++q)
#pragma unroll
    for (int i = 0; i < 8; ++i) tl[q * 4160 + (r0 + 8 * i) * 65 + c] = v[q][i];
  __syncthreads();
  const int nl = tid >> 3, kq = tid & 7;
#pragma unroll
  for (int q = 0; q < 4; ++q) {
    const int n = n0 + 64 * q + nl;
    if (n < N) {
      int drow = (mode == 0) ? (n + rowoff) : ((n >> 4) * 32 + (n & 15) + (mode == 2 ? 16 : 0));
      unsigned pk[4];
#pragma unroll
      for (int j = 0; j < 4; ++j) pk[j] = pk2(tl[q * 4160 + (8 * kq + 2 * j) * 65 + nl], tl[q * 4160 + (8 * kq + 2 * j + 1) * 65 + nl]);
      *(uint4*)(dst + (size_t)drow * ldd + k0 + 8 * kq) = make_uint4(pk[0], pk[1], pk[2], pk[3]);
    }
  }
  __syncthreads();
}

constexpr int WJ_IN = 16 * 6, WJ_UQ = 4 * 3, WJ_UK = 2 * 2, WJ_UV = 2 * 2, WJ_GLU = 4 * 1, WJ_OUT = 16 * 4, WJ_G = 16 * 11, WJ_U = 16 * 11, WJ_D = 44 * 4;
constexpr int WJ_EARLY = WJ_IN + WJ_UQ + WJ_UK + WJ_UV + WJ_GLU, WJ_ALL = WJ_EARLY + WJ_OUT + WJ_G + WJ_U + WJ_D;
DI void weight_job(const Params& p, int l, int j, float* tl) {
  if (j < WJ_IN) { transpose_strip(p.w_in + (size_t)l * 1024 * 1440, 1440, (j % 16) * 64, (j / 16) * 256, p.Wt_in() + (size_t)l * 1572864, 1024, 0, 0, tl); return; }
  j -= WJ_IN;
  if (j < WJ_UQ) { transpose_strip(p.w_uq + (size_t)l * 196608, 768, (j % 4) * 64, (j / 4) * 256, p.Wt_uq() + (size_t)l * 196608, 256, 0, 0, tl); return; }
  j -= WJ_UQ;
  if (j < WJ_UK) { transpose_strip(p.w_uk + (size_t)l * 65536, 512, (j % 2) * 64, (j / 2) * 256, p.Wt_ukv() + (size_t)l * 262144, 256, 0, 0, tl); return; }
  j -= WJ_UK;
  if (j < WJ_UV) { transpose_strip(p.w_uv + (size_t)l * 65536, 512, (j % 2) * 64, (j / 2) * 256, p.Wt_ukv() + (size_t)l * 262144, 256, 0, 512, tl); return; }
  j -= WJ_UV;
  if (j < WJ_GLU) { transpose_strip(p.w_glu + (size_t)l * 65536, 256, (j % 4) * 64, (j / 4) * 256, p.Wt_glu() + (size_t)l * 65536, 256, 0, 0, tl); return; }
  j -= WJ_GLU;
  if (j < WJ_OUT) { transpose_strip(p.w_out + (size_t)l * 1048576, 1024, (j % 16) * 64, (j / 16) * 256, p.Wt_out() + (size_t)l * 1048576, 1024, 0, 0, tl); return; }
  j -= WJ_OUT;
  if (j < WJ_G) { transpose_strip(p.w_gate + (size_t)l * 2883584, 2816, (j % 16) * 64, (j / 16) * 256, p.Wt_gu() + (size_t)l * 5767168, 1024, 1, 0, tl); return; }
  j -= WJ_G;
  if (j < WJ_U) { transpose_strip(p.w_up + (size_t)l * 2883584, 2816, (j % 16) * 64, (j / 16) * 256, p.Wt_gu() + (size_t)l * 5767168, 1024, 2, 0, tl); return; }
  j -= WJ_U;
  transpose_strip(p.w_down + (size_t)l * 2883584, 1024, (j % 44) * 64, (j / 44) * 256, p.Wt_dn() + (size_t)l * 2883584, 2816, 0, 0, tl);
}
template <class F>
DI void idle_block_jobs(int n, int first_idle, F f) {
  const int G = gridDim.x, nidle = G - first_idle;
  if (nidle > 0) { if ((int)blockIdx.x >= first_idle) for (int e = blockIdx.x - first_idle; e < n; e += nidle) f(e); }
  else for (int e = blockIdx.x; e < n; e += G) f(e);
}

DI void phase_pre1(const Params& p, char* smem) {
  const int tid = tidx();
  float* tl = (float*)smem;
  constexpr int N_T = WJ_EARLY + WJ_OUT, N_MODS = 192, N_ROPE = 128, N_S5 = 8, N_ZP = 32;
  for (int it = blockIdx.x; it < N_T + N_MODS + N_ROPE + N_S5 + N_ZP; it += gridDim.x) {
    if (it >= N_T + N_MODS + N_ROPE + N_S5) {
      const int zj = it - (N_T + N_MODS + N_ROPE + N_S5);
#pragma unroll
      for (int i = 0; i < 2; ++i) { const int c = tid + NT * i, row = zj * 64 + (c >> 4), ch = c & 15; *(uint4*)(p.Wt_ukv() + (size_t)row * 256 + 128 + ch * 8) = make_uint4(0, 0, 0, 0); }
      continue;
    }
    if (it >= N_MODS && it < N_MODS + N_T) { weight_job(p, 0, it - N_MODS, tl); continue; }
    if (it < N_MODS) {
      const int j = it, l = j / 96, cg0 = (j % 96) * 64;
      float* sil = (float*)smem;
      float* red = sil + 3072;
      for (int i = tid; i < 3072; i += NT) {
        int ci = i >> 10, k = i & 1023;
        float cv = (ci == 0) ? p.c_ctx[k] : p.c[(ci - 1) * 1024 + k];
        sil[i] = cv * sigmoidf(cv);
      }
      __syncthreads();
      const int w = tid >> 6, lane = tid & 63, n = cg0 + lane;
      float a0 = 0.f, a1 = 0.f, a2 = 0.f;
      const float* wp = p.w_ada + (size_t)l * 1024 * 6144 + n;
#pragma unroll 32
      for (int k = w * 128; k < w * 128 + 128; ++k) {
        float wv = wp[(size_t)k * 6144];
        a0 += sil[k] * wv; a1 += sil[1024 + k] * wv; a2 += sil[2048 + k] * wv;
      }
      red[(w * 3 + 0) * 64 + lane] = a0; red[(w * 3 + 1) * 64 + lane] = a1; red[(w * 3 + 2) * 64 + lane] = a2;
      __syncthreads();
      if (tid < 192) {
        int ci = tid >> 6, ln = tid & 63;
        float sm = 0.f;
#pragma unroll
        for (int ww = 0; ww < 8; ++ww) sm += red[(ww * 3 + ci) * 64 + ln];
        p.mods()[(size_t)(l * 3 + ci) * 6144 + cg0 + ln] = sm + p.b_ada[l * 6144 + cg0 + ln];
      }
      __syncthreads();
      continue;
    }
    int j = it - N_MODS - N_T;
    if (j < N_ROPE) {
      int idx = j * NT + tid, pos = idx >> 4, i = idx & 15, f = i & 7;
      double v = 1.0;
      for (int q = 0; q < (f >> 1); ++q) v *= 0.1;
      if (f & 1) v *= 0.31622776601683794;
      float inv = (float)v;
      float ang = (float)((i < 8) ? (pos >> 6) : (pos & 63)) * inv;
      float sn, cs; sincos_d((double)ang, sn, cs);
      p.rope()[idx] = make_float2(cs, sn);
      continue;
    }
    j -= N_ROPE;
    {
      int e = j * NT + tid;
      float lre = p.s5_lre[e], lim = p.s5_lim[e], dt = expf(p.s5_ldt[e >> 6]);
      float mag = expf(lre * dt), ang = lim * dt, sn, cs;
      sincos_d((double)ang, sn, cs);
      float are = mag * cs, aim = mag * sn;
      float den = lre * lre + lim * lim, nre = are - 1.f, nim = aim;
      float fre = (nre * lre + nim * lim) / den, fim = (nim * lre - nre * lim) / den;
      p.s5a()[e] = make_float2(are, aim);
#pragma unroll
      for (int ch = 0; ch < 16; ++ch) {
        float br = p.s5_bre[(size_t)e * 16 + ch], bi = p.s5_bim[(size_t)e * 16 + ch];
        p.s5bre()[(size_t)e * 16 + ch] = fre * br - fim * bi;
        p.s5bim()[(size_t)e * 16 + ch] = fre * bi + fim * br;
      }
    }
  }
}

DI void store_h(const Params& p, int t, int lm, int scc, int shc, const float* v, int lane) {
  const float* mb = p.mods() + (size_t)(lm * 3 + tok_cond(t)) * 6144;
#pragma unroll
  for (int j = 0; j < 4; ++j) {
    int col = lane * 4 + 256 * j;
    float4 sc = *(const float4*)(mb + scc * 1024 + col), sh = *(const float4*)(mb + shc * 1024 + col);
    uint2 o;
    o.x = pk2(v[4 * j] * (1.f + sc.x) + sh.x, v[4 * j + 1] * (1.f + sc.y) + sh.y);
    o.y = pk2(v[4 * j + 2] * (1.f + sc.z) + sh.z, v[4 * j + 3] * (1.f + sc.w) + sh.w);
    *(uint2*)(p.H() + (size_t)t * 1024 + col) = o;
  }
}

DI void phase_pre2(const Params& p) {
  const int lane = tidx() & 63, w = tidx() >> 6;
  for (int it = blockIdx.x; it < TA / 8; it += gridDim.x) {
    int t = it * 8 + w;
    const float* xr = (t < TC) ? p.x_prompt + (size_t)t * 1024 : p.x_sample + (size_t)(t - TC) * 1024;
    float v[16];
#pragma unroll
    for (int j = 0; j < 4; ++j) { float4 x = *(const float4*)(xr + lane * 4 + 256 * j); v[4 * j] = x.x; v[4 * j + 1] = x.y; v[4 * j + 2] = x.z; v[4 * j + 3] = x.w; }
    store_h(p, t, 0, 1, 0, v, lane);
  }
}

DI void phase_ln(const Params& p, int l, int which) {
  const int lane = tidx() & 63, w = tidx() >> 6;
  const float* gp = (which == 1 ? p.ln1g : p.ln2g) + l * 1024;
  const float* bp = (which == 1 ? p.ln1b : p.ln2b) + l * 1024;
  for (int it = blockIdx.x; it < TA / 8; it += gridDim.x) {
    int t = it * 8 + w;
    float* xr = p.out + (size_t)t * 1024;
    float v[16]; float s = 0.f;
#pragma unroll
    for (int j = 0; j < 4; ++j) { float4 x = *(const float4*)(xr + lane * 4 + 256 * j); v[4 * j] = x.x; v[4 * j + 1] = x.y; v[4 * j + 2] = x.z; v[4 * j + 3] = x.w; s += x.x + x.y + x.z + x.w; }
    float mean = wave_sum(s) * (1.f / 1024.f);
    float q = 0.f;
#pragma unroll
    for (int i = 0; i < 16; ++i) { float d = v[i] - mean; q += d * d; }
    float rs = rsqrtf(wave_sum(q) * (1.f / 1024.f) + 1e-5f);
#pragma unroll
    for (int j = 0; j < 4; ++j) {
      int col = lane * 4 + 256 * j;
      float4 g = *(const float4*)(gp + col), b = *(const float4*)(bp + col);
      v[4 * j] = (v[4 * j] - mean) * rs * g.x + b.x; v[4 * j + 1] = (v[4 * j + 1] - mean) * rs * g.y + b.y;
      v[4 * j + 2] = (v[4 * j + 2] - mean) * rs * g.z + b.z; v[4 * j + 3] = (v[4 * j + 3] - mean) * rs * g.w + b.w;
      *(float4*)(xr + col) = make_float4(v[4 * j], v[4 * j + 1], v[4 * j + 2], v[4 * j + 3]);
    }
    if (which == 1) store_h(p, t, l, 4, 3, v, lane);
    else if (l + 1 < 2) store_h(p, t, l + 1, 1, 0, v, lane);
  }
}

typedef f32x4 Acc256[2][2][4][2];
typedef f32x4 Acc128[2][2][2][2];

#define XB_TMO      128
#define XB_XCNT(j)  (256  + 64 * (j))
#define XB_XSUB(j)  (1280 + 64 * (j))
#define XB_XGEN(j)  (2304 + 64 * (j))
#define XB_TOP      3328
#define XB_TOPGEN   3392
#define XCD_BAR_WORDS 3456
#define XB_SPIN_CAP (1u << 18)
DI unsigned xb_ld(unsigned* p) { return __hip_atomic_load(p, __ATOMIC_RELAXED, __HIP_MEMORY_SCOPE_AGENT); }
DI unsigned xb_add(unsigned* p, unsigned v) { return __hip_atomic_fetch_add(p, v, __ATOMIC_RELAXED, __HIP_MEMORY_SCOPE_AGENT); }
DI unsigned xb_xcc_id() { return (unsigned)__builtin_amdgcn_s_getreg((3 << 11) | 20) & 0xFu; }
#define XB_SPIN(cond, bar) do { unsigned _sp = 0; while (cond) { __builtin_amdgcn_s_sleep(1); \
    if ((++_sp & 255u) == 0u) { if (xb_ld(&(bar)[XB_TMO])) break; if (_sp > XB_SPIN_CAP) { atomicAdd(&(bar)[XB_TMO], 1u); break; } } } } while (0)
struct XcdBarrier { unsigned* bar; unsigned x; volatile LAS unsigned* st; };
DI XcdBarrier xcd_barrier_post(unsigned* bar, volatile LAS unsigned* st) {
  XcdBarrier b; b.bar = bar; b.x = xb_xcc_id(); b.st = st;
  if (threadIdx.x == 0) (void)xb_add(&bar[XB_XCNT(b.x)], 1u);
  return b;
}
DI void xcd_barrier_complete(unsigned* bar, unsigned x, unsigned& nloc, unsigned& nx) {
  const unsigned G = gridDim.x * gridDim.y * gridDim.z;
  unsigned sum, cnt, mine, sp = 0u;
  for (;;) {
    sum = 0u; cnt = 0u; mine = 0u;
#pragma unroll
    for (unsigned j = 0; j < 16; ++j) { const unsigned c = xb_ld(&bar[XB_XCNT(j)]); sum += c; cnt += (c > 0u) ? 1u : 0u; mine = (j == x) ? c : mine; }
    if (sum == G) break;
    __builtin_amdgcn_s_sleep(1);
    if ((++sp & 255u) == 0u) { if (xb_ld(&bar[XB_TMO])) break; if (sp > XB_SPIN_CAP) { atomicAdd(&bar[XB_TMO], 1u); break; } }
  }
  nloc = mine > 0u ? mine : 1u; nx = cnt > 0u ? cnt : 1u;
}
DI void xcd_barrier(const XcdBarrier& b) {
  asm volatile("s_waitcnt vmcnt(0)" ::: "memory");
  __syncthreads();
  if (threadIdx.x == 0) {
    unsigned* bar = b.bar;
    __builtin_amdgcn_s_waitcnt(0);
    unsigned nloc = b.st[0], nx = b.st[1];
    if (nloc == 0u) { xcd_barrier_complete(bar, b.x, nloc, nx); b.st[0] = nloc; b.st[1] = nx; }
    const unsigned old = xb_add(&bar[XB_XSUB(b.x)], 1u);
    const unsigned gen = old / nloc;
    if (old + 1u == (gen + 1u) * nloc) {
      __builtin_amdgcn_fence(__ATOMIC_RELEASE, "agent");
      asm volatile("s_waitcnt vmcnt(0)" ::: "memory");
      const unsigned og = xb_add(&bar[XB_TOP], 1u);
      const unsigned tg = og / nx;
      if (og + 1u == (tg + 1u) * nx) xb_add(&bar[XB_TOPGEN], 1u);
      else XB_SPIN(xb_ld(&bar[XB_TOPGEN]) == tg, bar);
      __builtin_amdgcn_fence(__ATOMIC_ACQUIRE, "agent");
      xb_add(&bar[XB_XGEN(b.x)], 1u);
      asm volatile("s_waitcnt vmcnt(0)" ::: "memory");
    } else {
      XB_SPIN(xb_ld(&bar[XB_XGEN(b.x)]) == gen, bar);
      __builtin_amdgcn_fence(__ATOMIC_ACQUIRE, "agent");
      asm volatile("s_waitcnt vmcnt(0)" ::: "memory");
    }
  }
  __syncthreads();
}

DI void phase_a(const Params& p, int l, char* smem) {
  constexpr int NG = 48 * 5;
  bool pre = false;
  for (int it = blockIdx.x; it < NG + 256 + 200; it += gridDim.x) {
    if (it >= NG + 256) {
      const int zj = it - NG - 256, tid = tidx();
#pragma unroll
      for (int i = 0; i < 2; ++i) { const int c = tid + NT * i, row = zj * 64 + (c >> 4), ch = c & 15; *(uint4*)(p.CKV() + (size_t)row * 256 + 128 + ch * 8) = make_uint4(0, 0, 0, 0); }
      continue;
    }
    if (it < NG) {
      int pm, pn, npm = 0, npn = 0; tile_order(it, 48, 5, pm, pn);
      const bool hn = (it + (int)gridDim.x) < NG; if (hn) tile_order(it + gridDim.x, 48, 5, npm, npn);
      auto epi = [&](Acc256& acc, int r0, int c0, int fr, int fq) __attribute__((always_inline)) {
#pragma unroll
        for (int ai = 0; ai < 2; ++ai)
#pragma unroll
          for (int bj = 0; bj < 2; ++bj) {
            const int colbase = c0 + bj * 128;
            if (colbase >= 1440) continue;
            const int cb = colbase >> 5;
#pragma unroll
            for (int m = 0; m < 4; ++m) {
              const int rowb = r0 + ai * 128 + m * 16 + fq * 4;
              const bool ctx = rowb < TC;
              const f32x4 a0 = acc[ai][bj][m][0], a1 = acc[ai][bj][m][1];
              if (cb < 16 || cb == 44) {
#pragma unroll
                for (int j = 0; j < 4; ++j) {
                  const int row = rowb + j;
                  float v0 = a0[j], v1 = a1[j];
                  const float raw0 = v0, raw1 = v1;
                  if (!ctx) {
                    float2 cs = p.rope()[tok_pos(row) * 16 + fr];
                    float t0 = v0 * cs.x - v1 * cs.y, t1 = v1 * cs.x + v0 * cs.y;
                    v0 = t0; v1 = t1;
                  }
                  if (cb < 8) {
                    u16* q = p.Qd() + (size_t)row * 256 + colbase + fr;
                    q[0] = f2bf(v0 * QS_D); q[16] = f2bf(v1 * QS_D);
                  } else if (cb < 16) {
                    const int cc = colbase - 256 + fr;
                    if (ctx) { float* o = p.out + O_DK + ((size_t)((row >> 8) * 2 + l) * 256 + (row & 255)) * 256 + cc; o[0] = raw0; o[16] = raw1; }
                    u16* k = p.Kd() + (size_t)tok_key(row) * 256 + cc;
                    k[0] = f2bf(v0); k[16] = f2bf(v1);
                  } else {
                    if (ctx) { float* o = p.out + O_KR + ((size_t)((row >> 8) * 2 + l) * 256 + (row & 255)) * 32 + fr; o[0] = raw0; o[16] = raw1; }
                    u16* k = p.KR() + (size_t)tok_key(row) * 32 + fr;
                    k[0] = f2bf(v0); k[16] = f2bf(v1);
                  }
                }
              } else if (cb < 24) {
                const int cc = colbase - 512 + fr;
                if (ctx) {
#pragma unroll
                  for (int j = 0; j < 4; ++j) {
                    float* o = p.out + O_DV + ((size_t)(((rowb + j) >> 8) * 2 + l) * 256 + ((rowb + j) & 255)) * 256 + cc;
                    o[0] = a0[j]; o[16] = a1[j];
                  }
                }
                const size_t key = tok_key(rowb);
                *(uint2*)(p.VdT() + (size_t)cc * KA + key) = make_uint2(pk2(a0[0], a0[1]), pk2(a0[2], a0[3]));
                *(uint2*)(p.VdT() + (size_t)(cc + 16) * KA + key) = make_uint2(pk2(a1[0], a1[1]), pk2(a1[2], a1[3]));
              } else {
                float* dst; int ld, c2;
                if (cb < 32) { dst = p.U(); ld = 256; c2 = colbase - 768 + fr; }
                else if (cb < 40) { dst = p.QL(); ld = 256; c2 = colbase - 1024 + fr; }
                else { dst = p.KVL(); ld = 128; c2 = colbase - 1280 + fr; }
#pragma unroll
                for (int j = 0; j < 4; ++j) { float* o = dst + (size_t)(rowb + j) * ld + c2; o[0] = a0[j]; o[16] = a1[j]; }
              }
              SCHED;
            }
          }
      };
      gemm256<4>(p.H(), p.Wt_in() + (size_t)l * 1572864, 1024, pm * 256, pn * 256, smem, epi, pre, hn, npm * 256, npn * 256); pre = hn;
    } else {
      const int tid = tidx();
      const int ci = (it - NG) * 2 + (tid >> 8), t8 = tid & 255, b = ci >> 8, j = ci & 255;
      const size_t key = TC + b * 4352 + 4096 + j;
      const size_t src = (size_t)((b * 2 + l) * 256 + j);
      p.Kd()[key * 256 + t8] = f2bf(p.cache_k[src * 256 + t8]);
      p.VdT()[(size_t)t8 * KA + key] = f2bf(p.cache_v[src * 256 + t8]);
      if (t8 < 128) p.CKV()[key * 256 + t8] = f2bf(p.cache_ckv[src * 128 + t8]);
      if (t8 < 32) p.KR()[key * 32 + t8] = f2bf(p.cache_kr[src * 32 + t8]);
    }
  }
}

DI void s5_bu_to_lds(const Params& p, int e0, int tok0, int g, char* img, int lane) {
  const int n = lane & 15, q4 = lane >> 4;
  bf16x8 af[2];
#pragma unroll
  for (int mt = 0; mt < 2; ++mt) {
    uint4 z = make_uint4(0, 0, 0, 0);
    if (q4 < 2) {
      const float* up = p.U() + (size_t)(tok0 + 16 * mt + n) * 256 + g * 16 + 8 * q4;
      float4 x = *(const float4*)up, y = *(const float4*)(up + 4);
      z = make_uint4(pk2(x.x, x.y), pk2(x.z, x.w), pk2(y.x, y.y), pk2(y.z, y.w));
    }
    af[mt] = __builtin_bit_cast(bf16x8, z);
  }
#pragma unroll
  for (int nt = 0; nt < 8; ++nt) {
    uint4 z = make_uint4(0, 0, 0, 0);
    if (q4 < 2) {
      const float* bp = ((nt < 4) ? p.s5bre() : p.s5bim()) + (size_t)(e0 + 16 * (nt & 3) + n) * 16 + 8 * q4;
      float4 x = *(const float4*)bp, y = *(const float4*)(bp + 4);
      z = make_uint4(pk2(x.x, x.y), pk2(x.z, x.w), pk2(y.x, y.y), pk2(y.z, y.w));
    }
    const bf16x8 bfr = __builtin_bit_cast(bf16x8, z);
#pragma unroll
    for (int mt = 0; mt < 2; ++mt) {
      f32x4 d = {0.f, 0.f, 0.f, 0.f};
      d = MFMA16(af[mt], bfr, d);
#pragma unroll
      for (int reg = 0; reg < 4; ++reg) *(float*)(img + (16 * mt + 4 * q4 + reg) * 528 + (16 * nt + n) * 4) = d[reg];
    }
  }
}

DI void s5_pass1(const Params& p, int l, int witem, char* img) {
  const int lane = tidx() & 63;
  int d, g, c, nch, qbase, cbase;
  if (witem < 8192) { c = witem & 127; g = (witem >> 7) & 15; d = (witem >> 11) & 1; int b = witem >> 12; nch = 128; qbase = TC + b * 4096; cbase = 128 + b * 128; }
  else { int x = witem - 8192; c = x & 7; g = (x >> 3) & 15; d = (x >> 7) & 1; int b = x >> 8; nch = 8; qbase = b * 256; cbase = b * 8; }
  const int e0 = ((l * 2 + d) * 16 + g) * 64;
  const int tok0 = qbase + (d ? (nch - 1 - c) : c) * 32;
  s5_bu_to_lds(p, e0, tok0, g, img, lane);
  lds_fence();
  const float2 a = p.s5a()[e0 + lane];
  float hr = 0.f, hi = 0.f;
#pragma unroll 4
  for (int j = 0; j < 32; ++j) {
    const int row = d ? (31 - j) : j;
    const float bur = *(const float*)(img + row * 528 + lane * 4), bui = *(const float*)(img + row * 528 + 256 + lane * 4);
    float nr = a.x * hr - a.y * hi + bur, ni = a.x * hi + a.y * hr + bui;
    hr = nr; hi = ni;
  }
  p.FIN()[(size_t)(((cbase + c) * 2 + d) * 16 + g) * 64 + lane] = make_float2(hr, hi);
  lds_fence();
}

DI void s5_carry(const Params& p, int l, int witem) {
  const int lane = tidx() & 63;
  int g, d, b, nch, cbase; bool isctx;
  if (witem < 64) { g = witem & 15; d = (witem >> 4) & 1; b = witem >> 5; nch = 128; cbase = 128 + b * 128; isctx = false; }
  else { int x = witem - 64; g = x & 15; d = (x >> 4) & 1; b = x >> 5; nch = 8; cbase = b * 8; isctx = true; }
  const int e = ((l * 2 + d) * 16 + g) * 64 + lane;
  const float2 a = p.s5a()[e];
  float tr = a.x, ti = a.y;
#pragma unroll
  for (int s = 0; s < 5; ++s) { float nr = tr * tr - ti * ti, ni = 2.f * tr * ti; tr = nr; ti = ni; }
  float hr = 0.f, hi = 0.f;
  if (!isctx) { const float* s = p.state_s5 + ((size_t)(((b * 2 + l) * 2 + d) * 16 + g) * 64 + lane) * 2; hr = s[0]; hi = s[1]; }
  const size_t base = (size_t)((cbase * 2 + d) * 16 + g) * 64 + lane;
  if (isctx) {
    float2 f[8];
#pragma unroll
    for (int i = 0; i < 8; ++i) f[i] = p.FIN()[base + (size_t)i * 2048];
#pragma unroll
    for (int i = 0; i < 8; ++i) {
      p.CIN()[base + (size_t)i * 2048] = make_float2(hr, hi);
      float nr = tr * hr - ti * hi + f[i].x, ni = tr * hi + ti * hr + f[i].y;
      hr = nr; hi = ni;
    }
  } else {
    for (int c = 0; c < 128; c += 32) {
      float2 f[32];
#pragma unroll
      for (int i = 0; i < 32; ++i) f[i] = p.FIN()[base + (size_t)(c + i) * 2048];
#pragma unroll
      for (int i = 0; i < 32; ++i) {
        p.CIN()[base + (size_t)(c + i) * 2048] = make_float2(hr, hi);
        float nr = tr * hr - ti * hi + f[i].x, ni = tr * hi + ti * hr + f[i].y;
        hr = nr; hi = ni;
      }
    }
  }
  if (isctx) {
    float* o = p.out + O_S5 + ((size_t)(((b * 2 + l) * 2 + d) * 16 + g) * 64 + lane) * 2;
    o[0] = hr; o[1] = hi;
  }
}

DI float gelu_tanh(float x) {
  float z = 0.7978845608028654f * (x + 0.044715f * x * x * x);
  float t = 1.f - 2.f / (1.f + __expf(2.f * z));
  return 0.5f * x * (1.f + t);
}

DI void s5_pass3(const Params& p, int l, int witem, char* img) {
  const int lane = tidx() & 63;
  int tc, g, b, nch, qbase, cbase;
  if (witem < 4096) { tc = witem & 127; g = (witem >> 7) & 15; b = witem >> 11; nch = 128; qbase = TC + b * 4096; cbase = 128 + b * 128; }
  else { int x = witem - 4096; tc = x & 7; g = (x >> 3) & 15; b = x >> 7; nch = 8; qbase = b * 256; cbase = b * 8; }
  const int tok0 = qbase + tc * 32;
  f32x4 acc0 = {0.f, 0.f, 0.f, 0.f}, acc1 = {0.f, 0.f, 0.f, 0.f};
  const int n = lane & 15, q4 = lane >> 4;
#pragma unroll 1
  for (int d = 0; d < 2; ++d) {
    const int pc = d ? (nch - 1 - tc) : tc;
    const int e0 = ((l * 2 + d) * 16 + g) * 64;
    s5_bu_to_lds(p, e0, tok0, g, img, lane);
    lds_fence();
    const float2 a = p.s5a()[e0 + lane];
    const float2 h0 = p.CIN()[(size_t)(((cbase + pc) * 2 + d) * 16 + g) * 64 + lane];
    float hr = h0.x, hi = h0.y;
#pragma unroll 4
    for (int j = 0; j < 32; ++j) {
      const int row = d ? (31 - j) : j;
      const float bur = *(const float*)(img + row * 528 + lane * 4), bui = *(const float*)(img + row * 528 + 256 + lane * 4);
      float nr = a.x * hr - a.y * hi + bur, ni = a.x * hi + a.y * hr + bui;
      hr = nr; hi = ni;
      *(u16*)(img + row * 528 + lane * 2) = f2bf(hr);
      *(u16*)(img + row * 528 + 128 + lane * 2) = f2bf(hi);
    }
    lds_fence();
#pragma unroll
    for (int s = 0; s < 4; ++s) {
      const float* cp = ((s < 2) ? p.s5_cre : p.s5_cim) + ((size_t)(((l * 2 + d) * 16 + g) * 16 + n)) * 64 + 32 * (s & 1) + 8 * q4;
      float4 c0 = *(const float4*)cp, c1 = *(const float4*)(cp + 4);
      const float sg = (s < 2) ? 1.f : -1.f;
      bf16x8 bfrag = __builtin_bit_cast(bf16x8, make_uint4(pk2(sg * c0.x, sg * c0.y), pk2(sg * c0.z, sg * c0.w), pk2(sg * c1.x, sg * c1.y), pk2(sg * c1.z, sg * c1.w)));
      bf16x8 a0 = *(const bf16x8*)(img + (n) * 528 + (32 * s + 8 * q4) * 2);
      bf16x8 a1 = *(const bf16x8*)(img + (16 + n) * 528 + (32 * s + 8 * q4) * 2);
      acc0 = MFMA16(a0, bfrag, acc0);
      acc1 = MFMA16(a1, bfrag, acc1);
    }
    lds_fence();
  }
  const float dsk = p.s5_d[(l * 16 + g) * 16 + n];
#pragma unroll
  for (int reg = 0; reg < 4; ++reg) {
    const int row0 = 4 * q4 + reg, row1 = 16 + 4 * q4 + reg;
    const float u0 = p.U()[(size_t)(tok0 + row0) * 256 + g * 16 + n], u1 = p.U()[(size_t)(tok0 + row1) * 256 + g * 16 + n];
    p.YG()[(size_t)(tok0 + row0) * 256 + g * 16 + n] = f2bf(gelu_tanh(u0 * dsk + acc0[reg]));
    p.YG()[(size_t)(tok0 + row1) * 256 + g * 16 + n] = f2bf(gelu_tanh(u1 * dsk + acc1[reg]));
  }
}

DI void phase_b(const Params& p, int l, char* smem) {
  for (int it = blockIdx.x; it < 96; it += gridDim.x) {
    const int pm = it;
    auto epi = [&](Acc128& acc, int r0, int c0, int fr, int fq) __attribute__((always_inline)) {
      const int tid = tidx(), wid = tid >> 6, wr = wid >> 2, wc = wid & 3, brow = pm * 128;
      const bool ctx = brow < TC;
      float* part = (float*)(smem + 98304);
      float* stat = part + 1024;
      int rb2 = wr * 32 + fq * 4; asm volatile("" : "+v"(rb2));
#pragma unroll
      for (int ai = 0; ai < 2; ++ai)
#pragma unroll
        for (int m = 0; m < 2; ++m)
#pragma unroll
          for (int j = 0; j < 4; ++j) {
            const float v0 = acc[ai][0][m][0][j], v1 = acc[ai][0][m][1][j];
            float s2 = v0 * v0 + v1 * v1;
            s2 = row16_sum(s2);
            if (fr == 0) part[(rb2 + ai * 64 + m * 16 + j) * 4 + wc] = s2;
          }
      __syncthreads();
      if (tid < 128) stat[tid] = rsqrtf((part[tid * 4] + part[tid * 4 + 1] + part[tid * 4 + 2] + part[tid * 4 + 3]) * (1.f / 128.f) + 1e-6f);
      __syncthreads();
      int rb4 = wr * 32 + fq * 4; asm volatile("" : "+v"(rb4));
      const int kc = wc * 32 + fr;
      const float g0 = p.kv_g[l * 128 + kc], g1 = p.kv_g[l * 128 + kc + 16];
#pragma unroll
      for (int ai = 0; ai < 2; ++ai)
#pragma unroll
        for (int m = 0; m < 2; ++m)
#pragma unroll
          for (int j = 0; j < 4; ++j) {
            const int rowl = rb4 + ai * 64 + m * 16 + j, row = brow + rowl;
            const float rs = stat[rowl];
            const float c0v = acc[ai][0][m][0][j] * rs * g0, c1v = acc[ai][0][m][1][j] * rs * g1;
            if (ctx) { float* o = p.out + O_CKV + ((size_t)((row >> 8) * 2 + l) * 256 + (row & 255)) * 128 + kc; o[0] = c0v; o[16] = c1v; }
            u16* ck = p.CKV() + (size_t)tok_key(row) * 256 + kc;
            ck[0] = f2bf(c0v); ck[16] = f2bf(c1v);
            if (wc == 0) {
              float v0 = acc[ai][1][m][0][j], v1 = acc[ai][1][m][1][j];
              if (ctx) { float* o = p.out + O_KR + ((size_t)((row >> 8) * 2 + l) * 256 + (row & 255)) * 32 + fr; o[0] = v0; o[16] = v1; }
              else {
                const float2 cs = p.rope()[tok_pos(row) * 16 + fr];
                const float t0 = v0 * cs.x - v1 * cs.y, t1 = v1 * cs.x + v0 * cs.y;
                v0 = t0; v1 = t1;
              }
              u16* k = p.KR() + (size_t)tok_key(row) * 32 + fr;
              k[0] = f2bf(v0); k[16] = f2bf(v1);
            }
          }
      __syncthreads();
    };
    gemm256<2>(p.H(), p.Wt_in() + (size_t)l * 1572864, 1024, pm * 128, 1280, smem, epi);
  }
  constexpr int NS = 12288 / 8, NR = TA / 8;
  idle_block_jobs(NS + NR, 96, [&](int e) __attribute__((always_inline)) {
    const int lane = tidx() & 63, w = tidx() >> 6;
    if (e < NS) { s5_pass1(p, l, e * 8 + w, smem + w * 16896); return; }
    const int t = (e - NS) * 8 + w;
    float4 x = *(const float4*)(p.QL() + (size_t)t * 256 + lane * 4);
    float rs = rsqrtf(wave_sum(x.x * x.x + x.y * x.y + x.z * x.z + x.w * x.w) * (1.f / 256.f) + 1e-6f);
    float4 g = *(const float4*)(p.q_g + l * 256 + lane * 4);
    uint2 o; o.x = pk2(x.x * rs * g.x, x.y * rs * g.y); o.y = pk2(x.z * rs * g.z, x.w * rs * g.w);
    *(uint2*)(p.QLN() + (size_t)t * 256 + lane * 4) = o;
  });
}

DI void phase_c(const Params& p, int l, char* smem) {
  constexpr int N3 = 50 * 4, N2 = 48 * 3, NCAR = 72;
  for (int it = blockIdx.x; it < N3 + N2 + NCAR; it += gridDim.x) {
    if (it >= N3 + N2) { s5_carry(p, l, (it - N3 - N2) * 8 + (tidx() >> 6)); continue; }
    if (it < N3) {
      int pm, pn; tile_order(it, 50, 4, pm, pn);
      auto epi = [&](Acc256& acc, int r0, int c0, int fr, int fq) __attribute__((always_inline)) {
#pragma unroll
        for (int ai = 0; ai < 2; ++ai)
#pragma unroll
          for (int bj = 0; bj < 2; ++bj) {
            const int colbase = c0 + bj * 128;
#pragma unroll
            for (int m = 0; m < 4; ++m) {
              const int rowb = r0 + ai * 128 + m * 16 + fq * 4;
#pragma unroll
              for (int n = 0; n < 2; ++n) {
                const int col = colbase + n * 16 + fr;
                const f32x4 a = acc[ai][bj][m][n];
                if (colbase < 512) {
#pragma unroll
                  for (int j = 0; j < 4; ++j) p.Km()[(size_t)(rowb + j) * 512 + col] = f2bf(a[j]);
                } else {
                  *(uint2*)(p.VmT() + (size_t)(col - 512) * KA + rowb) = make_uint2(pk2(a[0], a[1]), pk2(a[2], a[3]));
                }
              }
            }
          }
      };
      gemm256<4>(p.CKV(), p.Wt_ukv() + (size_t)l * 262144, 256, pm * 256, pn * 256, smem, epi);
    } else {
      const int j = it - N3;
      int pm, pn; tile_order(j, 48, 3, pm, pn);
      auto epi = [&](Acc256& acc, int r0, int c0, int fr, int fq) __attribute__((always_inline)) {
#pragma unroll
        for (int ai = 0; ai < 2; ++ai)
#pragma unroll
          for (int bj = 0; bj < 2; ++bj) {
            const int colbase = c0 + bj * 128;
            const bool ropecol = ((colbase >> 5) % 3 == 2);
#pragma unroll
            for (int m = 0; m < 4; ++m) {
              const int rowb = r0 + ai * 128 + m * 16 + fq * 4;
              const bool rp = ropecol && (rowb >= TC);
#pragma unroll
              for (int j2 = 0; j2 < 4; ++j2) {
                const int row = rowb + j2;
                float v0 = acc[ai][bj][m][0][j2], v1 = acc[ai][bj][m][1][j2];
                if (rp) {
                  float2 cs = p.rope()[tok_pos(row) * 16 + fr];
                  float t0 = v0 * cs.x - v1 * cs.y, t1 = v1 * cs.x + v0 * cs.y;
                  v0 = t0; v1 = t1;
                }
                u16* q = p.Qm() + (size_t)row * 768 + colbase + fr;
                q[0] = f2bf(v0 * QS_M); q[16] = f2bf(v1 * QS_M);
              }
            }
          }
      };
      gemm256<4>(p.QLN(), p.Wt_uq() + (size_t)l * 196608, 256, pm * 256, pn * 256, smem, epi);
    }
  }
}

template <int DQK, int NQ>
DI void attn_item(const Params& p, int seq, int hs, int qb, char* smem) {
  constexpr int KP = DQK * 2 + 16, KS = 64 * KP, VP = 136, VS = 64 * VP, STG = KS + VS;
  constexpr int NKC = DQK / 8, NKTOT = 64 * NKC, NKL = (NKTOT + NT - 1) / NT, NS = DQK / 16;
  const int tid = tidx(), lane = tid & 63, w = tid >> 6, r = lane & 31, h = lane >> 5;
  int qtok0, key0, Lk;
  if (seq < 16) { qtok0 = seq * 256; key0 = seq * 256; Lk = 256; }
  else { int b = seq - 16; qtok0 = TC + b * 4096; key0 = TC + b * 4352; Lk = 4352; }
  const u16 *qp, *k1, *vt; int qld, k1ld;
  if (DQK == 32) { int head = hs >> 1, c = hs & 1; qp = p.Qd() + head * 64 + c * 32; qld = 256; k1 = p.Kd() + head * 64 + c * 32; k1ld = 256; vt = p.VdT() + (size_t)(head * 64) * KA; }
  else { int hh = hs - 8; qp = p.Qm() + hh * 96; qld = 768; k1 = p.Km() + hh * 64; k1ld = 512; vt = p.VmT() + (size_t)(hh * 64) * KA; }
  const int t0 = qtok0 + qb * (256 * NQ) + w * (32 * NQ) + r;
  bf16x8 qf[NQ][NS];
#pragma unroll
  for (int qi = 0; qi < NQ; ++qi)
#pragma unroll
    for (int s = 0; s < NS; ++s) qf[qi][s] = *(const bf16x8*)(qp + (size_t)(t0 + 32 * qi) * qld + 16 * s + 8 * h);
  uint4 rkA0 = make_uint4(0, 0, 0, 0), rkA1 = make_uint4(0, 0, 0, 0), rvA, rkB0 = make_uint4(0, 0, 0, 0), rkB1 = make_uint4(0, 0, 0, 0), rvB;
  const int key_0 = tid / NKC, ch_0 = tid % NKC, key_1 = (tid + NT) / NKC, ch_1 = (tid + NT) % NKC;
  const bool has0 = tid < NKTOT, has1 = (tid + NT) < NKTOT;
  auto kload = [&](int kb, int key, int ch) __attribute__((always_inline)) {
    return (DQK == 32 || ch < 8) ? *(const uint4*)(k1 + (size_t)(kb + key) * k1ld + ch * 8) : *(const uint4*)(p.KR() + (size_t)(kb + key) * 32 + (ch - 8) * 8);
  };
  auto gload = [&](int kt, uint4& r0, uint4& r1, uint4& rv) __attribute__((always_inline)) {
    const int kb = key0 + kt * 64;
    if (has0) r0 = kload(kb, key_0, ch_0);
    if (NKL > 1) { if (has1) r1 = kload(kb, key_1, ch_1); }
    { int dv = tid >> 3, ch = tid & 7; rv = *(const uint4*)(vt + (size_t)dv * KA + kb + ch * 8); }
  };
  auto lstore = [&](int buf, const uint4& r0, const uint4& r1, const uint4& rv) __attribute__((always_inline)) {
    char* sk = smem + buf * STG; char* sv = sk + KS;
    if (has0) *(uint4*)(sk + key_0 * KP + ch_0 * 16) = r0;
    if (NKL > 1) { if (has1) *(uint4*)(sk + key_1 * KP + ch_1 * 16) = r1; }
    { int dv = tid >> 3, ch = tid & 7; uint2* d = (uint2*)(sv + dv * VP + ch * 16); d[0] = make_uint2(rv.x, rv.y); d[1] = make_uint2(rv.z, rv.w); }
  };
  f32x16 O[NQ][2];
  float m[NQ], lsum[NQ];
#pragma unroll
  for (int qi = 0; qi < NQ; ++qi) {
    m[qi] = 0.f; lsum[qi] = 0.f;
#pragma unroll
    for (int e = 0; e < 16; ++e) { O[qi][0][e] = 0.f; O[qi][1][e] = 0.f; }
  }
  const int nkt = Lk >> 6;
  auto compute = [&](int buf, bool first) __attribute__((always_inline)) {
    const char* sk = smem + buf * STG; const char* sv = sk + KS;
    f32x16 S[NQ][2];
#pragma unroll
    for (int st = 0; st < 2; ++st) {
#pragma unroll
      for (int qi = 0; qi < NQ; ++qi) {
        const float nm = -m[qi];
#pragma unroll
        for (int e = 0; e < 16; ++e) S[qi][st][e] = nm;
      }
#pragma unroll
      for (int s = 0; s < NS; ++s) {
        bf16x8 kf = *(const bf16x8*)(sk + (32 * st + r) * KP + (16 * s + 8 * h) * 2);
#pragma unroll
        for (int qi = 0; qi < NQ; ++qi) S[qi][st] = MFMA32(kf, qf[qi][s], S[qi][st]);
      }
    }
    float psv[NQ];
#pragma unroll
    for (int qi = 0; qi < NQ; ++qi) {
      if (first) {
        float mx = fmaxf(fmaxf(S[qi][0][0], S[qi][0][1]), fmaxf(S[qi][1][0], S[qi][1][1]));
#pragma unroll
        for (int e = 2; e < 16; e += 2) { mx = fmaxf(fmaxf(mx, S[qi][0][e]), S[qi][0][e + 1]); mx = fmaxf(fmaxf(mx, S[qi][1][e]), S[qi][1][e + 1]); }
        {
          const unsigned mb = __float_as_uint(mx);
          auto sw = __builtin_amdgcn_permlane32_swap(mb, mb, false, false);
          mx = fmaxf(__uint_as_float(sw[0]), __uint_as_float(sw[1]));
        }
        m[qi] += mx;
#pragma unroll
        for (int e = 0; e < 16; ++e) { S[qi][0][e] -= mx; S[qi][1][e] -= mx; }
      }
      float ps = 0.f;
#pragma unroll
      for (int st = 0; st < 2; ++st)
#pragma unroll
        for (int e = 0; e < 16; ++e) { const float pe = __builtin_amdgcn_exp2f(S[qi][st][e]); S[qi][st][e] = pe; ps += pe; }
      lsum[qi] += ps;
      psv[qi] = ps;
    }
#pragma unroll
    for (int st = 0; st < 2; ++st)
#pragma unroll
      for (int s2 = 0; s2 < 2; ++s2) {
        bf16x8 pf[NQ];
#pragma unroll
        for (int qi = 0; qi < NQ; ++qi) {
          uint4 pu = make_uint4(pk2(S[qi][st][8 * s2], S[qi][st][8 * s2 + 1]), pk2(S[qi][st][8 * s2 + 2], S[qi][st][8 * s2 + 3]),
                                pk2(S[qi][st][8 * s2 + 4], S[qi][st][8 * s2 + 5]), pk2(S[qi][st][8 * s2 + 6], S[qi][st][8 * s2 + 7]));
          pf[qi] = __builtin_bit_cast(bf16x8, pu);
        }
#pragma unroll
        for (int md = 0; md < 2; ++md) {
          const char* va = sv + (32 * md + r) * VP + (32 * st + 16 * s2 + 4 * h) * 2;
          uint2 lo = *(const uint2*)va, hi = *(const uint2*)(va + 16);
          bf16x8 vf = __builtin_bit_cast(bf16x8, make_uint4(lo.x, lo.y, hi.x, hi.y));
#pragma unroll
          for (int qi = 0; qi < NQ; ++qi) O[qi][md] = MFMA32(vf, pf[qi], O[qi][md]);
        }
      }
#pragma unroll
    for (int qi = 0; qi < NQ; ++qi) {
      if (__builtin_amdgcn_ballot_w64(psv[qi] > 1048576.f) != 0) {
        float dlt = (psv[qi] > 1048576.f) ? __log2f(psv[qi]) : 0.f;
        {
          const unsigned mb = __float_as_uint(dlt);
          auto sw = __builtin_amdgcn_permlane32_swap(mb, mb, false, false);
          dlt = fmaxf(__uint_as_float(sw[0]), __uint_as_float(sw[1]));
        }
        const float alpha = __builtin_amdgcn_exp2f(-dlt);
        m[qi] += dlt; lsum[qi] *= alpha;
#pragma unroll
        for (int e = 0; e < 16; ++e) { O[qi][0][e] *= alpha; O[qi][1][e] *= alpha; }
      }
    }
  };
  constexpr bool DEEP = !(NQ == 2 && DQK == 96);
  if (!DEEP) {
    gload(0, rkA0, rkA1, rvA); lstore(0, rkA0, rkA1, rvA);
    __syncthreads();
    for (int kt = 0; kt < nkt; ++kt) {
      if (kt + 1 < nkt) gload(kt + 1, rkA0, rkA1, rvA);
      compute(kt & 1, kt == 0);
      if (kt + 1 < nkt) lstore((kt + 1) & 1, rkA0, rkA1, rvA);
      __syncthreads();
    }
  } else {
  gload(0, rkA0, rkA1, rvA); lstore(0, rkA0, rkA1, rvA); gload(1, rkA0, rkA1, rvA);
  __syncthreads();
  for (int kt = 0; kt < nkt; kt += 2) {
    if (kt + 2 < nkt) gload(kt + 2, rkB0, rkB1, rvB);
    compute(0, kt == 0);
    lstore(1, rkA0, rkA1, rvA);
    __syncthreads();
    if (kt + 3 < nkt) gload(kt + 3, rkA0, rkA1, rvA);
    compute(1, false);
    if (kt + 2 < nkt) lstore(0, rkB0, rkB1, rvB);
    __syncthreads();
  }
  }
#pragma unroll
  for (int qi = 0; qi < NQ; ++qi) {
    const float inv = 1.f / (lsum[qi] + __shfl_xor(lsum[qi], 32));
    const int t = t0 + 32 * qi;
#pragma unroll
    for (int md = 0; md < 2; ++md)
#pragma unroll
      for (int g4 = 0; g4 < 4; ++g4) {
        const int dv0 = 32 * md + 8 * g4 + 4 * h;
        float o0 = O[qi][md][4 * g4] * inv, o1 = O[qi][md][4 * g4 + 1] * inv, o2 = O[qi][md][4 * g4 + 2] * inv, o3 = O[qi][md][4 * g4 + 3] * inv;
        if (DQK == 32) *(float4*)(p.ODIFF() + (size_t)t * 512 + hs * 64 + dv0) = make_float4(o0, o1, o2, o3);
        else *(uint2*)(p.CC() + (size_t)t * 1024 + 512 + (hs - 8) * 64 + dv0) = make_uint2(pk2(o0, o1), pk2(o2, o3));
      }
  }
}

#define XB_S5CTR(l) (3800 + 64 * (l))
DI void phase_d(const Params& p, int l, char* smem, int sub = 0) {
  constexpr int NAD = 2 * 8 * 16, NAC = 16 * 16, NS = 6144 / 8;
  if (sub != 2) {
    for (int it = blockIdx.x; it < NAD + NAC; it += gridDim.x) {
      if (it < NAD) {
        int hs = it & 15, qb = (it >> 4) & 7, b = it >> 7;
        if (hs < 8) attn_item<32, 2>(p, 16 + b, hs, qb, smem); else attn_item<96, 2>(p, 16 + b, hs, qb, smem);
      } else {
        int j = it - NAD, hs = j & 15, b = j >> 4;
        if (hs < 8) attn_item<32, 1>(p, b, hs, 0, smem); else attn_item<96, 1>(p, b, hs, 0, smem);
      }
    }
  }
  if (sub == 1) return;
  if (sub == 2) {
    for (int it = blockIdx.x; it < NS; it += gridDim.x) s5_pass3(p, l, it * 8 + (tidx() >> 6), smem + (tidx() >> 6) * 16896);
    return;
  }
  volatile unsigned* bw = (volatile unsigned*)(smem + 147456 - 16);
  unsigned* ctr = p.bar() + XB_S5CTR(l);
  for (;;) {
    __syncthreads();
    if (threadIdx.x == 0) *bw = xb_add(ctr, 1u);
    __syncthreads();
    const unsigned e = *bw;
    const unsigned nx = (l == 0) ? (unsigned)(NS + WJ_G + WJ_U) : (unsigned)NS;
    if (e >= nx) break;
    if (e >= (unsigned)NS) { weight_job(p, 0, WJ_EARLY + WJ_OUT + (int)(e - NS), (float*)smem); continue; }
    const int w = tidx() >> 6;
    s5_pass3(p, l, (int)e * 8 + w, smem + w * 16896);
  }
}

DI void phase_e(const Params& p, int l, char* smem) {
  constexpr int NG = 96, NR = TA / 8;
  for (int it = blockIdx.x; it < NG; it += gridDim.x) {
    {
      auto epi = [&](Acc128& acc, int r0, int c0, int fr, int fq) __attribute__((always_inline)) {
#pragma unroll
        for (int ai = 0; ai < 2; ++ai)
#pragma unroll
          for (int bj = 0; bj < 2; ++bj)
#pragma unroll
            for (int m = 0; m < 2; ++m) {
#pragma unroll
              for (int n = 0; n < 2; ++n)
#pragma unroll
                for (int j = 0; j < 4; ++j) {
                  const int row = r0 + ai * 64 + m * 16 + fq * 4 + j, col = c0 + bj * 128 + n * 16 + fr;
                  float y = bf2f(p.YG()[(size_t)row * 256 + col]);
                  p.CC()[(size_t)row * 1024 + 256 + col] = f2bf(y * sigmoidf(acc[ai][bj][m][n][j]));
                }
              SCHED;
            }
      };
      gemm256<2>(p.YG(), p.Wt_glu() + (size_t)l * 65536, 256, it * 128, 0, smem, epi);
    }
  }
  idle_block_jobs(NR, NG, [&](int e) __attribute__((always_inline)) {
    {
      const int lane = tidx() & 63, w = tidx() >> 6;
      const int t = e * 8 + w;
      float a1 = 0.f, a2 = 0.f;
      if (lane < 32) { a1 = p.lq1[l * 32 + lane] * p.lk1[l * 32 + lane]; a2 = p.lq2[l * 32 + lane] * p.lk2[l * 32 + lane]; }
      const float lam_init = 0.8f - 0.6f * expf(-0.3f * (float)l);
      const float lam = expf(wave_sum(a1)) - expf(wave_sum(a2)) + lam_init;
      const float gg = p.diff_g[l * 64 + lane] * (1.f - lam_init);
#pragma unroll
      for (int hd = 0; hd < 4; ++hd) {
        float o0 = p.ODIFF()[(size_t)t * 512 + (2 * hd) * 64 + lane], o1 = p.ODIFF()[(size_t)t * 512 + (2 * hd + 1) * 64 + lane];
        float o = o0 - lam * o1;
        float rs = rsqrtf(wave_sum(o * o) * (1.f / 64.f) + 1e-6f);
        p.CC()[(size_t)t * 1024 + hd * 64 + lane] = f2bf(o * rs * gg);
      }
    }
  });
}


#define XB_LNCNT(i) (3520 + (i))
template <int WHICH>
DI void epi_res_ln(const Params& p, const int l, Acc256& acc, int r0, int c0, int fr, int fq, char* smem, int pm, int pn) {
  const int tid = tidx(), wid = tid >> 6, wr = wid >> 2, wc = wid & 3;
  const int brow = pm * 256, cond = tok_cond(brow), slot = (l * 2 + (WHICH - 1)) * 48 + pm;
  const float* mb = p.mods() + (size_t)(l * 3 + cond) * 6144;
  {
    const float* xb = ((WHICH == 1 && l == 0) ? ((brow < TC) ? p.x_prompt + (size_t)brow * 1024 : p.x_sample + (size_t)(brow - TC) * 1024) : p.out + (size_t)brow * 1024) + c0;
    int rb1 = wr * 64 + fq * 4; asm volatile("" : "+v"(rb1));
    float gt[2][2];
#pragma unroll
    for (int bj = 0; bj < 2; ++bj)
#pragma unroll
      for (int n = 0; n < 2; ++n) gt[bj][n] = mb[(WHICH == 1 ? 2048 : 5120) + c0 + bj * 128 + n * 16 + fr];
#pragma unroll
    for (int ai = 0; ai < 2; ++ai)
#pragma unroll
      for (int m = 0; m < 4; ++m) {
        int zz = 0;
        { constexpr int PA = 0; const int pa = (ai * 4 + m + 6) / 4 % 2, pm4 = (ai * 4 + m + 6) % 4; (void)PA;
          const f32x4 d0 = acc[pa][0][pm4][0], d1 = acc[pa][0][pm4][1], d2 = acc[pa][1][pm4][0], d3 = acc[pa][1][pm4][1];
          asm volatile("" : "+v"(zz) : "v"(d0[0]), "v"(d0[1]), "v"(d0[2]), "v"(d0[3]), "v"(d1[0]), "v"(d1[1]), "v"(d1[2]), "v"(d1[3]),
                                       "v"(d2[0]), "v"(d2[1]), "v"(d2[2]), "v"(d2[3]), "v"(d3[0]), "v"(d3[1]), "v"(d3[2]), "v"(d3[3])); }
#pragma unroll
        for (int j = 0; j < 4; ++j) {
          const int rowl = rb1 + ai * 128 + m * 16 + j;
          const float* xr = xb + (rowl * 1024 + fr + zz);
#pragma unroll
          for (int bj = 0; bj < 2; ++bj)
#pragma unroll
            for (int n = 0; n < 2; ++n) acc[ai][bj][m][n][j] = ALPHA * xr[bj * 128 + n * 16] + gt[bj][n] * acc[ai][bj][m][n][j];
        }
        asm volatile("" ::: "memory"); SCHED;
      }
  }
  float* part = (float*)(smem + 98304);
  float* stat = part + 2048;
  int rb2 = wr * 64 + fq * 4; asm volatile("" : "+v"(rb2));
#pragma unroll
  for (int ai = 0; ai < 2; ++ai)
#pragma unroll
    for (int m = 0; m < 4; ++m)
#pragma unroll
      for (int j = 0; j < 4; ++j) {
        float s1 = 0.f, s2 = 0.f;
#pragma unroll
        for (int bj = 0; bj < 2; ++bj)
#pragma unroll
          for (int n = 0; n < 2; ++n) { const float v = acc[ai][bj][m][n][j]; s1 += v; s2 += v * v; }
        s1 = row16_sum(s1); s2 = row16_sum(s2);
        if (fr == 0) {
          const int rowl = rb2 + ai * 128 + m * 16 + j;
          part[(rowl * 4 + wc) * 2] = s1; part[(rowl * 4 + wc) * 2 + 1] = s2;
        }
      }
  __syncthreads();
  float2* xch = p.XCH() + (size_t)slot * 1024;
  if (tid < 256) {
    float a = 0.f, b = 0.f;
#pragma unroll
    for (int w4 = 0; w4 < 4; ++w4) { a += part[(tid * 4 + w4) * 2]; b += part[(tid * 4 + w4) * 2 + 1]; }
    xch[tid * 4 + pn] = make_float2(a, b);
  }
  asm volatile("s_waitcnt vmcnt(0)" ::: "memory");
  __syncthreads();
  if (tid == 0) {
    unsigned* cnt = p.bar() + XB_LNCNT(slot);
    __builtin_amdgcn_fence(__ATOMIC_RELEASE, "agent");
    asm volatile("s_waitcnt vmcnt(0)" ::: "memory");
    xb_add(cnt, 1u);
    unsigned sp = 0;
    while (xb_ld(cnt) < 4u) { __builtin_amdgcn_s_sleep(1); if (++sp > (1u << 22)) break; }
    __builtin_amdgcn_fence(__ATOMIC_ACQUIRE, "agent");
    asm volatile("s_waitcnt vmcnt(0)" ::: "memory");
  }
  __syncthreads();
  if (tid < 256) {
    float a = 0.f, b = 0.f;
#pragma unroll
    for (int t4 = 0; t4 < 4; ++t4) { const float2 q = xch[tid * 4 + t4]; a += q.x; b += q.y; }
    const float mean = a * (1.f / 1024.f);
    stat[tid * 2] = mean; stat[tid * 2 + 1] = rsqrtf(fmaxf(b * (1.f / 1024.f) - mean * mean, 0.f) + 1e-5f);
  }
  __syncthreads();
  const float* gp = (WHICH == 1 ? p.ln1g : p.ln2g) + l * 1024;
  const float* bp = (WHICH == 1 ? p.ln1b : p.ln2b) + l * 1024;
  const bool hasH = (WHICH == 1) || (l + 1 < 2);
  const float* mh = (WHICH == 1) ? mb : p.mods() + (size_t)((l + 1 < 2 ? l + 1 : l) * 3 + cond) * 6144;
  const int scc = (WHICH == 1) ? 4 : 1, shc = (WHICH == 1) ? 3 : 0;
  int rb4 = wr * 64 + fq * 4; asm volatile("" : "+v"(rb4));
  float gam[2][2], bet[2][2], sc1[2][2], sh1[2][2];
#pragma unroll
  for (int bj = 0; bj < 2; ++bj)
#pragma unroll
    for (int n = 0; n < 2; ++n) {
      const int col = c0 + bj * 128 + n * 16 + fr;
      gam[bj][n] = gp[col]; bet[bj][n] = bp[col];
      sc1[bj][n] = hasH ? 1.f + mh[scc * 1024 + col] : 0.f; sh1[bj][n] = hasH ? mh[shc * 1024 + col] : 0.f;
    }
#pragma unroll
  for (int ai = 0; ai < 2; ++ai)
#pragma unroll
    for (int m = 0; m < 4; ++m) {
#pragma unroll
      for (int j = 0; j < 4; ++j) {
        const int rowl = rb4 + ai * 128 + m * 16 + j, row = brow + rowl;
        const float mean = stat[rowl * 2], rs = stat[rowl * 2 + 1];
#pragma unroll
        for (int bj = 0; bj < 2; ++bj)
#pragma unroll
          for (int n = 0; n < 2; ++n) {
            const int col = c0 + bj * 128 + n * 16 + fr;
            const float x = (acc[ai][bj][m][n][j] - mean) * rs * gam[bj][n] + bet[bj][n];
            p.out[(size_t)row * 1024 + col] = x;
            if (hasH) p.H()[(size_t)row * 1024 + col] = f2bf(x * sc1[bj][n] + sh1[bj][n]);
          }
      }
      asm volatile("" ::: "memory"); SCHED;
    }
  __syncthreads();
}

DI void phase_f(const Params& p, int l, char* smem) {
  for (int it = blockIdx.x; it < 48 * 4; it += gridDim.x) {
    int pm, pn; tile_order(it, 48, 4, pm, pn);
    auto epi = [&](Acc256& acc, int r0, int c0, int fr, int fq) __attribute__((always_inline)) {
      if (l == 0) epi_res_ln<1>(p, 0, acc, r0, c0, fr, fq, smem, pm, pn); else epi_res_ln<1>(p, 1, acc, r0, c0, fr, fq, smem, pm, pn);
    };
    const float* xt = ((l == 0) ? ((pm * 256 < TC) ? p.x_prompt + (size_t)(pm * 256) * 1024 : p.x_sample + (size_t)(pm * 256 - TC) * 1024) : p.out + (size_t)(pm * 256) * 1024) + pn * 256;
    gemm256<4>(p.CC(), p.Wt_out() + (size_t)l * 1048576, 1024, pm * 256, pn * 256, smem, epi, false, false, 0, 0, xt);
  }
  if (l == 0)
    idle_block_jobs(WJ_D, 48 * 4, [&](int e) __attribute__((always_inline)) { weight_job(p, 0, WJ_EARLY + WJ_OUT + WJ_G + WJ_U + e, (float*)smem); });
}

template <int MT, class AccT>
DI void epi_swiglu(const Params& p, AccT& acc, int r0, int c0, int fr, int fq) {
#pragma unroll
  for (int ai = 0; ai < 2; ++ai)
#pragma unroll
    for (int bj = 0; bj < 2; ++bj) {
      const int unit = ((c0 + bj * 128) >> 5) * 16 + fr;
#pragma unroll
      for (int m = 0; m < MT; ++m)
#pragma unroll
        for (int j = 0; j < 4; ++j) {
          const int row = r0 + ai * (32 * MT) + m * 16 + fq * 4 + j;
          float g = acc[ai][bj][m][0][j], u = acc[ai][bj][m][1][j];
          p.ACT()[(size_t)row * 2816 + unit] = f2bf(g * sigmoidf(g) * u);
        }
    }
}
DI void phase_h(const Params& p, int l, char* smem) {
  constexpr int NFULL = 1024, NTOT = 48 * 22;
  bool pre = false;
  for (int it = blockIdx.x; it < NFULL + 2 * (NTOT - NFULL); it += gridDim.x) {
    if (it < NFULL) {
      int pm, pn, npm = 0, npn = 0; tile_order(it, 48, 22, pm, pn);
      const bool hn = (it + (int)gridDim.x) < NFULL; if (hn) tile_order(it + gridDim.x, 48, 22, npm, npn);
      auto epi = [&](Acc256& acc, int r0, int c0, int fr, int fq) __attribute__((always_inline)) { epi_swiglu<4>(p, acc, r0, c0, fr, fq); };
      gemm256<4>(p.H(), p.Wt_gu() + (size_t)l * 5767168, 1024, pm * 256, pn * 256, smem, epi, pre, hn, npm * 256, npn * 256); pre = hn;
    } else {
      const int hidx = it - NFULL;
      int pm, pn; tile_order(NFULL + (hidx >> 1), 48, 22, pm, pn);
      auto epi = [&](Acc128& acc, int r0, int c0, int fr, int fq) __attribute__((always_inline)) { epi_swiglu<2>(p, acc, r0, c0, fr, fq); };
      gemm256<2>(p.H(), p.Wt_gu() + (size_t)l * 5767168, 1024, pm * 256 + (hidx & 1) * 128, pn * 256, smem, epi);
    }
  }
}

DI void phase_i(const Params& p, int l, char* smem) {
  for (int it = blockIdx.x; it < 48 * 4; it += gridDim.x) {
    int pm, pn; tile_order(it, 48, 4, pm, pn);
    auto epi = [&](Acc256& acc, int r0, int c0, int fr, int fq) __attribute__((always_inline)) {
      if (l == 0) epi_res_ln<2>(p, 0, acc, r0, c0, fr, fq, smem, pm, pn); else epi_res_ln<2>(p, 1, acc, r0, c0, fr, fq, smem, pm, pn);
    };
    gemm256<4>(p.ACT(), p.Wt_dn() + (size_t)l * 2883584, 2816, pm * 256, pn * 256, smem, epi, false, false, 0, 0, p.out + (size_t)(pm * 256) * 1024 + pn * 256);
  }
  if (l == 0)
    idle_block_jobs(WJ_ALL, 48 * 4, [&](int e) __attribute__((always_inline)) { weight_job(p, 1, e, (float*)smem); });
}

#define GSYNC() xcd_barrier(xb)
DI void run_layer(const Params& p, const int l, char* smem, const XcdBarrier& xb, bool last) {
  phase_a(p, l, smem); GSYNC();
#if REP_K == 0
  phase_a(p, l, smem); GSYNC();
#endif
  phase_b(p, l, smem); GSYNC();
#if REP_K == 1
  phase_b(p, l, smem); GSYNC();
#endif
  phase_c(p, l, smem); GSYNC();
#if REP_K == 2
  phase_c(p, l, smem); GSYNC();
#endif
  phase_d(p, l, smem);
#if REP_K == 3
  GSYNC(); phase_d(p, l, smem, REP_SUB);
#endif
  GSYNC();
  phase_e(p, l, smem); GSYNC();
#if REP_K == 4
  phase_e(p, l, smem); GSYNC();
#endif
  phase_f(p, l, smem); GSYNC();
#if REP_K == 5
  if (l == 0) { phase_f(p, l, smem); GSYNC(); }
#endif
  phase_h(p, l, smem);
#if REP_K == 7
  GSYNC(); phase_h(p, l, smem);
#endif
  GSYNC();
  phase_i(p, l, smem);
  if (!last) GSYNC();
}

__global__ void __launch_bounds__(NT) __attribute__((target("no-packed-fp32-ops"))) mega(Params p) {
  extern __shared__ __attribute__((aligned(16))) char smem[];
  volatile LAS unsigned* xst = (volatile LAS unsigned*)(LAS char*)(smem + LDS_BYTES - 16);
  if (threadIdx.x == 0) { xst[0] = 0u; xst[1] = 0u; xst[2] = 0u; xst[3] = 0u; }
  __syncthreads();
  const XcdBarrier xb = xcd_barrier_post(p.bar(), xst);
  if (p.out == nullptr) cg::this_grid().sync();
  phase_pre1(p, smem); GSYNC();
#if REP_K == 10
  phase_pre1(p, smem); GSYNC();
#endif
  phase_pre2(p); GSYNC();
  run_layer(p, 0, smem, xb, false);
  run_layer(p, 1, smem, xb, true);
}

extern "C" void kernel_launch(void* const* d_in, const int* in_sizes, int n_in, void* d_out, int out_size, void* d_ws, size_t ws_size,
                              hipStream_t stream) {
  static int grid_blocks = 0;
  if (!grid_blocks) {
    int dev = 0, cus = 0, per_cu = 0;
    (void)hipGetDevice(&dev);
    (void)hipDeviceGetAttribute(&cus, hipDeviceAttributeMultiprocessorCount, dev);
    (void)hipFuncSetAttribute((const void*)mega, hipFuncAttributeMaxDynamicSharedMemorySize, LDS_BYTES);
    (void)hipOccupancyMaxActiveBlocksPerMultiprocessor(&per_cu, (const void*)mega, NT, LDS_BYTES);
    if (per_cu < 1) per_cu = 1;
    if (per_cu > 1) per_cu = 1;
    grid_blocks = cus * per_cu;
  }
  Params p{};
  const float** pin = (const float**)&p;
  for (int i = 0; i < 39; ++i) pin[i] = (const float*)d_in[i];
  p.out = (float*)d_out;
  p.ws = (char*)d_ws;
  if (WS_END > ws_size) { fprintf(stderr, "kernel_launch: workspace too small (%zu > %zu)\n", (size_t)WS_END, ws_size); return; }
  (void)hipMemsetAsync(p.ws + OFF_bar, 0, 16384, stream);
  void* args[] = {&p};
  hipError_t e = hipLaunchCooperativeKernel((const void*)mega, dim3(grid_blocks), dim3(NT), args, LDS_BYTES, stream);
  if (e != hipSuccess) fprintf(stderr, "cooperative launch failed: %s (grid %d)\n", hipGetErrorString(e), grid_blocks);
}
```

```cpp
#include <hip/hip_runtime.h>
#include <hip/hip_cooperative_groups.h>
#include <cstdio>
namespace cg = cooperative_groups;

#ifndef REP_K
#define REP_K -1
#endif
#ifndef REP_SUB
#define REP_SUB 0
#endif

typedef unsigned short u16;
typedef __bf16 bf2_t __attribute__((ext_vector_type(2)));
typedef float f2_t __attribute__((ext_vector_type(2)));
using bf16x8 = __attribute__((ext_vector_type(8))) short;
using f32x16 = __attribute__((ext_vector_type(16))) float;
using f32x4 = __attribute__((ext_vector_type(4))) float;
#define DI __device__ __forceinline__

DI unsigned pk2(float a, float b) { f2_t v = {a, b}; return __builtin_bit_cast(unsigned, __builtin_convertvector(v, bf2_t)); }
DI u16 f2bf(float a) { return (u16)(pk2(a, 0.f) & 0xffffu); }
DI float bf2f(u16 v) { return __uint_as_float(((unsigned)v) << 16); }
#define MFMA32(a, b, c) __builtin_amdgcn_mfma_f32_32x32x16_bf16((a), (b), (c), 0, 0, 0)
#define MFMA16(a, b, c) __builtin_amdgcn_mfma_f32_16x16x32_bf16((a), (b), (c), 0, 0, 0)

constexpr int TC = 4096, TD = 8192, TA = 12288, KA = 12800;
constexpr int NPH = 22;
constexpr int LDS_BYTES = 147456 + 16;
constexpr int NT = 512;
constexpr float ALPHA = 1.41421356237309515f;
constexpr float LOG2E = 1.44269504088896341f;
constexpr float QS_D = 0.17677669529663689f * LOG2E;
constexpr float QS_M = 0.10206207261596575f * LOG2E;
constexpr size_t O_DK = 12582912, O_DV = 14680064, O_CKV = 16777216, O_KR = 17825792, O_S5 = 18087936;

constexpr size_t al256(size_t x) { return (x + 255) & ~(size_t)255; }
constexpr size_t OFF_bar = 0;
constexpr size_t OFF_Wt_in = OFF_bar + al256(16384);
constexpr size_t OFF_Wt_out = OFF_Wt_in + al256(2ull*1572864*2);
constexpr size_t OFF_Wt_uq = OFF_Wt_out + al256(2ull*1048576*2);
constexpr size_t OFF_Wt_ukv = OFF_Wt_uq + al256(2ull*196608*2);
constexpr size_t OFF_Wt_glu = OFF_Wt_ukv + al256(2ull*262144*2);
constexpr size_t OFF_Wt_gu = OFF_Wt_glu + al256(2ull*65536*2);
constexpr size_t OFF_Wt_dn = OFF_Wt_gu + al256(2ull*5767168*2);
constexpr size_t OFF_mods = OFF_Wt_dn + al256(2ull*2883584*2);
constexpr size_t OFF_rope = OFF_mods + al256(2ull*3*6144*4);
constexpr size_t OFF_s5a = OFF_rope + al256(4096ull*16*8);
constexpr size_t OFF_s5bre = OFF_s5a + al256(4096ull*8);
constexpr size_t OFF_s5bim = OFF_s5bre + al256(4096ull*16*4);
constexpr size_t OFF_H = OFF_s5bim + al256(4096ull*16*4);
constexpr size_t OFF_CC = OFF_H + al256((size_t)TA*1024*2);
constexpr size_t OFF_Qd = OFF_CC + al256((size_t)TA*1024*2);
constexpr size_t OFF_Kd = OFF_Qd + al256((size_t)TA*256*2);
constexpr size_t OFF_VdT = OFF_Kd + al256((size_t)KA*256*2);
constexpr size_t OFF_QLN = OFF_VdT + al256((size_t)KA*256*2);
constexpr size_t OFF_CKV = OFF_QLN + al256((size_t)TA*256*2);
constexpr size_t OFF_KR = OFF_CKV + al256((size_t)KA*256*2);
constexpr size_t OFF_YG = OFF_KR + al256((size_t)KA*32*2);
constexpr size_t OFF_U = OFF_YG + al256((size_t)TA*256*2);
constexpr size_t OFF_QL = OFF_U + al256((size_t)TA*256*4);
constexpr size_t OFF_KVL = OFF_QL + al256((size_t)TA*256*4);
constexpr size_t OFF_FIN = OFF_KVL + al256((size_t)TA*128*4);
constexpr size_t OFF_CIN = OFF_FIN + al256(384ull*2*16*64*8);
constexpr size_t OFF_XCH = OFF_CIN + al256(384ull*2*16*64*8);
constexpr size_t OFF_Qm = OFF_XCH + al256(4ull*48*256*4*8);
constexpr size_t OFF_Km = OFF_Qm + al256((size_t)TA*768*2);
constexpr size_t OFF_VmT = OFF_Km + al256((size_t)KA*512*2);
constexpr size_t OFF_ODIFF = OFF_VmT + al256((size_t)KA*512*2);
constexpr size_t WS_END = OFF_ODIFF + al256((size_t)TA*512*4);
constexpr size_t OFF_ACT = OFF_Qm;
static_assert(OFF_ACT + (size_t)TA * 2816 * 2 <= WS_END, "ACT alias region too small");
static_assert(WS_END <= 268435456ull, "workspace exceeds 256 MiB");

struct Params {
  const float *x_prompt, *x_sample, *c, *cache_k, *cache_v, *cache_ckv, *cache_kr, *state_s5, *c_ctx;
  const float *w_ada, *b_ada, *w_in, *w_out, *lq1, *lk1, *lq2, *lk2, *diff_g;
  const float *s5_lre, *s5_lim, *s5_ldt, *s5_bre, *s5_bim, *s5_cre, *s5_cim, *s5_d, *w_glu;
  const float *q_g, *w_uq, *kv_g, *w_uk, *w_uv, *ln1g, *ln1b, *ln2g, *ln2b, *w_gate, *w_up, *w_down;
  float* out;
  char* ws;
  DI unsigned* bar() const { return (unsigned*)(ws + OFF_bar); }
  DI u16* Wt_in() const { return (u16*)(ws + OFF_Wt_in); }
  DI u16* Wt_out() const { return (u16*)(ws + OFF_Wt_out); }
  DI u16* Wt_uq() const { return (u16*)(ws + OFF_Wt_uq); }
  DI u16* Wt_ukv() const { return (u16*)(ws + OFF_Wt_ukv); }
  DI u16* Wt_glu() const { return (u16*)(ws + OFF_Wt_glu); }
  DI u16* Wt_gu() const { return (u16*)(ws + OFF_Wt_gu); }
  DI u16* Wt_dn() const { return (u16*)(ws + OFF_Wt_dn); }
  DI float* mods() const { return (float*)(ws + OFF_mods); }
  DI float2* rope() const { return (float2*)(ws + OFF_rope); }
  DI float2* s5a() const { return (float2*)(ws + OFF_s5a); }
  DI float* s5bre() const { return (float*)(ws + OFF_s5bre); }
  DI float* s5bim() const { return (float*)(ws + OFF_s5bim); }
  DI u16* H() const { return (u16*)(ws + OFF_H); }
  DI u16* CC() const { return (u16*)(ws + OFF_CC); }
  DI u16* Qd() const { return (u16*)(ws + OFF_Qd); }
  DI u16* Kd() const { return (u16*)(ws + OFF_Kd); }
  DI u16* VdT() const { return (u16*)(ws + OFF_VdT); }
  DI u16* QLN() const { return (u16*)(ws + OFF_QLN); }
  DI u16* CKV() const { return (u16*)(ws + OFF_CKV); }
  DI u16* KR() const { return (u16*)(ws + OFF_KR); }
  DI u16* YG() const { return (u16*)(ws + OFF_YG); }
  DI float* U() const { return (float*)(ws + OFF_U); }
  DI float* QL() const { return (float*)(ws + OFF_QL); }
  DI float* KVL() const { return (float*)(ws + OFF_KVL); }
  DI float2* FIN() const { return (float2*)(ws + OFF_FIN); }
  DI float2* CIN() const { return (float2*)(ws + OFF_CIN); }
  DI float2* XCH() const { return (float2*)(ws + OFF_XCH); }
  DI u16* Qm() const { return (u16*)(ws + OFF_Qm); }
  DI u16* Km() const { return (u16*)(ws + OFF_Km); }
  DI u16* VmT() const { return (u16*)(ws + OFF_VmT); }
  DI float* ODIFF() const { return (float*)(ws + OFF_ODIFF); }
  DI u16* ACT() const { return (u16*)(ws + OFF_ACT); }
};

DI int tidx() { int t = threadIdx.x; asm volatile("" : "+v"(t)); return t; }
DI int tok_cond(int t) { return t < TC ? 0 : 1 + ((t - TC) >> 12); }
DI int tok_pos(int t) { return t < TC ? (t & 255) : ((t - TC) & 4095); }
DI int tok_key(int t) { return t < TC ? t : TC + ((t - TC) >> 12) * 4352 + ((t - TC) & 4095); }
DI float wave_sum(float v) {
#pragma unroll
  for (int o = 32; o; o >>= 1) v += __shfl_xor(v, o);
  return v;
}
DI float row16_sum(float v) {
  v += __builtin_bit_cast(float, __builtin_amdgcn_update_dpp(0, __builtin_bit_cast(int, v), 0xB1, 0xF, 0xF, true));
  v += __builtin_bit_cast(float, __builtin_amdgcn_update_dpp(0, __builtin_bit_cast(int, v), 0x4E, 0xF, 0xF, true));
  v += __builtin_bit_cast(float, __builtin_amdgcn_update_dpp(0, __builtin_bit_cast(int, v), 0x141, 0xF, 0xF, true));
  v += __builtin_bit_cast(float, __builtin_amdgcn_update_dpp(0, __builtin_bit_cast(int, v), 0x140, 0xF, 0xF, true));
  return v;
}
DI int crow(int reg, int h) { return (reg & 3) + 8 * (reg >> 2) + 4 * h; }
DI void lds_fence() { asm volatile("s_waitcnt lgkmcnt(0)" ::: "memory"); }
DI float sigmoidf(float x) { return 1.f / (1.f + __expf(-x)); }

DI void sincos_d(double x, float& s, float& c) {
  const double TWO_PI = 6.283185307179586476925;
  double k = rint(x / TWO_PI);
  double r = x - k * TWO_PI;
  double r2 = r * r, ss = 1.0, cc = 1.0;
#pragma unroll
  for (int n = 13; n >= 1; --n) {
    ss = 1.0 - r2 * (1.0 / (double)((2 * n) * (2 * n + 1))) * ss;
    cc = 1.0 - r2 * (1.0 / (double)((2 * n - 1) * (2 * n))) * cc;
  }
  s = (float)(r * ss); c = (float)cc;
}

#define LAS __attribute__((address_space(3)))
DI int lds_byte(int r, int c) { int st = (r >> 4) * 2 + (c >> 5), rr = r & 15, cc = c & 31, ob = rr * 64 + cc * 2; return st * 1024 + (ob ^ (((ob >> 9) & 1) << 5)); }
DI void stage_rc(int b, int& R, int& C) { int st = b / 1024, sb = b % 1024, swz = sb ^ (((sb >> 9) & 1) << 5); R = (st >> 1) * 16 + swz / 64; C = (st & 1) * 32 + (swz % 64) / 2; }
DI void tile_order(int L, int nM, int nN, int& pm, int& pn) {
  const int nwg = nM * nN; int wgid = L;
  { const int q = nwg / 8, r = nwg % 8, xcd = wgid % 8, off = wgid / 8; wgid = (xcd < r ? xcd * (q + 1) : r * (q + 1) + (xcd - r) * q) + off; }
  const int nig = 8 * nN, gid = wgid / nig, fm = gid * 8, gsz = min(nM - fm, 8);
  pm = fm + ((wgid % nig) % gsz); pn = (wgid % nig) / gsz;
}
template <int MT, class Epi>
DI void gemm256(const u16* A, const u16* Bt, int Kc, int brow, int bcol, char* smem, Epi epi, bool prestaged = false, bool has_next = false, int nbrow = 0, int nbcol = 0,
                const float* pf_tile = nullptr) {
  constexpr int HTB = 16384;
  const int K = Kc;
  LAS char* lds = (LAS char*)smem;
  const int tid = tidx(), wid = tid >> 6, lane = tid & 63, wr = wid >> 2, wc = wid & 3, fr = lane & 15, fq = lane >> 4;
  unsigned voff[2];
#pragma unroll
  for (int i = 0; i < 2; ++i) { int R, C; stage_rc(tid * 16 + i * 8192, R, C); voff[i] = (unsigned)(R * K + C) * 2u; }
  const unsigned ldsw = (unsigned)wid * 1024u;
  const int aoff = lds_byte(wr * (16 * MT) + fr, fq * 8), boff = lds_byte(wc * 32 + fr, fq * 8);
  const char* Ab = (const char*)(A + (size_t)brow * K);
  const char* Bb = (const char*)(Bt + (size_t)bcol * K);
  const size_t hstepA = (size_t)(32 * MT) * K * 2, hstepB = (size_t)128 * K * 2;
#define G_SA(b, h) (((b) * 2 + (h)) * HTB)
#define G_SB(b, h) ((4 + (b) * 2 + (h)) * HTB)
#define G_STAGE_(bufoff, gbase, hh, kt, hs) do { const char* _g = (gbase) + (hh) * (hs) + (size_t)(kt) * 128; _Pragma("unroll") for (int _i = 0; _i < 2; ++_i) \
    __builtin_amdgcn_global_load_lds((const unsigned*)(_g + voff[_i]), (LAS unsigned*)(lds + (bufoff) + ldsw + _i * 8192), 16, 0, 0); } while (0)
#define G_LDA(dst, b, h) do { _Pragma("unroll") for (int m = 0; m < MT; ++m) _Pragma("unroll") for (int k = 0; k < 2; ++k) dst[m][k] = *(const LAS bf16x8*)(lds + G_SA(b, h) + aoff + m * 2048 + k * 1024); } while (0)
#define G_LDB(dst, b, h) do { _Pragma("unroll") for (int n = 0; n < 2; ++n) _Pragma("unroll") for (int k = 0; k < 2; ++k) dst[n][k] = *(const LAS bf16x8*)(lds + G_SB(b, h) + boff + n * 2048 + k * 1024); } while (0)
#define G_MMA(ai, bj, At, Bq) do { __builtin_amdgcn_s_setprio(1); _Pragma("unroll") for (int m = 0; m < MT; ++m) _Pragma("unroll") for (int n = 0; n < 2; ++n) _Pragma("unroll") for (int k = 0; k < 2; ++k) \
    acc[ai][bj][m][n] = MFMA16(At[m][k], Bq[n][k], acc[ai][bj][m][n]); __builtin_amdgcn_s_setprio(0); } while (0)
#define WAIT_V(n) asm volatile("s_waitcnt vmcnt(" #n ")" ::: "memory")
#define WAIT_L(n) asm volatile("s_waitcnt lgkmcnt(" #n ")" ::: "memory")
#define BAR __builtin_amdgcn_s_barrier()
#define SCHED __builtin_amdgcn_sched_barrier(0)
  f32x4 acc[2][2][MT][2];
#pragma unroll
  for (int a = 0; a < 2; ++a)
#pragma unroll
    for (int b = 0; b < 2; ++b)
#pragma unroll
      for (int m = 0; m < MT; ++m)
#pragma unroll
        for (int n = 0; n < 2; ++n) acc[a][b][m][n] = f32x4{0.f, 0.f, 0.f, 0.f};
  bf16x8 At[MT][2], B0[2][2], B1[2][2];
  const int nt = K / 64;
  if (!prestaged) {
    G_STAGE_(G_SB(0, 0), Bb, 0, 0, hstepB); G_STAGE_(G_SA(0, 0), Ab, 0, 0, hstepA);
    G_STAGE_(G_SB(0, 1), Bb, 1, 0, hstepB); G_STAGE_(G_SA(0, 1), Ab, 1, 0, hstepA);
  }
  if (wr == 1) BAR;
  WAIT_V(4); BAR;
  G_STAGE_(G_SB(1, 0), Bb, 0, 1, hstepB); G_STAGE_(G_SA(1, 0), Ab, 0, 1, hstepA); G_STAGE_(G_SB(1, 1), Bb, 1, 1, hstepB);
  WAIT_V(6); BAR;
  for (int t = 0; t < nt - 2; t += 2) {
    G_LDB(B0, 0, 0); SCHED; G_LDA(At, 0, 0); G_STAGE_(G_SA(1, 1), Ab, 1, t + 1, hstepA);
    if (MT == 4) WAIT_L(8); else WAIT_L(4); BAR; WAIT_L(0); G_MMA(0, 0, At, B0); BAR; SCHED;
    G_LDB(B1, 0, 1); G_STAGE_(G_SB(0, 0), Bb, 0, t + 2, hstepB);
    BAR; WAIT_L(0); G_MMA(0, 1, At, B1); BAR;
    G_LDA(At, 0, 1); G_STAGE_(G_SA(0, 0), Ab, 0, t + 2, hstepA);
    BAR; WAIT_L(0); G_MMA(1, 0, At, B0); BAR; SCHED;
    G_STAGE_(G_SB(0, 1), Bb, 1, t + 2, hstepB);
    WAIT_V(6); BAR; G_MMA(1, 1, At, B1); BAR;
    G_LDB(B0, 1, 0); SCHED; G_LDA(At, 1, 0); G_STAGE_(G_SA(0, 1), Ab, 1, t + 2, hstepA);
    if (MT == 4) WAIT_L(8); else WAIT_L(4); BAR; WAIT_L(0); G_MMA(0, 0, At, B0); BAR; SCHED;
    G_LDB(B1, 1, 1); G_STAGE_(G_SB(1, 0), Bb, 0, t + 3, hstepB);
    BAR; WAIT_L(0); G_MMA(0, 1, At, B1); BAR;
    G_LDA(At, 1, 1); G_STAGE_(G_SA(1, 0), Ab, 0, t + 3, hstepA);
    BAR; WAIT_L(0); G_MMA(1, 0, At, B0); BAR; SCHED;
    G_STAGE_(G_SB(1, 1), Bb, 1, t + 3, hstepB);
    WAIT_V(6); BAR; G_MMA(1, 1, At, B1); BAR;
  }
  { G_LDB(B0, 0, 0); G_LDA(At, 0, 0); G_STAGE_(G_SA(1, 1), Ab, 1, nt - 1, hstepA);
    if (pf_tile) {
#pragma unroll
      for (int i = 0; i < 4; ++i) {
        const int line = tid + 512 * i;
        __builtin_amdgcn_global_load_lds((const unsigned*)(pf_tile + (size_t)(line >> 3) * 1024 + (line & 7) * 32), (LAS unsigned*)(lds + 131072 + (i * 8 + wid) * 256), 4, 0, 0);
      }
    }
    BAR; WAIT_L(0); G_MMA(0, 0, At, B0); BAR;
    G_LDB(B1, 0, 1); BAR; WAIT_L(0); G_MMA(0, 1, At, B1); BAR;
    G_LDA(At, 0, 1); WAIT_V(4); BAR; WAIT_L(0); G_MMA(1, 0, At, B0); G_MMA(1, 1, At, B1); BAR; }
  { G_LDB(B0, 1, 0); G_LDA(At, 1, 0); WAIT_V(2); BAR; WAIT_L(0); G_MMA(0, 0, At, B0); BAR;
    G_LDB(B1, 1, 1); WAIT_V(0); BAR; WAIT_L(0); G_MMA(0, 1, At, B1); BAR;
    G_LDA(At, 1, 1); BAR; WAIT_L(0); G_MMA(1, 0, At, B0); G_MMA(1, 1, At, B1); BAR; }
  if (wr == 0) BAR;
  if (has_next) {
    const char* Ab2 = (const char*)(A + (size_t)nbrow * K); const char* Bb2 = (const char*)(Bt + (size_t)nbcol * K);
    G_STAGE_(G_SB(0, 0), Bb2, 0, 0, hstepB); G_STAGE_(G_SA(0, 0), Ab2, 0, 0, hstepA);
    G_STAGE_(G_SB(0, 1), Bb2, 1, 0, hstepB); G_STAGE_(G_SA(0, 1), Ab2, 1, 0, hstepA);
  }
  epi(acc, brow + wr * (16 * MT), bcol + wc * 32, fr, fq);
}

DI void transpose_strip(const float* src, int N, int k0, int n0, u16* dst, int ldd, int mode, int rowoff, float* tl) {
  const int tid = tidx(), c = tid & 63, r0 = tid >> 6;
  float v[4][8];
#pragma unroll
  for (int q = 0; q < 4; ++q)
#pragma unroll
    for (int i = 0; i < 8; ++i) {
      const int n = n0 + 64 * q + c;
      v[q][i] = (n < N) ? src[(size_t)(k0 + r0 + 8 * i) * N + n] : 0.f;
    }
#pragma unroll
  for (int q = 0; q < 4; ++q)
#pragma unroll
    for (int i = 0; i < 8; ++i) tl[q * 4160 + (r0 + 8 * i) * 65 + c] = v[q][i];
  __syncthreads();
  const int nl = tid >> 3, kq = tid & 7;
#pragma unroll
  for (int q = 0; q < 4; ++q) {
    const int n = n0 + 64 * q + nl;
    if (n < N) {
      int drow = (mode == 0) ? (n + rowoff) : ((n >> 4) * 32 + (n & 15) + (mode == 2 ? 16 : 0));
      unsigned pk[4];
#pragma unroll
      for (int j = 0; j < 4; ++j) pk[j] = pk2(tl[q * 4160 + (8 * kq + 2 * j) * 65 + nl], tl[q * 4160 + (8 * kq + 2 * j + 1) * 65 + nl]);
      *(uint4*)(dst + (size_t)drow * ldd + k0 + 8 * kq) = make_uint4(pk[0], pk[1], pk[2], pk[3]);
    }
  }
  __syncthreads();
}

constexpr int WJ_IN = 16 * 6, WJ_UQ = 4 * 3, WJ_UK = 2 * 2, WJ_UV = 2 * 2, WJ_GLU = 4 * 1, WJ_OUT = 16 * 4, WJ_G = 16 * 11, WJ_U = 16 * 11, WJ_D = 44 * 4;
constexpr int WJ_EARLY = WJ_IN + WJ_UQ + WJ_UK + WJ_UV + WJ_GLU, WJ_ALL = WJ_EARLY + WJ_OUT + WJ_G + WJ_U + WJ_D;
DI void weight_job(const Params& p, int l, int j, float* tl) {
  if (j < WJ_IN) { transpose_strip(p.w_in + (size_t)l * 1024 * 1440, 1440, (j % 16) * 64, (j / 16) * 256, p.Wt_in() + (size_t)l * 1572864, 1024, 0, 0, tl); return; }
  j -= WJ_IN;
  if (j < WJ_UQ) { transpose_strip(p.w_uq + (size_t)l * 196608, 768, (j % 4) * 64, (j / 4) * 256, p.Wt_uq() + (size_t)l * 196608, 256, 0, 0, tl); return; }
  j -= WJ_UQ;
  if (j < WJ_UK) { transpose_strip(p.w_uk + (size_t)l * 65536, 512, (j % 2) * 64, (j / 2) * 256, p.Wt_ukv() + (size_t)l * 262144, 256, 0, 0, tl); return; }
  j -= WJ_UK;
  if (j < WJ_UV) { transpose_strip(p.w_uv + (size_t)l * 65536, 512, (j % 2) * 64, (j / 2) * 256, p.Wt_ukv() + (size_t)l * 262144, 256, 0, 512, tl); return; }
  j -= WJ_UV;
  if (j < WJ_GLU) { transpose_strip(p.w_glu + (size_t)l * 65536, 256, (j % 4) * 64, (j / 4) * 256, p.Wt_glu() + (size_t)l * 65536, 256, 0, 0, tl); return; }
  j -= WJ_GLU;
  if (j < WJ_OUT) { transpose_strip(p.w_out + (size_t)l * 1048576, 1024, (j % 16) * 64, (j / 16) * 256, p.Wt_out() + (size_t)l * 1048576, 1024, 0, 0, tl); return; }
  j -= WJ_OUT;
  if (j < WJ_G) { transpose_strip(p.w_gate + (size_t)l * 2883584, 2816, (j % 16) * 64, (j / 16) * 256, p.Wt_gu() + (size_t)l * 5767168, 1024, 1, 0, tl); return; }
  j -= WJ_G;
  if (j < WJ_U) { transpose_strip(p.w_up + (size_t)l * 2883584, 2816, (j % 16) * 64, (j / 16) * 256, p.Wt_gu() + (size_t)l * 5767168, 1024, 2, 0, tl); return; }
  j -= WJ_U;
  transpose_strip(p.w_down + (size_t)l * 2883584, 1024, (j % 44) * 64, (j / 44) * 256, p.Wt_dn() + (size_t)l * 2883584, 2816, 0, 0, tl);
}
template <class F>
DI void idle_block_jobs(int n, int first_idle, F f) {
  const int G = gridDim.x, nidle = G - first_idle;
  if (nidle > 0) { if ((int)blockIdx.x >= first_idle) for (int e = blockIdx.x - first_idle; e < n; e += nidle) f(e); }
  else for (int e = blockIdx.x; e < n; e += G) f(e);
}

DI void phase_pre1(const Params& p, char* smem) {
  const int tid = tidx();
  float* tl = (float*)smem;
  constexpr int N_T = WJ_EARLY + WJ_OUT, N_MODS = 192, N_ROPE = 128, N_S5 = 8, N_ZP = 32;
  for (int it = blockIdx.x; it < N_T + N_MODS + N_ROPE + N_S5 + N_ZP; it += gridDim.x) {
    if (it >= N_T + N_MODS + N_ROPE + N_S5) {
      const int zj = it - (N_T + N_MODS + N_ROPE + N_S5);
#pragma unroll
      for (int i = 0; i < 2; ++i) { const int c = tid + NT * i, row = zj * 64 + (c >> 4), ch = c & 15; *(uint4*)(p.Wt_ukv() + (size_t)row * 256 + 128 + ch * 8) = make_uint4(0, 0, 0, 0); }
      continue;
    }
    if (it >= N_MODS && it < N_MODS + N_T) { weight_job(p, 0, it - N_MODS, tl); continue; }
    if (it < N_MODS) {
      const int j = it, l = j / 96, cg0 = (j % 96) * 64;
      float* sil = (float*)smem;
      float* red = sil + 3072;
      for (int i = tid; i < 3072; i += NT) {
        int ci = i >> 10, k = i & 1023;
        float cv = (ci == 0) ? p.c_ctx[k] : p.c[(ci - 1) * 1024 + k];
        sil[i] = cv * sigmoidf(cv);
      }
      __syncthreads();
      const int w = tid >> 6, lane = tid & 63, n = cg0 + lane;
      float a0 = 0.f, a1 = 0.f, a2 = 0.f;
      const float* wp = p.w_ada + (size_t)l * 1024 * 6144 + n;
#pragma unroll 32
      for (int k = w * 128; k < w * 128 + 128; ++k) {
        float wv = wp[(size_t)k * 6144];
        a0 += sil[k] * wv; a1 += sil[1024 + k] * wv; a2 += sil[2048 + k] * wv;
      }
      red[(w * 3 + 0) * 64 + lane] = a0; red[(w * 3 + 1) * 64 + lane] = a1; red[(w * 3 + 2) * 64 + lane] = a2;
      __syncthreads();
      if (tid < 192) {
        int ci = tid >> 6, ln = tid & 63;
        float sm = 0.f;
#pragma unroll
        for (int ww = 0; ww < 8; ++ww) sm += red[(ww * 3 + ci) * 64 + ln];
        p.mods()[(size_t)(l * 3 + ci) * 6144 + cg0 + ln] = sm + p.b_ada[l * 6144 + cg0 + ln];
      }
      __syncthreads();
      continue;
    }
    int j = it - N_MODS - N_T;
    if (j < N_ROPE) {
      int idx = j * NT + tid, pos = idx >> 4, i = idx & 15, f = i & 7;
      double v = 1.0;
      for (int q = 0; q < (f >> 1); ++q) v *= 0.1;
      if (f & 1) v *= 0.31622776601683794;
      float inv = (float)v;
      float ang = (float)((i < 8) ? (pos >> 6) : (pos & 63)) * inv;
      float sn, cs; sincos_d((double)ang, sn, cs);
      p.rope()[idx] = make_float2(cs, sn);
      continue;
    }
    j -= N_ROPE;
    {
      int e = j * NT + tid;
      float lre = p.s5_lre[e], lim = p.s5_lim[e], dt = expf(p.s5_ldt[e >> 6]);
      float mag = expf(lre * dt), ang = lim * dt, sn, cs;
      sincos_d((double)ang, sn, cs);
      float are = mag * cs, aim = mag * sn;
      float den = lre * lre + lim * lim, nre = are - 1.f, nim = aim;
      float fre = (nre * lre + nim * lim) / den, fim = (nim * lre - nre * lim) / den;
      p.s5a()[e] = make_float2(are, aim);
#pragma unroll
      for (int ch = 0; ch < 16; ++ch) {
        float br = p.s5_bre[(size_t)e * 16 + ch], bi = p.s5_bim[(size_t)e * 16 + ch];
        p.s5bre()[(size_t)e * 16 + ch] = fre * br - fim * bi;
        p.s5bim()[(size_t)e * 16 + ch] = fre * bi + fim * br;
      }
    }
  }
}

DI void store_h(const Params& p, int t, int lm, int scc, int shc, const float* v, int lane) {
  const float* mb = p.mods() + (size_t)(lm * 3 + tok_cond(t)) * 6144;
#pragma unroll
  for (int j = 0; j < 4; ++j) {
    int col = lane * 4 + 256 * j;
    float4 sc = *(const float4*)(mb + scc * 1024 + col), sh = *(const float4*)(mb + shc * 1024 + col);
    uint2 o;
    o.x = pk2(v[4 * j] * (1.f + sc.x) + sh.x, v[4 * j + 1] * (1.f + sc.y) + sh.y);
    o.y = pk2(v[4 * j + 2] * (1.f + sc.z) + sh.z, v[4 * j + 3] * (1.f + sc.w) + sh.w);
    *(uint2*)(p.H() + (size_t)t * 1024 + col) = o;
  }
}

DI void phase_pre2(const Params& p) {
  const int lane = tidx() & 63, w = tidx() >> 6;
  for (int it = blockIdx.x; it < TA / 8; it += gridDim.x) {
    int t = it * 8 + w;
    const float* xr = (t < TC) ? p.x_prompt + (size_t)t * 1024 : p.x_sample + (size_t)(t - TC) * 1024;
    float v[16];
#pragma unroll
    for (int j = 0; j < 4; ++j) { float4 x = *(const float4*)(xr + lane * 4 + 256 * j); v[4 * j] = x.x; v[4 * j + 1] = x.y; v[4 * j + 2] = x.z; v[4 * j + 3] = x.w; }
    store_h(p, t, 0, 1, 0, v, lane);
  }
}

DI void phase_ln(const Params& p, int l, int which) {
  const int lane = tidx() & 63, w = tidx() >> 6;
  const float* gp = (which == 1 ? p.ln1g : p.ln2g) + l * 1024;
  const float* bp = (which == 1 ? p.ln1b : p.ln2b) + l * 1024;
  for (int it = blockIdx.x; it < TA / 8; it += gridDim.x) {
    int t = it * 8 + w;
    float* xr = p.out + (size_t)t * 1024;
    float v[16]; float s = 0.f;
#pragma unroll
    for (int j = 0; j < 4; ++j) { float4 x = *(const float4*)(xr + lane * 4 + 256 * j); v[4 * j] = x.x; v[4 * j + 1] = x.y; v[4 * j + 2] = x.z; v[4 * j + 3] = x.w; s += x.x + x.y + x.z + x.w; }
    float mean = wave_sum(s) * (1.f / 1024.f);
    float q = 0.f;
#pragma unroll
    for (int i = 0; i < 16; ++i) { float d = v[i] - mean; q += d * d; }
    float rs = rsqrtf(wave_sum(q) * (1.f / 1024.f) + 1e-5f);
#pragma unroll
    for (int j = 0; j < 4; ++j) {
      int col = lane * 4 + 256 * j;
      float4 g = *(const float4*)(gp + col), b = *(const float4*)(bp + col);
      v[4 * j] = (v[4 * j] - mean) * rs * g.x + b.x; v[4 * j + 1] = (v[4 * j + 1] - mean) * rs * g.y + b.y;
      v[4 * j + 2] = (v[4 * j + 2] - mean) * rs * g.z + b.z; v[4 * j + 3] = (v[4 * j + 3] - mean) * rs * g.w + b.w;
      *(float4*)(xr + col) = make_float4(v[4 * j], v[4 * j + 1], v[4 * j + 2], v[4 * j + 3]);
    }
    if (which == 1) store_h(p, t, l, 4, 3, v, lane);
    else if (l + 1 < 2) store_h(p, t, l + 1, 1, 0, v, lane);
  }
}

typedef f32x4 Acc256[2][2][4][2];
typedef f32x4 Acc128[2][2][2][2];

#define XB_TMO      128
#define XB_XCNT(j)  (256  + 64 * (j))
#define XB_XSUB(j)  (1280 + 64 * (j))
#define XB_XGEN(j)  (2304 + 64 * (j))
#define XB_TOP      3328
#define XB_TOPGEN   3392
#define XCD_BAR_WORDS 3456
#define XB_SPIN_CAP (1u << 18)
DI unsigned xb_ld(unsigned* p) { return __hip_atomic_load(p, __ATOMIC_RELAXED, __HIP_MEMORY_SCOPE_AGENT); }
DI unsigned xb_add(unsigned* p, unsigned v) { return __hip_atomic_fetch_add(p, v, __ATOMIC_RELAXED, __HIP_MEMORY_SCOPE_AGENT); }
DI unsigned xb_xcc_id() { return (unsigned)__builtin_amdgcn_s_getreg((3 << 11) | 20) & 0xFu; }
#define XB_SPIN(cond, bar) do { unsigned _sp = 0; while (cond) { __builtin_amdgcn_s_sleep(1); \
    if ((++_sp & 255u) == 0u) { if (xb_ld(&(bar)[XB_TMO])) break; if (_sp > XB_SPIN_CAP) { atomicAdd(&(bar)[XB_TMO], 1u); break; } } } } while (0)
struct XcdBarrier { unsigned* bar; unsigned x; volatile LAS unsigned* st; };
DI XcdBarrier xcd_barrier_post(unsigned* bar, volatile LAS unsigned* st) {
  XcdBarrier b; b.bar = bar; b.x = xb_xcc_id(); b.st = st;
  if (threadIdx.x == 0) (void)xb_add(&bar[XB_XCNT(b.x)], 1u);
  return b;
}
DI void xcd_barrier_complete(unsigned* bar, unsigned x, unsigned& nloc, unsigned& nx) {
  const unsigned G = gridDim.x * gridDim.y * gridDim.z;
  unsigned sum, cnt, mine, sp = 0u;
  for (;;) {
    sum = 0u; cnt = 0u; mine = 0u;
#pragma unroll
    for (unsigned j = 0; j < 16; ++j) { const unsigned c = xb_ld(&bar[XB_XCNT(j)]); sum += c; cnt += (c > 0u) ? 1u : 0u; mine = (j == x) ? c : mine; }
    if (sum == G) break;
    __builtin_amdgcn_s_sleep(1);
    if ((++sp & 255u) == 0u) { if (xb_ld(&bar[XB_TMO])) break; if (sp > XB_SPIN_CAP) { atomicAdd(&bar[XB_TMO], 1u); break; } }
  }
  nloc = mine > 0u ? mine : 1u; nx = cnt > 0u ? cnt : 1u;
}
DI void xcd_barrier(const XcdBarrier& b) {
  asm volatile("s_waitcnt vmcnt(0)" ::: "memory");
  __syncthreads();
  if (threadIdx.x == 0) {
    unsigned* bar = b.bar;
    __builtin_amdgcn_s_waitcnt(0);
    unsigned nloc = b.st[0], nx = b.st[1];
    if (nloc == 0u) { xcd_barrier_complete(bar, b.x, nloc, nx); b.st[0] = nloc; b.st[1] = nx; }
    const unsigned old = xb_add(&bar[XB_XSUB(b.x)], 1u);
    const unsigned gen = old / nloc;
    if (old + 1u == (gen + 1u) * nloc) {
      __builtin_amdgcn_fence(__ATOMIC_RELEASE, "agent");
      asm volatile("s_waitcnt vmcnt(0)" ::: "memory");
      const unsigned og = xb_add(&bar[XB_TOP], 1u);
      const unsigned tg = og / nx;
      if (og + 1u == (tg + 1u) * nx) xb_add(&bar[XB_TOPGEN], 1u);
      else XB_SPIN(xb_ld(&bar[XB_TOPGEN]) == tg, bar);
      __builtin_amdgcn_fence(__ATOMIC_ACQUIRE, "agent");
      xb_add(&bar[XB_XGEN(b.x)], 1u);
      asm volatile("s_waitcnt vmcnt(0)" ::: "memory");
    } else {
      XB_SPIN(xb_ld(&bar[XB_XGEN(b.x)]) == gen, bar);
      __builtin_amdgcn_fence(__ATOMIC_ACQUIRE, "agent");
      asm volatile("s_waitcnt vmcnt(0)" ::: "memory");
    }
  }
  __syncthreads();
}

DI void phase_a(const Params& p, int l, char* smem) {
  constexpr int NG = 48 * 5;
  bool pre = false;
  for (int it = blockIdx.x; it < NG + 256 + 200; it += gridDim.x) {
    if (it >= NG + 256) {
      const int zj = it - NG - 256, tid = tidx();
#pragma unroll
      for (int i = 0; i < 2; ++i) { const int c = tid + NT * i, row = zj * 64 + (c >> 4), ch = c & 15; *(uint4*)(p.CKV() + (size_t)row * 256 + 128 + ch * 8) = make_uint4(0, 0, 0, 0); }
      continue;
    }
    if (it < NG) {
      int pm, pn, npm = 0, npn = 0; tile_order(it, 48, 5, pm, pn);
      const bool hn = (it + (int)gridDim.x) < NG; if (hn) tile_order(it + gridDim.x, 48, 5, npm, npn);
      auto epi = [&](Acc256& acc, int r0, int c0, int fr, int fq) __attribute__((always_inline)) {
#pragma unroll
        for (int ai = 0; ai < 2; ++ai)
#pragma unroll
          for (int bj = 0; bj < 2; ++bj) {
            const int colbase = c0 + bj * 128;
            if (colbase >= 1440) continue;
            const int cb = colbase >> 5;
#pragma unroll
            for (int m = 0; m < 4; ++m) {
              const int rowb = r0 + ai * 128 + m * 16 + fq * 4;
              const bool ctx = rowb < TC;
              const f32x4 a0 = acc[ai][bj][m][0], a1 = acc[ai][bj][m][1];
              if (cb < 16 || cb == 44) {
#pragma unroll
                for (int j = 0; j < 4; ++j) {
                  const int row = rowb + j;
                  float v0 = a0[j], v1 = a1[j];
                  const float raw0 = v0, raw1 = v1;
                  if (!ctx) {
                    float2 cs = p.rope()[tok_pos(row) * 16 + fr];
                    float t0 = v0 * cs.x - v1 * cs.y, t1 = v1 * cs.x + v0 * cs.y;
                    v0 = t0; v1 = t1;
                  }
                  if (cb < 8) {
                    u16* q = p.Qd() + (size_t)row * 256 + colbase + fr;
                    q[0] = f2bf(v0 * QS_D); q[16] = f2bf(v1 * QS_D);
                  } else if (cb < 16) {
                    const int cc = colbase - 256 + fr;
                    if (ctx) { float* o = p.out + O_DK + ((size_t)((row >> 8) * 2 + l) * 256 + (row & 255)) * 256 + cc; o[0] = raw0; o[16] = raw1; }
                    u16* k = p.Kd() + (size_t)tok_key(row) * 256 + cc;
                    k[0] = f2bf(v0); k[16] = f2bf(v1);
                  } else {
                    if (ctx) { float* o = p.out + O_KR + ((size_t)((row >> 8) * 2 + l) * 256 + (row & 255)) * 32 + fr; o[0] = raw0; o[16] = raw1; }
                    u16* k = p.KR() + (size_t)tok_key(row) * 32 + fr;
                    k[0] = f2bf(v0); k[16] = f2bf(v1);
                  }
                }
              } else if (cb < 24) {
                const int cc = colbase - 512 + fr;
                if (ctx) {
#pragma unroll
                  for (int j = 0; j < 4; ++j) {
                    float* o = p.out + O_DV + ((size_t)(((rowb + j) >> 8) * 2 + l) * 256 + ((rowb + j) & 255)) * 256 + cc;
                    o[0] = a0[j]; o[16] = a1[j];
                  }
                }
                const size_t key = tok_key(rowb);
                *(uint2*)(p.VdT() + (size_t)cc * KA + key) = make_uint2(pk2(a0[0], a0[1]), pk2(a0[2], a0[3]));
                *(uint2*)(p.VdT() + (size_t)(cc + 16) * KA + key) = make_uint2(pk2(a1[0], a1[1]), pk2(a1[2], a1[3]));
              } else {
                float* dst; int ld, c2;
                if (cb < 32) { dst = p.U(); ld = 256; c2 = colbase - 768 + fr; }
                else if (cb < 40) { dst = p.QL(); ld = 256; c2 = colbase - 1024 + fr; }
                else { dst = p.KVL(); ld = 128; c2 = colbase - 1280 + fr; }
#pragma unroll
                for (int j = 0; j < 4; ++j) { float* o = dst + (size_t)(rowb + j) * ld + c2; o[0] = a0[j]; o[16] = a1[j]; }
              }
              SCHED;
            }
          }
      };
      gemm256<4>(p.H(), p.Wt_in() + (size_t)l * 1572864, 1024, pm * 256, pn * 256, smem, epi, pre, hn, npm * 256, npn * 256); pre = hn;
    } else {
      const int tid = tidx();
      const int ci = (it - NG) * 2 + (tid >> 8), t8 = tid & 255, b = ci >> 8, j = ci & 255;
      const size_t key = TC + b * 4352 + 4096 + j;
      const size_t src = (size_t)((b * 2 + l) * 256 + j);
      p.Kd()[key * 256 + t8] = f2bf(p.cache_k[src * 256 + t8]);
      p.VdT()[(size_t)t8 * KA + key] = f2bf(p.cache_v[src * 256 + t8]);
      if (t8 < 128) p.CKV()[key * 256 + t8] = f2bf(p.cache_ckv[src * 128 + t8]);
      if (t8 < 32) p.KR()[key * 32 + t8] = f2bf(p.cache_kr[src * 32 + t8]);
    }
  }
}

DI void s5_bu_to_lds(const Params& p, int e0, int tok0, int g, char* img, int lane) {
  const int n = lane & 15, q4 = lane >> 4;
  bf16x8 af[2];
#pragma unroll
  for (int mt = 0; mt < 2; ++mt) {
    uint4 z = make_uint4(0, 0, 0, 0);
    if (q4 < 2) {
      const float* up = p.U() + (size_t)(tok0 + 16 * mt + n) * 256 + g * 16 + 8 * q4;
      float4 x = *(const float4*)up, y = *(const float4*)(up + 4);
      z = make_uint4(pk2(x.x, x.y), pk2(x.z, x.w), pk2(y.x, y.y), pk2(y.z, y.w));
    }
    af[mt] = __builtin_bit_cast(bf16x8, z);
  }
#pragma unroll
  for (int nt = 0; nt < 8; ++nt) {
    uint4 z = make_uint4(0, 0, 0, 0);
    if (q4 < 2) {
      const float* bp = ((nt < 4) ? p.s5bre() : p.s5bim()) + (size_t)(e0 + 16 * (nt & 3) + n) * 16 + 8 * q4;
      float4 x = *(const float4*)bp, y = *(const float4*)(bp + 4);
      z = make_uint4(pk2(x.x, x.y), pk2(x.z, x.w), pk2(y.x, y.y), pk2(y.z, y.w));
    }
    const bf16x8 bfr = __builtin_bit_cast(bf16x8, z);
#pragma unroll
    for (int mt = 0; mt < 2; ++mt) {
      f32x4 d = {0.f, 0.f, 0.f, 0.f};
      d = MFMA16(af[mt], bfr, d);
#pragma unroll
      for (int reg = 0; reg < 4; ++reg) *(float*)(img + (16 * mt + 4 * q4 + reg) * 528 + (16 * nt + n) * 4) = d[reg];
    }
  }
}

DI void s5_pass1(const Params& p, int l, int witem, char* img) {
  const int lane = tidx() & 63;
  int d, g, c, nch, qbase, cbase;
  if (witem < 8192) { c = witem & 127; g = (witem >> 7) & 15; d = (witem >> 11) & 1; int b = witem >> 12; nch = 128; qbase = TC + b * 4096; cbase = 128 + b * 128; }
  else { int x = witem - 8192; c = x & 7; g = (x >> 3) & 15; d = (x >> 7) & 1; int b = x >> 8; nch = 8; qbase = b * 256; cbase = b * 8; }
  const int e0 = ((l * 2 + d) * 16 + g) * 64;
  const int tok0 = qbase + (d ? (nch - 1 - c) : c) * 32;
  s5_bu_to_lds(p, e0, tok0, g, img, lane);
  lds_fence();
  const float2 a = p.s5a()[e0 + lane];
  float hr = 0.f, hi = 0.f;
#pragma unroll 4
  for (int j = 0; j < 32; ++j) {
    const int row = d ? (31 - j) : j;
    const float bur = *(const float*)(img + row * 528 + lane * 4), bui = *(const float*)(img + row * 528 + 256 + lane * 4);
    float nr = a.x * hr - a.y * hi + bur, ni = a.x * hi + a.y * hr + bui;
    hr = nr; hi = ni;
  }
  p.FIN()[(size_t)(((cbase + c) * 2 + d) * 16 + g) * 64 + lane] = make_float2(hr, hi);
  lds_fence();
}

DI void s5_carry(const Params& p, int l, int witem) {
  const int lane = tidx() & 63;
  int g, d, b, nch, cbase; bool isctx;
  if (witem < 64) { g = witem & 15; d = (witem >> 4) & 1; b = witem >> 5; nch = 128; cbase = 128 + b * 128; isctx = false; }
  else { int x = witem - 64; g = x & 15; d = (x >> 4) & 1; b = x >> 5; nch = 8; cbase = b * 8; isctx = true; }
  const int e = ((l * 2 + d) * 16 + g) * 64 + lane;
  const float2 a = p.s5a()[e];
  float tr = a.x, ti = a.y;
#pragma unroll
  for (int s = 0; s < 5; ++s) { float nr = tr * tr - ti * ti, ni = 2.f * tr * ti; tr = nr; ti = ni; }
  float hr = 0.f, hi = 0.f;
  if (!isctx) { const float* s = p.state_s5 + ((size_t)(((b * 2 + l) * 2 + d) * 16 + g) * 64 + lane) * 2; hr = s[0]; hi = s[1]; }
  const size_t base = (size_t)((cbase * 2 + d) * 16 + g) * 64 + lane;
  if (isctx) {
    float2 f[8];
#pragma unroll
    for (int i = 0; i < 8; ++i) f[i] = p.FIN()[base + (size_t)i * 2048];
#pragma unroll
    for (int i = 0; i < 8; ++i) {
      p.CIN()[base + (size_t)i * 2048] = make_float2(hr, hi);
      float nr = tr * hr - ti * hi + f[i].x, ni = tr * hi + ti * hr + f[i].y;
      hr = nr; hi = ni;
    }
  } else {
    for (int c = 0; c < 128; c += 32) {
      float2 f[32];
#pragma unroll
      for (int i = 0; i < 32; ++i) f[i] = p.FIN()[base + (size_t)(c + i) * 2048];
#pragma unroll
      for (int i = 0; i < 32; ++i) {
        p.CIN()[base + (size_t)(c + i) * 2048] = make_float2(hr, hi);
        float nr = tr * hr - ti * hi + f[i].x, ni = tr * hi + ti * hr + f[i].y;
        hr = nr; hi = ni;
      }
    }
  }
  if (isctx) {
    float* o = p.out + O_S5 + ((size_t)(((b * 2 + l) * 2 + d) * 16 + g) * 64 + lane) * 2;
    o[0] = hr; o[1] = hi;
  }
}

DI float gelu_tanh(float x) {
  float z = 0.7978845608028654f * (x + 0.044715f * x * x * x);
  float t = 1.f - 2.f / (1.f + __expf(2.f * z));
  return 0.5f * x * (1.f + t);
}

DI void s5_pass3(const Params& p, int l, int witem, char* img) {
  const int lane = tidx() & 63;
  int tc, g, b, nch, qbase, cbase;
  if (witem < 4096) { tc = witem & 127; g = (witem >> 7) & 15; b = witem >> 11; nch = 128; qbase = TC + b * 4096; cbase = 128 + b * 128; }
  else { int x = witem - 4096; tc = x & 7; g = (x >> 3) & 15; b = x >> 7; nch = 8; qbase = b * 256; cbase = b * 8; }
  const int tok0 = qbase + tc * 32;
  f32x4 acc0 = {0.f, 0.f, 0.f, 0.f}, acc1 = {0.f, 0.f, 0.f, 0.f};
  const int n = lane & 15, q4 = lane >> 4;
#pragma unroll 1
  for (int d = 0; d < 2; ++d) {
    const int pc = d ? (nch - 1 - tc) : tc;
    const int e0 = ((l * 2 + d) * 16 + g) * 64;
    s5_bu_to_lds(p, e0, tok0, g, img, lane);
    lds_fence();
    const float2 a = p.s5a()[e0 + lane];
    const float2 h0 = p.CIN()[(size_t)(((cbase + pc) * 2 + d) * 16 + g) * 64 + lane];
    float hr = h0.x, hi = h0.y;
#pragma unroll 4
    for (int j = 0; j < 32; ++j) {
      const int row = d ? (31 - j) : j;
      const float bur = *(const float*)(img + row * 528 + lane * 4), bui = *(const float*)(img + row * 528 + 256 + lane * 4);
      float nr = a.x * hr - a.y * hi + bur, ni = a.x * hi + a.y * hr + bui;
      hr = nr; hi = ni;
      *(u16*)(img + row * 528 + lane * 2) = f2bf(hr);
      *(u16*)(img + row * 528 + 128 + lane * 2) = f2bf(hi);
    }
    lds_fence();
#pragma unroll
    for (int s = 0; s < 4; ++s) {
      const float* cp = ((s < 2) ? p.s5_cre : p.s5_cim) + ((size_t)(((l * 2 + d) * 16 + g) * 16 + n)) * 64 + 32 * (s & 1) + 8 * q4;
      float4 c0 = *(const float4*)cp, c1 = *(const float4*)(cp + 4);
      const float sg = (s < 2) ? 1.f : -1.f;
      bf16x8 bfrag = __builtin_bit_cast(bf16x8, make_uint4(pk2(sg * c0.x, sg * c0.y), pk2(sg * c0.z, sg * c0.w), pk2(sg * c1.x, sg * c1.y), pk2(sg * c1.z, sg * c1.w)));
      bf16x8 a0 = *(const bf16x8*)(img + (n) * 528 + (32 * s + 8 * q4) * 2);
      bf16x8 a1 = *(const bf16x8*)(img + (16 + n) * 528 + (32 * s + 8 * q4) * 2);
      acc0 = MFMA16(a0, bfrag, acc0);
      acc1 = MFMA16(a1, bfrag, acc1);
    }
    lds_fence();
  }
  const float dsk = p.s5_d[(l * 16 + g) * 16 + n];
#pragma unroll
  for (int reg = 0; reg < 4; ++reg) {
    const int row0 = 4 * q4 + reg, row1 = 16 + 4 * q4 + reg;
    const float u0 = p.U()[(size_t)(tok0 + row0) * 256 + g * 16 + n], u1 = p.U()[(size_t)(tok0 + row1) * 256 + g * 16 + n];
    p.YG()[(size_t)(tok0 + row0) * 256 + g * 16 + n] = f2bf(gelu_tanh(u0 * dsk + acc0[reg]));
    p.YG()[(size_t)(tok0 + row1) * 256 + g * 16 + n] = f2bf(gelu_tanh(u1 * dsk + acc1[reg]));
  }
}

DI void phase_b(const Params& p, int l, char* smem) {
  for (int it = blockIdx.x; it < 96; it += gridDim.x) {
    const int pm = it;
    auto epi = [&](Acc128& acc, int r0, int c0, int fr, int fq) __attribute__((always_inline)) {
      const int tid = tidx(), wid = tid >> 6, wr = wid >> 2, wc = wid & 3, brow = pm * 128;
      const bool ctx = brow < TC;
      float* part = (float*)(smem + 98304);
      float* stat = part + 1024;
      int rb2 = wr * 32 + fq * 4; asm volatile("" : "+v"(rb2));
#pragma unroll
      for (int ai = 0; ai < 2; ++ai)
#pragma unroll
        for (int m = 0; m < 2; ++m)
#pragma unroll
          for (int j = 0; j < 4; ++j) {
            const float v0 = acc[ai][0][m][0][j], v1 = acc[ai][0][m][1][j];
            float s2 = v0 * v0 + v1 * v1;
            s2 = row16_sum(s2);
            if (fr == 0) part[(rb2 + ai * 64 + m * 16 + j) * 4 + wc] = s2;
          }
      __syncthreads();
      if (tid < 128) stat[tid] = rsqrtf((part[tid * 4] + part[tid * 4 + 1] + part[tid * 4 + 2] + part[tid * 4 + 3]) * (1.f / 128.f) + 1e-6f);
      __syncthreads();
      int rb4 = wr * 32 + fq * 4; asm volatile("" : "+v"(rb4));
      const int kc = wc * 32 + fr;
      const float g0 = p.kv_g[l * 128 + kc], g1 = p.kv_g[l * 128 + kc + 16];
#pragma unroll
      for (int ai = 0; ai < 2; ++ai)
#pragma unroll
        for (int m = 0; m < 2; ++m)
#pragma unroll
          for (int j = 0; j < 4; ++j) {
            const int rowl = rb4 + ai * 64 + m * 16 + j, row = brow + rowl;
            const float rs = stat[rowl];
            const float c0v = acc[ai][0][m][0][j] * rs * g0, c1v = acc[ai][0][m][1][j] * rs * g1;
            if (ctx) { float* o = p.out + O_CKV + ((size_t)((row >> 8) * 2 + l) * 256 + (row & 255)) * 128 + kc; o[0] = c0v; o[16] = c1v; }
            u16* ck = p.CKV() + (size_t)tok_key(row) * 256 + kc;
            ck[0] = f2bf(c0v); ck[16] = f2bf(c1v);
            if (wc == 0) {
              float v0 = acc[ai][1][m][0][j], v1 = acc[ai][1][m][1][j];
              if (ctx) { float* o = p.out + O_KR + ((size_t)((row >> 8) * 2 + l) * 256 + (row & 255)) * 32 + fr; o[0] = v0; o[16] = v1; }
              else {
                const float2 cs = p.rope()[tok_pos(row) * 16 + fr];
                const float t0 = v0 * cs.x - v1 * cs.y, t1 = v1 * cs.x + v0 * cs.y;
                v0 = t0; v1 = t1;
              }
              u16* k = p.KR() + (size_t)tok_key(row) * 32 + fr;
              k[0] = f2bf(v0); k[16] = f2bf(v1);
            }
          }
      __syncthreads();
    };
    gemm256<2>(p.H(), p.Wt_in() + (size_t)l * 1572864, 1024, pm * 128, 1280, smem, epi);
  }
  constexpr int NS = 12288 / 8, NR = TA / 8;
  idle_block_jobs(NS + NR, 96, [&](int e) __attribute__((always_inline)) {
    const int lane = tidx() & 63, w = tidx() >> 6;
    if (e < NS) { s5_pass1(p, l, e * 8 + w, smem + w * 16896); return; }
    const int t = (e - NS) * 8 + w;
    float4 x = *(const float4*)(p.QL() + (size_t)t * 256 + lane * 4);
    float rs = rsqrtf(wave_sum(x.x * x.x + x.y * x.y + x.z * x.z + x.w * x.w) * (1.f / 256.f) + 1e-6f);
    float4 g = *(const float4*)(p.q_g + l * 256 + lane * 4);
    uint2 o; o.x = pk2(x.x * rs * g.x, x.y * rs * g.y); o.y = pk2(x.z * rs * g.z, x.w * rs * g.w);
    *(uint2*)(p.QLN() + (size_t)t * 256 + lane * 4) = o;
  });
}

DI void phase_c(const Params& p, int l, char* smem) {
  constexpr int N3 = 50 * 4, N2 = 48 * 3, NCAR = 72;
  for (int it = blockIdx.x; it < N3 + N2 + NCAR; it += gridDim.x) {
    if (it >= N3 + N2) { s5_carry(p, l, (it - N3 - N2) * 8 + (tidx() >> 6)); continue; }
    if (it < N3) {
      int pm, pn; tile_order(it, 50, 4, pm, pn);
      auto epi = [&](Acc256& acc, int r0, int c0, int fr, int fq) __attribute__((always_inline)) {
#pragma unroll
        for (int ai = 0; ai < 2; ++ai)
#pragma unroll
          for (int bj = 0; bj < 2; ++bj) {
            const int colbase = c0 + bj * 128;
#pragma unroll
            for (int m = 0; m < 4; ++m) {
              const int rowb = r0 + ai * 128 + m * 16 + fq * 4;
#pragma unroll
              for (int n = 0; n < 2; ++n) {
                const int col = colbase + n * 16 + fr;
                const f32x4 a = acc[ai][bj][m][n];
                if (colbase < 512) {
#pragma unroll
                  for (int j = 0; j < 4; ++j) p.Km()[(size_t)(rowb + j) * 512 + col] = f2bf(a[j]);
                } else {
                  *(uint2*)(p.VmT() + (size_t)(col - 512) * KA + rowb) = make_uint2(pk2(a[0], a[1]), pk2(a[2], a[3]));
                }
              }
            }
          }
      };
      gemm256<4>(p.CKV(), p.Wt_ukv() + (size_t)l * 262144, 256, pm * 256, pn * 256, smem, epi);
    } else {
      const int j = it - N3;
      int pm, pn; tile_order(j, 48, 3, pm, pn);
      auto epi = [&](Acc256& acc, int r0, int c0, int fr, int fq) __attribute__((always_inline)) {
#pragma unroll
        for (int ai = 0; ai < 2; ++ai)
#pragma unroll
          for (int bj = 0; bj < 2; ++bj) {
            const int colbase = c0 + bj * 128;
            const bool ropecol = ((colbase >> 5) % 3 == 2);
#pragma unroll
            for (int m = 0; m < 4; ++m) {
              const int rowb = r0 + ai * 128 + m * 16 + fq * 4;
              const bool rp = ropecol && (rowb >= TC);
#pragma unroll
              for (int j2 = 0; j2 < 4; ++j2) {
                const int row = rowb + j2;
                float v0 = acc[ai][bj][m][0][j2], v1 = acc[ai][bj][m][1][j2];
                if (rp) {
                  float2 cs = p.rope()[tok_pos(row) * 16 + fr];
                  float t0 = v0 * cs.x - v1 * cs.y, t1 = v1 * cs.x + v0 * cs.y;
                  v0 = t0; v1 = t1;
                }
                u16* q = p.Qm() + (size_t)row * 768 + colbase + fr;
                q[0] = f2bf(v0 * QS_M); q[16] = f2bf(v1 * QS_M);
              }
            }
          }
      };
      gemm256<4>(p.QLN(), p.Wt_uq() + (size_t)l * 196608, 256, pm * 256, pn * 256, smem, epi);
    }
  }
}

template <int DQK, int NQ>
DI void attn_item(const Params& p, int seq, int hs, int qb, char* smem) {
  constexpr int KP = DQK * 2 + 16, KS = 64 * KP, VP = 136, VS = 64 * VP, STG = KS + VS;
  constexpr int NKC = DQK / 8, NKTOT = 64 * NKC, NKL = (NKTOT + NT - 1) / NT, NS = DQK / 16;
  const int tid = tidx(), lane = tid & 63, w = tid >> 6, r = lane & 31, h = lane >> 5;
  int qtok0, key0, Lk;
  if (seq < 16) { qtok0 = seq * 256; key0 = seq * 256; Lk = 256; }
  else { int b = seq - 16; qtok0 = TC + b * 4096; key0 = TC + b * 4352; Lk = 4352; }
  const u16 *qp, *k1, *vt; int qld, k1ld;
  if (DQK == 32) { int head = hs >> 1, c = hs & 1; qp = p.Qd() + head * 64 + c * 32; qld = 256; k1 = p.Kd() + head * 64 + c * 32; k1ld = 256; vt = p.VdT() + (size_t)(head * 64) * KA; }
  else { int hh = hs - 8; qp = p.Qm() + hh * 96; qld = 768; k1 = p.Km() + hh * 64; k1ld = 512; vt = p.VmT() + (size_t)(hh * 64) * KA; }
  const int t0 = qtok0 + qb * (256 * NQ) + w * (32 * NQ) + r;
  bf16x8 qf[NQ][NS];
#pragma unroll
  for (int qi = 0; qi < NQ; ++qi)
#pragma unroll
    for (int s = 0; s < NS; ++s) qf[qi][s] = *(const bf16x8*)(qp + (size_t)(t0 + 32 * qi) * qld + 16 * s + 8 * h);
  uint4 rkA0 = make_uint4(0, 0, 0, 0), rkA1 = make_uint4(0, 0, 0, 0), rvA, rkB0 = make_uint4(0, 0, 0, 0), rkB1 = make_uint4(0, 0, 0, 0), rvB;
  const int key_0 = tid / NKC, ch_0 = tid % NKC, key_1 = (tid + NT) / NKC, ch_1 = (tid + NT) % NKC;
  const bool has0 = tid < NKTOT, has1 = (tid + NT) < NKTOT;
  auto kload = [&](int kb, int key, int ch) __attribute__((always_inline)) {
    return (DQK == 32 || ch < 8) ? *(const uint4*)(k1 + (size_t)(kb + key) * k1ld + ch * 8) : *(const uint4*)(p.KR() + (size_t)(kb + key) * 32 + (ch - 8) * 8);
  };
  auto gload = [&](int kt, uint4& r0, uint4& r1, uint4& rv) __attribute__((always_inline)) {
    const int kb = key0 + kt * 64;
    if (has0) r0 = kload(kb, key_0, ch_0);
    if (NKL > 1) { if (has1) r1 = kload(kb, key_1, ch_1); }
    { int dv = tid >> 3, ch = tid & 7; rv = *(const uint4*)(vt + (size_t)dv * KA + kb + ch * 8); }
  };
  auto lstore = [&](int buf, const uint4& r0, const uint4& r1, const uint4& rv) __attribute__((always_inline)) {
    char* sk = smem + buf * STG; char* sv = sk + KS;
    if (has0) *(uint4*)(sk + key_0 * KP + ch_0 * 16) = r0;
    if (NKL > 1) { if (has1) *(uint4*)(sk + key_1 * KP + ch_1 * 16) = r1; }
    { int dv = tid >> 3, ch = tid & 7; uint2* d = (uint2*)(sv + dv * VP + ch * 16); d[0] = make_uint2(rv.x, rv.y); d[1] = make_uint2(rv.z, rv.w); }
  };
  f32x16 O[NQ][2];
  float m[NQ], lsum[NQ];
#pragma unroll
  for (int qi = 0; qi < NQ; ++qi) {
    m[qi] = 0.f; lsum[qi] = 0.f;
#pragma unroll
    for (int e = 0; e < 16; ++e) { O[qi][0][e] = 0.f; O[qi][1][e] = 0.f; }
  }
  const int nkt = Lk >> 6;
  auto compute = [&](int buf, bool first) __attribute__((always_inline)) {
    const char* sk = smem + buf * STG; const char* sv = sk + KS;
    f32x16 S[NQ][2];
#pragma unroll
    for (int st = 0; st < 2; ++st) {
#pragma unroll
      for (int qi = 0; qi < NQ; ++qi) {
        const float nm = -m[qi];
#pragma unroll
        for (int e = 0; e < 16; ++e) S[qi][st][e] = nm;
      }
#pragma unroll
      for (int s = 0; s < NS; ++s) {
        bf16x8 kf = *(const bf16x8*)(sk + (32 * st + r) * KP + (16 * s + 8 * h) * 2);
#pragma unroll
        for (int qi = 0; qi < NQ; ++qi) S[qi][st] = MFMA32(kf, qf[qi][s], S[qi][st]);
      }
    }
    float psv[NQ];
#pragma unroll
    for (int qi = 0; qi < NQ; ++qi) {
      if (first) {
        float mx = fmaxf(fmaxf(S[qi][0][0], S[qi][0][1]), fmaxf(S[qi][1][0], S[qi][1][1]));
#pragma unroll
        for (int e = 2; e < 16; e += 2) { mx = fmaxf(fmaxf(mx, S[qi][0][e]), S[qi][0][e + 1]); mx = fmaxf(fmaxf(mx, S[qi][1][e]), S[qi][1][e + 1]); }
        {
          const unsigned mb = __float_as_uint(mx);
          auto sw = __builtin_amdgcn_permlane32_swap(mb, mb, false, false);
          mx = fmaxf(__uint_as_float(sw[0]), __uint_as_float(sw[1]));
        }
        m[qi] += mx;
#pragma unroll
        for (int e = 0; e < 16; ++e) { S[qi][0][e] -= mx; S[qi][1][e] -= mx; }
      }
      float ps = 0.f;
#pragma unroll
      for (int st = 0; st < 2; ++st)
#pragma unroll
        for (int e = 0; e < 16; ++e) { const float pe = __builtin_amdgcn_exp2f(S[qi][st][e]); S[qi][st][e] = pe; ps += pe; }
      lsum[qi] += ps;
      psv[qi] = ps;
    }
#pragma unroll
    for (int st = 0; st < 2; ++st)
#pragma unroll
      for (int s2 = 0; s2 < 2; ++s2) {
        bf16x8 pf[NQ];
#pragma unroll
        for (int qi = 0; qi < NQ; ++qi) {
          uint4 pu = make_uint4(pk2(S[qi][st][8 * s2], S[qi][st][8 * s2 + 1]), pk2(S[qi][st][8 * s2 + 2], S[qi][st][8 * s2 + 3]),
                                pk2(S[qi][st][8 * s2 + 4], S[qi][st][8 * s2 + 5]), pk2(S[qi][st][8 * s2 + 6], S[qi][st][8 * s2 + 7]));
          pf[qi] = __builtin_bit_cast(bf16x8, pu);
        }
#pragma unroll
        for (int md = 0; md < 2; ++md) {
          const char* va = sv + (32 * md + r) * VP + (32 * st + 16 * s2 + 4 * h) * 2;
          uint2 lo = *(const uint2*)va, hi = *(const uint2*)(va + 16);
          bf16x8 vf = __builtin_bit_cast(bf16x8, make_uint4(lo.x, lo.y, hi.x, hi.y));
#pragma unroll
          for (int qi = 0; qi < NQ; ++qi) O[qi][md] = MFMA32(vf, pf[qi], O[qi][md]);
        }
      }
#pragma unroll
    for (int qi = 0; qi < NQ; ++qi) {
      if (__builtin_amdgcn_ballot_w64(psv[qi] > 1048576.f) != 0) {
        float dlt = (psv[qi] > 1048576.f) ? __log2f(psv[qi]) : 0.f;
        {
          const unsigned mb = __float_as_uint(dlt);
          auto sw = __builtin_amdgcn_permlane32_swap(mb, mb, false, false);
          dlt = fmaxf(__uint_as_float(sw[0]), __uint_as_float(sw[1]));
        }
        const float alpha = __builtin_amdgcn_exp2f(-dlt);
        m[qi] += dlt; lsum[qi] *= alpha;
#pragma unroll
        for (int e = 0; e < 16; ++e) { O[qi][0][e] *= alpha; O[qi][1][e] *= alpha; }
      }
    }
  };
  constexpr bool DEEP = !(NQ == 2 && DQK == 96);
  if (!DEEP) {
    gload(0, rkA0, rkA1, rvA); lstore(0, rkA0, rkA1, rvA);
    __syncthreads();
    for (int kt = 0; kt < nkt; ++kt) {
      if (kt + 1 < nkt) gload(kt + 1, rkA0, rkA1, rvA);
      compute(kt & 1, kt == 0);
      if (kt + 1 < nkt) lstore((kt + 1) & 1, rkA0, rkA1, rvA);
      __syncthreads();
    }
  } else {
  gload(0, rkA0, rkA1, rvA); lstore(0, rkA0, rkA1, rvA); gload(1, rkA0, rkA1, rvA);
  __syncthreads();
  for (int kt = 0; kt < nkt; kt += 2) {
    if (kt + 2 < nkt) gload(kt + 2, rkB0, rkB1, rvB);
    compute(0, kt == 0);
    lstore(1, rkA0, rkA1, rvA);
    __syncthreads();
    if (kt + 3 < nkt) gload(kt + 3, rkA0, rkA1, rvA);
    compute(1, false);
    if (kt + 2 < nkt) lstore(0, rkB0, rkB1, rvB);
    __syncthreads();
  }
  }
#pragma unroll
  for (int qi = 0; qi < NQ; ++qi) {
    const float inv = 1.f / (lsum[qi] + __shfl_xor(lsum[qi], 32));
    const int t = t0 + 32 * qi;
#pragma unroll
    for (int md = 0; md < 2; ++md)
#pragma unroll
      for (int g4 = 0; g4 < 4; ++g4) {
        const int dv0 = 32 * md + 8 * g4 + 4 * h;
        float o0 = O[qi][md][4 * g4] * inv, o1 = O[qi][md][4 * g4 + 1] * inv, o2 = O[qi][md][4 * g4 + 2] * inv, o3 = O[qi][md][4 * g4 + 3] * inv;
        if (DQK == 32) *(float4*)(p.ODIFF() + (size_t)t * 512 + hs * 64 + dv0) = make_float4(o0, o1, o2, o3);
        else *(uint2*)(p.CC() + (size_t)t * 1024 + 512 + (hs - 8) * 64 + dv0) = make_uint2(pk2(o0, o1), pk2(o2, o3));
      }
  }
}

#define XB_S5CTR(l) (3800 + 64 * (l))
DI void phase_d(const Params& p, int l, char* smem, int sub = 0) {
  constexpr int NAD = 2 * 8 * 16, NAC = 16 * 16, NS = 6144 / 8;
  if (sub != 2) {
    for (int it = blockIdx.x; it < NAD + NAC; it += gridDim.x) {
      if (it < NAD) {
        int hs = it & 15, qb = (it >> 4) & 7, b = it >> 7;
        if (hs < 8) attn_item<32, 2>(p, 16 + b, hs, qb, smem); else attn_item<96, 2>(p, 16 + b, hs, qb, smem);
      } else {
        int j = it - NAD, hs = j & 15, b = j >> 4;
        if (hs < 8) attn_item<32, 1>(p, b, hs, 0, smem); else attn_item<96, 1>(p, b, hs, 0, smem);
      }
    }
  }
  if (sub == 1) return;
  if (sub == 2) {
    for (int it = blockIdx.x; it < NS; it += gridDim.x) s5_pass3(p, l, it * 8 + (tidx() >> 6), smem + (tidx() >> 6) * 16896);
    return;
  }
  volatile unsigned* bw = (volatile unsigned*)(smem + 147456 - 16);
  unsigned* ctr = p.bar() + XB_S5CTR(l);
  for (;;) {
    __syncthreads();
    if (threadIdx.x == 0) *bw = xb_add(ctr, 1u);
    __syncthreads();
    const unsigned e = *bw;
    const unsigned nx = (l == 0) ? (unsigned)(NS + WJ_G + WJ_U) : (unsigned)NS;
    if (e >= nx) break;
    if (e >= (unsigned)NS) { weight_job(p, 0, WJ_EARLY + WJ_OUT + (int)(e - NS), (float*)smem); continue; }
    const int w = tidx() >> 6;
    s5_pass3(p, l, (int)e * 8 + w, smem + w * 16896);
  }
}

DI void phase_e(const Params& p, int l, char* smem) {
  constexpr int NG = 96, NR = TA / 8;
  for (int it = blockIdx.x; it < NG; it += gridDim.x) {
    {
      auto epi = [&](Acc128& acc, int r0, int c0, int fr, int fq) __attribute__((always_inline)) {
#pragma unroll
        for (int ai = 0; ai < 2; ++ai)
#pragma unroll
          for (int bj = 0; bj < 2; ++bj)
#pragma unroll
            for (int m = 0; m < 2; ++m) {
#pragma unroll
              for (int n = 0; n < 2; ++n)
#pragma unroll
                for (int j = 0; j < 4; ++j) {
                  const int row = r0 + ai * 64 + m * 16 + fq * 4 + j, col = c0 + bj * 128 + n * 16 + fr;
                  float y = bf2f(p.YG()[(size_t)row * 256 + col]);
                  p.CC()[(size_t)row * 1024 + 256 + col] = f2bf(y * sigmoidf(acc[ai][bj][m][n][j]));
                }
              SCHED;
            }
      };
      gemm256<2>(p.YG(), p.Wt_glu() + (size_t)l * 65536, 256, it * 128, 0, smem, epi);
    }
  }
  idle_block_jobs(NR, NG, [&](int e) __attribute__((always_inline)) {
    {
      const int lane = tidx() & 63, w = tidx() >> 6;
      const int t = e * 8 + w;
      float a1 = 0.f, a2 = 0.f;
      if (lane < 32) { a1 = p.lq1[l * 32 + lane] * p.lk1[l * 32 + lane]; a2 = p.lq2[l * 32 + lane] * p.lk2[l * 32 + lane]; }
      const float lam_init = 0.8f - 0.6f * expf(-0.3f * (float)l);
      const float lam = expf(wave_sum(a1)) - expf(wave_sum(a2)) + lam_init;
      const float gg = p.diff_g[l * 64 + lane] * (1.f - lam_init);
#pragma unroll
      for (int hd = 0; hd < 4; ++hd) {
        float o0 = p.ODIFF()[(size_t)t * 512 + (2 * hd) * 64 + lane], o1 = p.ODIFF()[(size_t)t * 512 + (2 * hd + 1) * 64 + lane];
        float o = o0 - lam * o1;
        float rs = rsqrtf(wave_sum(o * o) * (1.f / 64.f) + 1e-6f);
        p.CC()[(size_t)t * 1024 + hd * 64 + lane] = f2bf(o * rs * gg);
      }
    }
  });
}


#define XB_LNCNT(i) (3520 + (i))
template <int WHICH>
DI void epi_res_ln(const Params& p, const int l, Acc256& acc, int r0, int c0, int fr, int fq, char* smem, int pm, int pn) {
  const int tid = tidx(), wid = tid >> 6, wr = wid >> 2, wc = wid & 3;
  const int brow = pm * 256, cond = tok_cond(brow), slot = (l * 2 + (WHICH - 1)) * 48 + pm;
  const float* mb = p.mods() + (size_t)(l * 3 + cond) * 6144;
  {
    const float* xb = ((WHICH == 1 && l == 0) ? ((brow < TC) ? p.x_prompt + (size_t)brow * 1024 : p.x_sample + (size_t)(brow - TC) * 1024) : p.out + (size_t)brow * 1024) + c0;
    int rb1 = wr * 64 + fq * 4; asm volatile("" : "+v"(rb1));
    float gt[2][2];
#pragma unroll
    for (int bj = 0; bj < 2; ++bj)
#pragma unroll
      for (int n = 0; n < 2; ++n) gt[bj][n] = mb[(WHICH == 1 ? 2048 : 5120) + c0 + bj * 128 + n * 16 + fr];
#pragma unroll
    for (int ai = 0; ai < 2; ++ai)
#pragma unroll
      for (int m = 0; m < 4; ++m) {
        int zz = 0;
        { constexpr int PA = 0; const int pa = (ai * 4 + m + 4) / 4 % 2, pm4 = (ai * 4 + m + 4) % 4; (void)PA;
          const f32x4 d0 = acc[pa][0][pm4][0], d1 = acc[pa][0][pm4][1], d2 = acc[pa][1][pm4][0], d3 = acc[pa][1][pm4][1];
          asm volatile("" : "+v"(zz) : "v"(d0[0]), "v"(d0[1]), "v"(d0[2]), "v"(d0[3]), "v"(d1[0]), "v"(d1[1]), "v"(d1[2]), "v"(d1[3]),
                                       "v"(d2[0]), "v"(d2[1]), "v"(d2[2]), "v"(d2[3]), "v"(d3[0]), "v"(d3[1]), "v"(d3[2]), "v"(d3[3])); }
#pragma unroll
        for (int j = 0; j < 4; ++j) {
          const int rowl = rb1 + ai * 128 + m * 16 + j;
          const float* xr = xb + (rowl * 1024 + fr + zz);
#pragma unroll
          for (int bj = 0; bj < 2; ++bj)
#pragma unroll
            for (int n = 0; n < 2; ++n) acc[ai][bj][m][n][j] = ALPHA * xr[bj * 128 + n * 16] + gt[bj][n] * acc[ai][bj][m][n][j];
        }
        asm volatile("" ::: "memory"); SCHED;
      }
  }
  float* part = (float*)(smem + 98304);
  float* stat = part + 2048;
  int rb2 = wr * 64 + fq * 4; asm volatile("" : "+v"(rb2));
#pragma unroll
  for (int ai = 0; ai < 2; ++ai)
#pragma unroll
    for (int m = 0; m < 4; ++m)
#pragma unroll
      for (int j = 0; j < 4; ++j) {
        float s1 = 0.f, s2 = 0.f;
#pragma unroll
        for (int bj = 0; bj < 2; ++bj)
#pragma unroll
          for (int n = 0; n < 2; ++n) { const float v = acc[ai][bj][m][n][j]; s1 += v; s2 += v * v; }
        s1 = row16_sum(s1); s2 = row16_sum(s2);
        if (fr == 0) {
          const int rowl = rb2 + ai * 128 + m * 16 + j;
          part[(rowl * 4 + wc) * 2] = s1; part[(rowl * 4 + wc) * 2 + 1] = s2;
        }
      }
  __syncthreads();
  float2* xch = p.XCH() + (size_t)slot * 1024;
  if (tid < 256) {
    float a = 0.f, b = 0.f;
#pragma unroll
    for (int w4 = 0; w4 < 4; ++w4) { a += part[(tid * 4 + w4) * 2]; b += part[(tid * 4 + w4) * 2 + 1]; }
    xch[tid * 4 + pn] = make_float2(a, b);
  }
  asm volatile("s_waitcnt vmcnt(0)" ::: "memory");
  __syncthreads();
  if (tid == 0) {
    unsigned* cnt = p.bar() + XB_LNCNT(slot);
    __builtin_amdgcn_fence(__ATOMIC_RELEASE, "agent");
    asm volatile("s_waitcnt vmcnt(0)" ::: "memory");
    xb_add(cnt, 1u);
    unsigned sp = 0;
    while (xb_ld(cnt) < 4u) { __builtin_amdgcn_s_sleep(1); if (++sp > (1u << 22)) break; }
    __builtin_amdgcn_fence(__ATOMIC_ACQUIRE, "agent");
    asm volatile("s_waitcnt vmcnt(0)" ::: "memory");
  }
  __syncthreads();
  if (tid < 256) {
    float a = 0.f, b = 0.f;
#pragma unroll
    for (int t4 = 0; t4 < 4; ++t4) { const float2 q = xch[tid * 4 + t4]; a += q.x; b += q.y; }
    const float mean = a * (1.f / 1024.f);
    stat[tid * 2] = mean; stat[tid * 2 + 1] = rsqrtf(fmaxf(b * (1.f / 1024.f) - mean * mean, 0.f) + 1e-5f);
  }
  __syncthreads();
  const float* gp = (WHICH == 1 ? p.ln1g : p.ln2g) + l * 1024;
  const float* bp = (WHICH == 1 ? p.ln1b : p.ln2b) + l * 1024;
  const bool hasH = (WHICH == 1) || (l + 1 < 2);
  const float* mh = (WHICH == 1) ? mb : p.mods() + (size_t)((l + 1 < 2 ? l + 1 : l) * 3 + cond) * 6144;
  const int scc = (WHICH == 1) ? 4 : 1, shc = (WHICH == 1) ? 3 : 0;
  int rb4 = wr * 64 + fq * 4; asm volatile("" : "+v"(rb4));
  float gam[2][2], bet[2][2], sc1[2][2], sh1[2][2];
#pragma unroll
  for (int bj = 0; bj < 2; ++bj)
#pragma unroll
    for (int n = 0; n < 2; ++n) {
      const int col = c0 + bj * 128 + n * 16 + fr;
      gam[bj][n] = gp[col]; bet[bj][n] = bp[col];
      sc1[bj][n] = hasH ? 1.f + mh[scc * 1024 + col] : 0.f; sh1[bj][n] = hasH ? mh[shc * 1024 + col] : 0.f;
    }
#pragma unroll
  for (int ai = 0; ai < 2; ++ai)
#pragma unroll
    for (int m = 0; m < 4; ++m) {
#pragma unroll
      for (int j = 0; j < 4; ++j) {
        const int rowl = rb4 + ai * 128 + m * 16 + j, row = brow + rowl;
        const float mean = stat[rowl * 2], rs = stat[rowl * 2 + 1];
#pragma unroll
        for (int bj = 0; bj < 2; ++bj)
#pragma unroll
          for (int n = 0; n < 2; ++n) {
            const int col = c0 + bj * 128 + n * 16 + fr;
            const float x = (acc[ai][bj][m][n][j] - mean) * rs * gam[bj][n] + bet[bj][n];
            p.out[(size_t)row * 1024 + col] = x;
            if (hasH) p.H()[(size_t)row * 1024 + col] = f2bf(x * sc1[bj][n] + sh1[bj][n]);
          }
      }
      asm volatile("" ::: "memory"); SCHED;
    }
  __syncthreads();
}

DI void phase_f(const Params& p, int l, char* smem) {
  for (int it = blockIdx.x; it < 48 * 4; it += gridDim.x) {
    int pm, pn; tile_order(it, 48, 4, pm, pn);
    auto epi = [&](Acc256& acc, int r0, int c0, int fr, int fq) __attribute__((always_inline)) {
      if (l == 0) epi_res_ln<1>(p, 0, acc, r0, c0, fr, fq, smem, pm, pn); else epi_res_ln<1>(p, 1, acc, r0, c0, fr, fq, smem, pm, pn);
    };
    const float* xt = ((l == 0) ? ((pm * 256 < TC) ? p.x_prompt + (size_t)(pm * 256) * 1024 : p.x_sample + (size_t)(pm * 256 - TC) * 1024) : p.out + (size_t)(pm * 256) * 1024) + pn * 256;
    gemm256<4>(p.CC(), p.Wt_out() + (size_t)l * 1048576, 1024, pm * 256, pn * 256, smem, epi, false, false, 0, 0, xt);
  }
  if (l == 0)
    idle_block_jobs(WJ_D, 48 * 4, [&](int e) __attribute__((always_inline)) { weight_job(p, 0, WJ_EARLY + WJ_OUT + WJ_G + WJ_U + e, (float*)smem); });
}

template <int MT, class AccT>
DI void epi_swiglu(const Params& p, AccT& acc, int r0, int c0, int fr, int fq) {
#pragma unroll
  for (int ai = 0; ai < 2; ++ai)
#pragma unroll
    for (int bj = 0; bj < 2; ++bj) {
      const int unit = ((c0 + bj * 128) >> 5) * 16 + fr;
#pragma unroll
      for (int m = 0; m < MT; ++m)
#pragma unroll
        for (int j = 0; j < 4; ++j) {
          const int row = r0 + ai * (32 * MT) + m * 16 + fq * 4 + j;
          float g = acc[ai][bj][m][0][j], u = acc[ai][bj][m][1][j];
          p.ACT()[(size_t)row * 2816 + unit] = f2bf(g * sigmoidf(g) * u);
        }
    }
}
DI void phase_h(const Params& p, int l, char* smem) {
  constexpr int NFULL = 1024, NTOT = 48 * 22;
  bool pre = false;
  for (int it = blockIdx.x; it < NFULL + 2 * (NTOT - NFULL); it += gridDim.x) {
    if (it < NFULL) {
      int pm, pn, npm = 0, npn = 0; tile_order(it, 48, 22, pm, pn);
      const bool hn = (it + (int)gridDim.x) < NFULL; if (hn) tile_order(it + gridDim.x, 48, 22, npm, npn);
      auto epi = [&](Acc256& acc, int r0, int c0, int fr, int fq) __attribute__((always_inline)) { epi_swiglu<4>(p, acc, r0, c0, fr, fq); };
      gemm256<4>(p.H(), p.Wt_gu() + (size_t)l * 5767168, 1024, pm * 256, pn * 256, smem, epi, pre, hn, npm * 256, npn * 256); pre = hn;
    } else {
      const int hidx = it - NFULL;
      int pm, pn; tile_order(NFULL + (hidx >> 1), 48, 22, pm, pn);
      auto epi = [&](Acc128& acc, int r0, int c0, int fr, int fq) __attribute__((always_inline)) { epi_swiglu<2>(p, acc, r0, c0, fr, fq); };
      gemm256<2>(p.H(), p.Wt_gu() + (size_t)l * 5767168, 1024, pm * 256 + (hidx & 1) * 128, pn * 256, smem, epi);
    }
  }
}

DI void phase_i(const Params& p, int l, char* smem) {
  for (int it = blockIdx.x; it < 48 * 4; it += gridDim.x) {
    int pm, pn; tile_order(it, 48, 4, pm, pn);
    auto epi = [&](Acc256& acc, int r0, int c0, int fr, int fq) __attribute__((always_inline)) {
      if (l == 0) epi_res_ln<2>(p, 0, acc, r0, c0, fr, fq, smem, pm, pn); else epi_res_ln<2>(p, 1, acc, r0, c0, fr, fq, smem, pm, pn);
    };
    gemm256<4>(p.ACT(), p.Wt_dn() + (size_t)l * 2883584, 2816, pm * 256, pn * 256, smem, epi, false, false, 0, 0, p.out + (size_t)(pm * 256) * 1024 + pn * 256);
  }
  if (l == 0)
    idle_block_jobs(WJ_ALL, 48 * 4, [&](int e) __attribute__((always_inline)) { weight_job(p, 1, e, (float*)smem); });
}

#define GSYNC() xcd_barrier(xb)
DI void run_layer(const Params& p, const int l, char* smem, const XcdBarrier& xb, bool last) {
  phase_a(p, l, smem); GSYNC();
#if REP_K == 0
  phase_a(p, l, smem); GSYNC();
#endif
  phase_b(p, l, smem); GSYNC();
#if REP_K == 1
  phase_b(p, l, smem); GSYNC();
#endif
  phase_c(p, l, smem); GSYNC();
#if REP_K == 2
  phase_c(p, l, smem); GSYNC();
#endif
  phase_d(p, l, smem);
#if REP_K == 3
  GSYNC(); phase_d(p, l, smem, REP_SUB);
#endif
  GSYNC();
  phase_e(p, l, smem); GSYNC();
#if REP_K == 4
  phase_e(p, l, smem); GSYNC();
#endif
  phase_f(p, l, smem); GSYNC();
#if REP_K == 5
  if (l == 0) { phase_f(p, l, smem); GSYNC(); }
#endif
  phase_h(p, l, smem);
#if REP_K == 7
  GSYNC(); phase_h(p, l, smem);
#endif
  GSYNC();
  phase_i(p, l, smem);
  if (!last) GSYNC();
}

__global__ void __launch_bounds__(NT) __attribute__((target("no-packed-fp32-ops"))) mega(Params p) {
  extern __shared__ __attribute__((aligned(16))) char smem[];
  volatile LAS unsigned* xst = (volatile LAS unsigned*)(LAS char*)(smem + LDS_BYTES - 16);
  if (threadIdx.x == 0) { xst[0] = 0u; xst[1] = 0u; xst[2] = 0u; xst[3] = 0u; }
  __syncthreads();
  const XcdBarrier xb = xcd_barrier_post(p.bar(), xst);
  if (p.out == nullptr) cg::this_grid().sync();
  phase_pre1(p, smem); GSYNC();
#if REP_K == 10
  phase_pre1(p, smem); GSYNC();
#endif
  phase_pre2(p); GSYNC();
  run_layer(p, 0, smem, xb, false);
  run_layer(p, 1, smem, xb, true);
}

extern "C" void kernel_launch(void* const* d_in, const int* in_sizes, int n_in, void* d_out, int out_size, void* d_ws, size_t ws_size,
                              hipStream_t stream) {
  static int grid_blocks = 0;
  if (!grid_blocks) {
    int dev = 0, cus = 0, per_cu = 0;
    (void)hipGetDevice(&dev);
    (void)hipDeviceGetAttribute(&cus, hipDeviceAttributeMultiprocessorCount, dev);
    (void)hipFuncSetAttribute((const void*)mega, hipFuncAttributeMaxDynamicSharedMemorySize, LDS_BYTES);
    (void)hipOccupancyMaxActiveBlocksPerMultiprocessor(&per_cu, (const void*)mega, NT, LDS_BYTES);
    if (per_cu < 1) per_cu = 1;
    if (per_cu > 1) per_cu = 1;
    grid_blocks = cus * per_cu;
  }
  Params p{};
  const float** pin = (const float**)&p;
  for (int i = 0; i < 39; ++i) pin[i] = (const float*)d_in[i];
  p.out = (float*)d_out;
  p.ws = (char*)d_ws;
  if (WS_END > ws_size) { fprintf(stderr, "kernel_launch: workspace too small (%zu > %zu)\n", (size_t)WS_END, ws_size); return; }
  (void)hipMemsetAsync(p.ws + OFF_bar, 0, 16384, stream);
  void* args[] = {&p};
  hipError_t e = hipLaunchCooperativeKernel((const void*)mega, dim3(grid_blocks), dim3(NT), args, LDS_BYTES, stream);
  if (e != hipSuccess) fprintf(stderr, "cooperative launch failed: %s (grid %d)\n", hipGetErrorString(e), grid_blocks);
}
```

```cpp
#include <hip/hip_runtime.h>
#include <hip/hip_cooperative_groups.h>
#include <cstdio>
namespace cg = cooperative_groups;

#ifndef REP_K
#define REP_K -1
#endif
#ifndef REP_SUB
#define REP_SUB 0
#endif

typedef unsigned short u16;
typedef __bf16 bf2_t __attribute__((ext_vector_type(2)));
typedef float f2_t __attribute__((ext_vector_type(2)));
using bf16x8 = __attribute__((ext_vector_type(8))) short;
using f32x16 = __attribute__((ext_vector_type(16))) float;
using f32x4 = __attribute__((ext_vector_type(4))) float;
#define DI __device__ __forceinline__

DI unsigned pk2(float a, float b) { f2_t v = {a, b}; return __builtin_bit_cast(unsigned, __builtin_convertvector(v, bf2_t)); }
DI u16 f2bf(float a) { return (u16)(pk2(a, 0.f) & 0xffffu); }
DI float bf2f(u16 v) { return __uint_as_float(((unsigned)v) << 16); }
#define MFMA32(a, b, c) __builtin_amdgcn_mfma_f32_32x32x16_bf16((a), (b), (c), 0, 0, 0)
#define MFMA16(a, b, c) __builtin_amdgcn_mfma_f32_16x16x32_bf16((a), (b), (c), 0, 0, 0)

constexpr int TC = 4096, TD = 8192, TA = 12288, KA = 12800;
constexpr int NPH = 22;
constexpr int LDS_BYTES = 147456 + 16;
constexpr int NT = 512;
constexpr float ALPHA = 1.41421356237309515f;
constexpr float LOG2E = 1.44269504088896341f;
constexpr float QS_D = 0.17677669529663689f * LOG2E;
constexpr float QS_M = 0.10206207261596575f * LOG2E;
constexpr size_t O_DK = 12582912, O_DV = 14680064, O_CKV = 16777216, O_KR = 17825792, O_S5 = 18087936;

constexpr size_t al256(size_t x) { return (x + 255) & ~(size_t)255; }
constexpr size_t OFF_bar = 0;
constexpr size_t OFF_Wt_in = OFF_bar + al256(16384);
constexpr size_t OFF_Wt_out = OFF_Wt_in + al256(2ull*1572864*2);
constexpr size_t OFF_Wt_uq = OFF_Wt_out + al256(2ull*1048576*2);
constexpr size_t OFF_Wt_ukv = OFF_Wt_uq + al256(2ull*196608*2);
constexpr size_t OFF_Wt_glu = OFF_Wt_ukv + al256(2ull*262144*2);
constexpr size_t OFF_Wt_gu = OFF_Wt_glu + al256(2ull*65536*2);
constexpr size_t OFF_Wt_dn = OFF_Wt_gu + al256(2ull*5767168*2);
constexpr size_t OFF_mods = OFF_Wt_dn + al256(2ull*2883584*2);
constexpr size_t OFF_rope = OFF_mods + al256(2ull*3*6144*4);
constexpr size_t OFF_s5a = OFF_rope + al256(4096ull*16*8);
constexpr size_t OFF_s5bre = OFF_s5a + al256(4096ull*8);
constexpr size_t OFF_s5bim = OFF_s5bre + al256(4096ull*16*4);
constexpr size_t OFF_H = OFF_s5bim + al256(4096ull*16*4);
constexpr size_t OFF_CC = OFF_H + al256((size_t)TA*1024*2);
constexpr size_t OFF_Qd = OFF_CC + al256((size_t)TA*1024*2);
constexpr size_t OFF_Kd = OFF_Qd + al256((size_t)TA*256*2);
constexpr size_t OFF_VdT = OFF_Kd + al256((size_t)KA*256*2);
constexpr size_t OFF_QLN = OFF_VdT + al256((size_t)KA*256*2);
constexpr size_t OFF_CKV = OFF_QLN + al256((size_t)TA*256*2);
constexpr size_t OFF_KR = OFF_CKV + al256((size_t)KA*256*2);
constexpr size_t OFF_YG = OFF_KR + al256((size_t)KA*32*2);
constexpr size_t OFF_U = OFF_YG + al256((size_t)TA*256*2);
constexpr size_t OFF_QL = OFF_U + al256((size_t)TA*256*4);
constexpr size_t OFF_KVL = OFF_QL + al256((size_t)TA*256*4);
constexpr size_t OFF_FIN = OFF_KVL + al256((size_t)TA*128*4);
constexpr size_t OFF_CIN = OFF_FIN + al256(384ull*2*16*64*8);
constexpr size_t OFF_XCH = OFF_CIN + al256(384ull*2*16*64*8);
constexpr size_t OFF_Qm = OFF_XCH + al256(4ull*48*256*4*8);
constexpr size_t OFF_Km = OFF_Qm + al256((size_t)TA*768*2);
constexpr size_t OFF_VmT = OFF_Km + al256((size_t)KA*512*2);
constexpr size_t OFF_ODIFF = OFF_VmT + al256((size_t)KA*512*2);
constexpr size_t WS_END = OFF_ODIFF + al256((size_t)TA*512*4);
constexpr size_t OFF_ACT = OFF_Qm;
static_assert(OFF_ACT + (size_t)TA * 2816 * 2 <= WS_END, "ACT alias region too small");
static_assert(WS_END <= 268435456ull, "workspace exceeds 256 MiB");

struct Params {
  const float *x_prompt, *x_sample, *c, *cache_k, *cache_v, *cache_ckv, *cache_kr, *state_s5, *c_ctx;
  const float *w_ada, *b_ada, *w_in, *w_out, *lq1, *lk1, *lq2, *lk2, *diff_g;
  const float *s5_lre, *s5_lim, *s5_ldt, *s5_bre, *s5_bim, *s5_cre, *s5_cim, *s5_d, *w_glu;
  const float *q_g, *w_uq, *kv_g, *w_uk, *w_uv, *ln1g, *ln1b, *ln2g, *ln2b, *w_gate, *w_up, *w_down;
  float* out;
  char* ws;
  DI unsigned* bar() const { return (unsigned*)(ws + OFF_bar); }
  DI u16* Wt_in() const { return (u16*)(ws + OFF_Wt_in); }
  DI u16* Wt_out() const { return (u16*)(ws + OFF_Wt_out); }
  DI u16* Wt_uq() const { return (u16*)(ws + OFF_Wt_uq); }
  DI u16* Wt_ukv() const { return (u16*)(ws + OFF_Wt_ukv); }
  DI u16* Wt_glu() const { return (u16*)(ws + OFF_Wt_glu); }
  DI u16* Wt_gu() const { return (u16*)(ws + OFF_Wt_gu); }
  DI u16* Wt_dn() const { return (u16*)(ws + OFF_Wt_dn); }
  DI float* mods() const { return (float*)(ws + OFF_mods); }
  DI float2* rope() const { return (float2*)(ws + OFF_rope); }
  DI float2* s5a() const { return (float2*)(ws + OFF_s5a); }
  DI float* s5bre() const { return (float*)(ws + OFF_s5bre); }
  DI float* s5bim() const { return (float*)(ws + OFF_s5bim); }
  DI u16* H() const { return (u16*)(ws + OFF_H); }
  DI u16* CC() const { return (u16*)(ws + OFF_CC); }
  DI u16* Qd() const { return (u16*)(ws + OFF_Qd); }
  DI u16* Kd() const { return (u16*)(ws + OFF_Kd); }
  DI u16* VdT() const { return (u16*)(ws + OFF_VdT); }
  DI u16* QLN() const { return (u16*)(ws + OFF_QLN); }
  DI u16* CKV() const { return (u16*)(ws + OFF_CKV); }
  DI u16* KR() const { return (u16*)(ws + OFF_KR); }
  DI u16* YG() const { return (u16*)(ws + OFF_YG); }
  DI float* U() const { return (float*)(ws + OFF_U); }
  DI float* QL() const { return (float*)(ws + OFF_QL); }
  DI float* KVL() const { return (float*)(ws + OFF_KVL); }
  DI float2* FIN() const { return (float2*)(ws + OFF_FIN); }
  DI float2* CIN() const { return (float2*)(ws + OFF_CIN); }
  DI float2* XCH() const { return (float2*)(ws + OFF_XCH); }
  DI u16* Qm() const { return (u16*)(ws + OFF_Qm); }
  DI u16* Km() const { return (u16*)(ws + OFF_Km); }
  DI u16* VmT() const { return (u16*)(ws + OFF_VmT); }
  DI float* ODIFF() const { return (float*)(ws + OFF_ODIFF); }
  DI u16* ACT() const { return (u16*)(ws + OFF_ACT); }
};

DI int tidx() { int t = threadIdx.x; asm volatile("" : "+v"(t)); return t; }
DI int tok_cond(int t) { return t < TC ? 0 : 1 + ((t - TC) >> 12); }
DI int tok_pos(int t) { return t < TC ? (t & 255) : ((t - TC) & 4095); }
DI int tok_key(int t) { return t < TC ? t : TC + ((t - TC) >> 12) * 4352 + ((t - TC) & 4095); }
DI float wave_sum(float v) {
#pragma unroll
  for (int o = 32; o; o >>= 1) v += __shfl_xor(v, o);
  return v;
}
DI float row16_sum(float v) {
  v += __builtin_bit_cast(float, __builtin_amdgcn_update_dpp(0, __builtin_bit_cast(int, v), 0xB1, 0xF, 0xF, true));
  v += __builtin_bit_cast(float, __builtin_amdgcn_update_dpp(0, __builtin_bit_cast(int, v), 0x4E, 0xF, 0xF, true));
  v += __builtin_bit_cast(float, __builtin_amdgcn_update_dpp(0, __builtin_bit_cast(int, v), 0x141, 0xF, 0xF, true));
  v += __builtin_bit_cast(float, __builtin_amdgcn_update_dpp(0, __builtin_bit_cast(int, v), 0x140, 0xF, 0xF, true));
  return v;
}
DI int crow(int reg, int h) { return (reg & 3) + 8 * (reg >> 2) + 4 * h; }
DI void lds_fence() { asm volatile("s_waitcnt lgkmcnt(0)" ::: "memory"); }
DI float sigmoidf(float x) { return 1.f / (1.f + __expf(-x)); }

DI void sincos_d(double x, float& s, float& c) {
  const double TWO_PI = 6.283185307179586476925;
  double k = rint(x / TWO_PI);
  double r = x - k * TWO_PI;
  double r2 = r * r, ss = 1.0, cc = 1.0;
#pragma unroll
  for (int n = 13; n >= 1; --n) {
    ss = 1.0 - r2 * (1.0 / (double)((2 * n) * (2 * n + 1))) * ss;
    cc = 1.0 - r2 * (1.0 / (double)((2 * n - 1) * (2 * n))) * cc;
  }
  s = (float)(r * ss); c = (float)cc;
}

#define LAS __attribute__((address_space(3)))
DI int lds_byte(int r, int c) { int st = (r >> 4) * 2 + (c >> 5), rr = r & 15, cc = c & 31, ob = rr * 64 + cc * 2; return st * 1024 + (ob ^ (((ob >> 9) & 1) << 5)); }
DI void stage_rc(int b, int& R, int& C) { int st = b / 1024, sb = b % 1024, swz = sb ^ (((sb >> 9) & 1) << 5); R = (st >> 1) * 16 + swz / 64; C = (st & 1) * 32 + (swz % 64) / 2; }
DI void tile_order(int L, int nM, int nN, int& pm, int& pn) {
  const int nwg = nM * nN; int wgid = L;
  { const int q = nwg / 8, r = nwg % 8, xcd = wgid % 8, off = wgid / 8; wgid = (xcd < r ? xcd * (q + 1) : r * (q + 1) + (xcd - r) * q) + off; }
  const int nig = 8 * nN, gid = wgid / nig, fm = gid * 8, gsz = min(nM - fm, 8);
  pm = fm + ((wgid % nig) % gsz); pn = (wgid % nig) / gsz;
}
template <int MT, class Epi>
DI void gemm256(const u16* A, const u16* Bt, int Kc, int brow, int bcol, char* smem, Epi epi, bool prestaged = false, bool has_next = false, int nbrow = 0, int nbcol = 0,
                const float* pf_tile = nullptr) {
  constexpr int HTB = 16384;
  const int K = Kc;
  LAS char* lds = (LAS char*)smem;
  const int tid = tidx(), wid = tid >> 6, lane = tid & 63, wr = wid >> 2, wc = wid & 3, fr = lane & 15, fq = lane >> 4;
  unsigned voff[2];
#pragma unroll
  for (int i = 0; i < 2; ++i) { int R, C; stage_rc(tid * 16 + i * 8192, R, C); voff[i] = (unsigned)(R * K + C) * 2u; }
  const unsigned ldsw = (unsigned)wid * 1024u;
  const int aoff = lds_byte(wr * (16 * MT) + fr, fq * 8), boff = lds_byte(wc * 32 + fr, fq * 8);
  const char* Ab = (const char*)(A + (size_t)brow * K);
  const char* Bb = (const char*)(Bt + (size_t)bcol * K);
  const size_t hstepA = (size_t)(32 * MT) * K * 2, hstepB = (size_t)128 * K * 2;
#define G_SA(b, h) (((b) * 2 + (h)) * HTB)
#define G_SB(b, h) ((4 + (b) * 2 + (h)) * HTB)
#define G_STAGE_(bufoff, gbase, hh, kt, hs) do { const char* _g = (gbase) + (hh) * (hs) + (size_t)(kt) * 128; _Pragma("unroll") for (int _i = 0; _i < 2; ++_i) \
    __builtin_amdgcn_global_load_lds((const unsigned*)(_g + voff[_i]), (LAS unsigned*)(lds + (bufoff) + ldsw + _i * 8192), 16, 0, 0); } while (0)
#define G_LDA(dst, b, h) do { _Pragma("unroll") for (int m = 0; m < MT; ++m) _Pragma("unroll") for (int k = 0; k < 2; ++k) dst[m][k] = *(const LAS bf16x8*)(lds + G_SA(b, h) + aoff + m * 2048 + k * 1024); } while (0)
#define G_LDB(dst, b, h) do { _Pragma("unroll") for (int n = 0; n < 2; ++n) _Pragma("unroll") for (int k = 0; k < 2; ++k) dst[n][k] = *(const LAS bf16x8*)(lds + G_SB(b, h) + boff + n * 2048 + k * 1024); } while (0)
#define G_MMA(ai, bj, At, Bq) do { __builtin_amdgcn_s_setprio(1); _Pragma("unroll") for (int m = 0; m < MT; ++m) _Pragma("unroll") for (int n = 0; n < 2; ++n) _Pragma("unroll") for (int k = 0; k < 2; ++k) \
    acc[ai][bj][m][n] = MFMA16(At[m][k], Bq[n][k], acc[ai][bj][m][n]); __builtin_amdgcn_s_setprio(0); } while (0)
#define WAIT_V(n) asm volatile("s_waitcnt vmcnt(" #n ")" ::: "memory")
#define WAIT_L(n) asm volatile("s_waitcnt lgkmcnt(" #n ")" ::: "memory")
#define BAR __builtin_amdgcn_s_barrier()
#define SCHED __builtin_amdgcn_sched_barrier(0)
  f32x4 acc[2][2][MT][2];
#pragma unroll
  for (int a = 0; a < 2; ++a)
#pragma unroll
    for (int b = 0; b < 2; ++b)
#pragma unroll
      for (int m = 0; m < MT; ++m)
#pragma unroll
        for (int n = 0; n < 2; ++n) acc[a][b][m][n] = f32x4{0.f, 0.f, 0.f, 0.f};
  bf16x8 At[MT][2], B0[2][2], B1[2][2];
  const int nt = K / 64;
  if (!prestaged) {
    G_STAGE_(G_SB(0, 0), Bb, 0, 0, hstepB); G_STAGE_(G_SA(0, 0), Ab, 0, 0, hstepA);
    G_STAGE_(G_SB(0, 1), Bb, 1, 0, hstepB); G_STAGE_(G_SA(0, 1), Ab, 1, 0, hstepA);
  }
  if (wr == 1) BAR;
  WAIT_V(4); BAR;
  G_STAGE_(G_SB(1, 0), Bb, 0, 1, hstepB); G_STAGE_(G_SA(1, 0), Ab, 0, 1, hstepA); G_STAGE_(G_SB(1, 1), Bb, 1, 1, hstepB);
  WAIT_V(6); BAR;
  for (int t = 0; t < nt - 2; t += 2) {
    G_LDB(B0, 0, 0); SCHED; G_LDA(At, 0, 0); G_STAGE_(G_SA(1, 1), Ab, 1, t + 1, hstepA);
    if (MT == 4) WAIT_L(8); else WAIT_L(4); BAR; WAIT_L(0); G_MMA(0, 0, At, B0); BAR; SCHED;
    G_LDB(B1, 0, 1); G_STAGE_(G_SB(0, 0), Bb, 0, t + 2, hstepB);
    BAR; WAIT_L(0); G_MMA(0, 1, At, B1); BAR;
    G_LDA(At, 0, 1); G_STAGE_(G_SA(0, 0), Ab, 0, t + 2, hstepA);
    BAR; WAIT_L(0); G_MMA(1, 0, At, B0); BAR; SCHED;
    G_STAGE_(G_SB(0, 1), Bb, 1, t + 2, hstepB);
    WAIT_V(6); BAR; G_MMA(1, 1, At, B1); BAR;
    G_LDB(B0, 1, 0); SCHED; G_LDA(At, 1, 0); G_STAGE_(G_SA(0, 1), Ab, 1, t + 2, hstepA);
    if (MT == 4) WAIT_L(8); else WAIT_L(4); BAR; WAIT_L(0); G_MMA(0, 0, At, B0); BAR; SCHED;
    G_LDB(B1, 1, 1); G_STAGE_(G_SB(1, 0), Bb, 0, t + 3, hstepB);
    BAR; WAIT_L(0); G_MMA(0, 1, At, B1); BAR;
    G_LDA(At, 1, 1); G_STAGE_(G_SA(1, 0), Ab, 0, t + 3, hstepA);
    BAR; WAIT_L(0); G_MMA(1, 0, At, B0); BAR; SCHED;
    G_STAGE_(G_SB(1, 1), Bb, 1, t + 3, hstepB);
    WAIT_V(6); BAR; G_MMA(1, 1, At, B1); BAR;
  }
  { G_LDB(B0, 0, 0); G_LDA(At, 0, 0); G_STAGE_(G_SA(1, 1), Ab, 1, nt - 1, hstepA);
    if (pf_tile) {
#pragma unroll
      for (int i = 0; i < 4; ++i) {
        const int line = tid + 512 * i;
        __builtin_amdgcn_global_load_lds((const unsigned*)(pf_tile + (size_t)(line >> 3) * 1024 + (line & 7) * 32), (LAS unsigned*)(lds + 131072 + (i * 8 + wid) * 256), 4, 0, 0);
      }
    }
    BAR; WAIT_L(0); G_MMA(0, 0, At, B0); BAR;
    G_LDB(B1, 0, 1); BAR; WAIT_L(0); G_MMA(0, 1, At, B1); BAR;
    G_LDA(At, 0, 1); WAIT_V(4); BAR; WAIT_L(0); G_MMA(1, 0, At, B0); G_MMA(1, 1, At, B1); BAR; }
  { G_LDB(B0, 1, 0); G_LDA(At, 1, 0); WAIT_V(2); BAR; WAIT_L(0); G_MMA(0, 0, At, B0); BAR;
    G_LDB(B1, 1, 1); WAIT_V(0); BAR; WAIT_L(0); G_MMA(0, 1, At, B1); BAR;
    G_LDA(At, 1, 1); BAR; WAIT_L(0); G_MMA(1, 0, At, B0); G_MMA(1, 1, At, B1); BAR; }
  if (wr == 0) BAR;
  if (has_next) {
    const char* Ab2 = (const char*)(A + (size_t)nbrow * K); const char* Bb2 = (const char*)(Bt + (size_t)nbcol * K);
    G_STAGE_(G_SB(0, 0), Bb2, 0, 0, hstepB); G_STAGE_(G_SA(0, 0), Ab2, 0, 0, hstepA);
    G_STAGE_(G_SB(0, 1), Bb2, 1, 0, hstepB); G_STAGE_(G_SA(0, 1), Ab2, 1, 0, hstepA);
  }
  epi(acc, brow + wr * (16 * MT), bcol + wc * 32, fr, fq);
}

DI void transpose_strip(const float* src, int N, int k0, int n0, u16* dst, int ldd, int mode, int rowoff, float* tl) {
  const int tid = tidx(), c = tid & 63, r0 = tid >> 6;
  float v[4][8];
#pragma unroll
  for (int q = 0; q < 4; ++q)
#pragma unroll
    for (int i = 0; i < 8; ++i) {
      const int n = n0 + 64 * q + c;
      v[q][i] = (n < N) ? __builtin_nontemporal_load(src + (size_t)(k0 + r0 + 8 * i) * N + n) : 0.f;
    }
#pragma unroll
  for (int q = 0; q < 4; ++q)
#pragma unroll
    for (int i = 0; i < 8; ++i) tl[q * 4160 + (r0 + 8 * i) * 65 + c] = v[q][i];
  __syncthreads();
  const int nl = tid >> 3, kq = tid & 7;
#pragma unroll
  for (int q = 0; q < 4; ++q) {
    const int n = n0 + 64 * q + nl;
    if (n < N) {
      int drow = (mode == 0) ? (n + rowoff) : ((n >> 4) * 32 + (n & 15) + (mode == 2 ? 16 : 0));
      unsigned pk[4];
#pragma unroll
      for (int j = 0; j < 4; ++j) pk[j] = pk2(tl[q * 4160 + (8 * kq + 2 * j) * 65 + nl], tl[q * 4160 + (8 * kq + 2 * j + 1) * 65 + nl]);
      *(uint4*)(dst + (size_t)drow * ldd + k0 + 8 * kq) = make_uint4(pk[0], pk[1], pk[2], pk[3]);
    }
  }
  __syncthreads();
}

constexpr int WJ_IN = 16 * 6, WJ_UQ = 4 * 3, WJ_UK = 2 * 2, WJ_UV = 2 * 2, WJ_GLU = 4 * 1, WJ_OUT = 16 * 4, WJ_G = 16 * 11, WJ_U = 16 * 11, WJ_D = 44 * 4;
constexpr int WJ_EARLY = WJ_IN + WJ_UQ + WJ_UK + WJ_UV + WJ_GLU, WJ_ALL = WJ_EARLY + WJ_OUT + WJ_G + WJ_U + WJ_D;
DI void weight_job(const Params& p, int l, int j, float* tl) {
  if (j < WJ_IN) { transpose_strip(p.w_in + (size_t)l * 1024 * 1440, 1440, (j % 16) * 64, (j / 16) * 256, p.Wt_in() + (size_t)l * 1572864, 1024, 0, 0, tl); return; }
  j -= WJ_IN;
  if (j < WJ_UQ) { transpose_strip(p.w_uq + (size_t)l * 196608, 768, (j % 4) * 64, (j / 4) * 256, p.Wt_uq() + (size_t)l * 196608, 256, 0, 0, tl); return; }
  j -= WJ_UQ;
  if (j < WJ_UK) { transpose_strip(p.w_uk + (size_t)l * 65536, 512, (j % 2) * 64, (j / 2) * 256, p.Wt_ukv() + (size_t)l * 262144, 256, 0, 0, tl); return; }
  j -= WJ_UK;
  if (j < WJ_UV) { transpose_strip(p.w_uv + (size_t)l * 65536, 512, (j % 2) * 64, (j / 2) * 256, p.Wt_ukv() + (size_t)l * 262144, 256, 0, 512, tl); return; }
  j -= WJ_UV;
  if (j < WJ_GLU) { transpose_strip(p.w_glu + (size_t)l * 65536, 256, (j % 4) * 64, (j / 4) * 256, p.Wt_glu() + (size_t)l * 65536, 256, 0, 0, tl); return; }
  j -= WJ_GLU;
  if (j < WJ_OUT) { transpose_strip(p.w_out + (size_t)l * 1048576, 1024, (j % 16) * 64, (j / 16) * 256, p.Wt_out() + (size_t)l * 1048576, 1024, 0, 0, tl); return; }
  j -= WJ_OUT;
  if (j < WJ_G) { transpose_strip(p.w_gate + (size_t)l * 2883584, 2816, (j % 16) * 64, (j / 16) * 256, p.Wt_gu() + (size_t)l * 5767168, 1024, 1, 0, tl); return; }
  j -= WJ_G;
  if (j < WJ_U) { transpose_strip(p.w_up + (size_t)l * 2883584, 2816, (j % 16) * 64, (j / 16) * 256, p.Wt_gu() + (size_t)l * 5767168, 1024, 2, 0, tl); return; }
  j -= WJ_U;
  transpose_strip(p.w_down + (size_t)l * 2883584, 1024, (j % 44) * 64, (j / 44) * 256, p.Wt_dn() + (size_t)l * 2883584, 2816, 0, 0, tl);
}
template <class F>
DI void idle_block_jobs(int n, int first_idle, F f) {
  const int G = gridDim.x, nidle = G - first_idle;
  if (nidle > 0) { if ((int)blockIdx.x >= first_idle) for (int e = blockIdx.x - first_idle; e < n; e += nidle) f(e); }
  else for (int e = blockIdx.x; e < n; e += G) f(e);
}

DI void phase_pre1(const Params& p, char* smem) {
  const int tid = tidx();
  float* tl = (float*)smem;
  constexpr int N_T = WJ_EARLY + WJ_OUT, N_MODS = 192, N_ROPE = 128, N_S5 = 8, N_ZP = 32;
  for (int it = blockIdx.x; it < N_T + N_MODS + N_ROPE + N_S5 + N_ZP; it += gridDim.x) {
    if (it >= N_T + N_MODS + N_ROPE + N_S5) {
      const int zj = it - (N_T + N_MODS + N_ROPE + N_S5);
#pragma unroll
      for (int i = 0; i < 2; ++i) { const int c = tid + NT * i, row = zj * 64 + (c >> 4), ch = c & 15; *(uint4*)(p.Wt_ukv() + (size_t)row * 256 + 128 + ch * 8) = make_uint4(0, 0, 0, 0); }
      continue;
    }
    if (it >= N_MODS && it < N_MODS + N_T) { weight_job(p, 0, it - N_MODS, tl); continue; }
    if (it < N_MODS) {
      const int j = it, l = j / 96, cg0 = (j % 96) * 64;
      float* sil = (float*)smem;
      float* red = sil + 3072;
      for (int i = tid; i < 3072; i += NT) {
        int ci = i >> 10, k = i & 1023;
        float cv = (ci == 0) ? p.c_ctx[k] : p.c[(ci - 1) * 1024 + k];
        sil[i] = cv * sigmoidf(cv);
      }
      __syncthreads();
      const int w = tid >> 6, lane = tid & 63, n = cg0 + lane;
      float a0 = 0.f, a1 = 0.f, a2 = 0.f;
      const float* wp = p.w_ada + (size_t)l * 1024 * 6144 + n;
#pragma unroll 32
      for (int k = w * 128; k < w * 128 + 128; ++k) {
        float wv = __builtin_nontemporal_load(wp + (size_t)k * 6144);
        a0 += sil[k] * wv; a1 += sil[1024 + k] * wv; a2 += sil[2048 + k] * wv;
      }
      red[(w * 3 + 0) * 64 + lane] = a0; red[(w * 3 + 1) * 64 + lane] = a1; red[(w * 3 + 2) * 64 + lane] = a2;
      __syncthreads();
      if (tid < 192) {
        int ci = tid >> 6, ln = tid & 63;
        float sm = 0.f;
#pragma unroll
        for (int ww = 0; ww < 8; ++ww) sm += red[(ww * 3 + ci) * 64 + ln];
        p.mods()[(size_t)(l * 3 + ci) * 6144 + cg0 + ln] = sm + p.b_ada[l * 6144 + cg0 + ln];
      }
      __syncthreads();
      continue;
    }
    int j = it - N_MODS - N_T;
    if (j < N_ROPE) {
      int idx = j * NT + tid, pos = idx >> 4, i = idx & 15, f = i & 7;
      double v = 1.0;
      for (int q = 0; q < (f >> 1); ++q) v *= 0.1;
      if (f & 1) v *= 0.31622776601683794;
      float inv = (float)v;
      float ang = (float)((i < 8) ? (pos >> 6) : (pos & 63)) * inv;
      float sn, cs; sincos_d((double)ang, sn, cs);
      p.rope()[idx] = make_float2(cs, sn);
      continue;
    }
    j -= N_ROPE;
    {
      int e = j * NT + tid;
      float lre = p.s5_lre[e], lim = p.s5_lim[e], dt = expf(p.s5_ldt[e >> 6]);
      float mag = expf(lre * dt), ang = lim * dt, sn, cs;
      sincos_d((double)ang, sn, cs);
      float are = mag * cs, aim = mag * sn;
      float den = lre * lre + lim * lim, nre = are - 1.f, nim = aim;
      float fre = (nre * lre + nim * lim) / den, fim = (nim * lre - nre * lim) / den;
      p.s5a()[e] = make_float2(are, aim);
#pragma unroll
      for (int ch = 0; ch < 16; ++ch) {
        float br = p.s5_bre[(size_t)e * 16 + ch], bi = p.s5_bim[(size_t)e * 16 + ch];
        p.s5bre()[(size_t)e * 16 + ch] = fre * br - fim * bi;
        p.s5bim()[(size_t)e * 16 + ch] = fre * bi + fim * br;
      }
    }
  }
}

DI void store_h(const Params& p, int t, int lm, int scc, int shc, const float* v, int lane) {
  const float* mb = p.mods() + (size_t)(lm * 3 + tok_cond(t)) * 6144;
#pragma unroll
  for (int j = 0; j < 4; ++j) {
    int col = lane * 4 + 256 * j;
    float4 sc = *(const float4*)(mb + scc * 1024 + col), sh = *(const float4*)(mb + shc * 1024 + col);
    uint2 o;
    o.x = pk2(v[4 * j] * (1.f + sc.x) + sh.x, v[4 * j + 1] * (1.f + sc.y) + sh.y);
    o.y = pk2(v[4 * j + 2] * (1.f + sc.z) + sh.z, v[4 * j + 3] * (1.f + sc.w) + sh.w);
    *(uint2*)(p.H() + (size_t)t * 1024 + col) = o;
  }
}

DI void phase_pre2(const Params& p) {
  const int lane = tidx() & 63, w = tidx() >> 6;
  for (int it = blockIdx.x; it < TA / 8; it += gridDim.x) {
    int t = it * 8 + w;
    const float* xr = (t < TC) ? p.x_prompt + (size_t)t * 1024 : p.x_sample + (size_t)(t - TC) * 1024;
    float v[16];
#pragma unroll
    for (int j = 0; j < 4; ++j) { float4 x = *(const float4*)(xr + lane * 4 + 256 * j); v[4 * j] = x.x; v[4 * j + 1] = x.y; v[4 * j + 2] = x.z; v[4 * j + 3] = x.w; }
    store_h(p, t, 0, 1, 0, v, lane);
  }
}

DI void phase_ln(const Params& p, int l, int which) {
  const int lane = tidx() & 63, w = tidx() >> 6;
  const float* gp = (which == 1 ? p.ln1g : p.ln2g) + l * 1024;
  const float* bp = (which == 1 ? p.ln1b : p.ln2b) + l * 1024;
  for (int it = blockIdx.x; it < TA / 8; it += gridDim.x) {
    int t = it * 8 + w;
    float* xr = p.out + (size_t)t * 1024;
    float v[16]; float s = 0.f;
#pragma unroll
    for (int j = 0; j < 4; ++j) { float4 x = *(const float4*)(xr + lane * 4 + 256 * j); v[4 * j] = x.x; v[4 * j + 1] = x.y; v[4 * j + 2] = x.z; v[4 * j + 3] = x.w; s += x.x + x.y + x.z + x.w; }
    float mean = wave_sum(s) * (1.f / 1024.f);
    float q = 0.f;
#pragma unroll
    for (int i = 0; i < 16; ++i) { float d = v[i] - mean; q += d * d; }
    float rs = rsqrtf(wave_sum(q) * (1.f / 1024.f) + 1e-5f);
#pragma unroll
    for (int j = 0; j < 4; ++j) {
      int col = lane * 4 + 256 * j;
      float4 g = *(const float4*)(gp + col), b = *(const float4*)(bp + col);
      v[4 * j] = (v[4 * j] - mean) * rs * g.x + b.x; v[4 * j + 1] = (v[4 * j + 1] - mean) * rs * g.y + b.y;
      v[4 * j + 2] = (v[4 * j + 2] - mean) * rs * g.z + b.z; v[4 * j + 3] = (v[4 * j + 3] - mean) * rs * g.w + b.w;
      *(float4*)(xr + col) = make_float4(v[4 * j], v[4 * j + 1], v[4 * j + 2], v[4 * j + 3]);
    }
    if (which == 1) store_h(p, t, l, 4, 3, v, lane);
    else if (l + 1 < 2) store_h(p, t, l + 1, 1, 0, v, lane);
  }
}

typedef f32x4 Acc256[2][2][4][2];
typedef f32x4 Acc128[2][2][2][2];

#define XB_TMO      128
#define XB_XCNT(j)  (256  + 64 * (j))
#define XB_XSUB(j)  (1280 + 64 * (j))
#define XB_XGEN(j)  (2304 + 64 * (j))
#define XB_TOP      3328
#define XB_TOPGEN   3392
#define XCD_BAR_WORDS 3456
#define XB_SPIN_CAP (1u << 18)
DI unsigned xb_ld(unsigned* p) { return __hip_atomic_load(p, __ATOMIC_RELAXED, __HIP_MEMORY_SCOPE_AGENT); }
DI unsigned xb_add(unsigned* p, unsigned v) { return __hip_atomic_fetch_add(p, v, __ATOMIC_RELAXED, __HIP_MEMORY_SCOPE_AGENT); }
DI unsigned xb_xcc_id() { return (unsigned)__builtin_amdgcn_s_getreg((3 << 11) | 20) & 0xFu; }
#define XB_SPIN(cond, bar) do { unsigned _sp = 0; while (cond) { __builtin_amdgcn_s_sleep(1); \
    if ((++_sp & 255u) == 0u) { if (xb_ld(&(bar)[XB_TMO])) break; if (_sp > XB_SPIN_CAP) { atomicAdd(&(bar)[XB_TMO], 1u); break; } } } } while (0)
struct XcdBarrier { unsigned* bar; unsigned x; volatile LAS unsigned* st; };
DI XcdBarrier xcd_barrier_post(unsigned* bar, volatile LAS unsigned* st) {
  XcdBarrier b; b.bar = bar; b.x = xb_xcc_id(); b.st = st;
  if (threadIdx.x == 0) (void)xb_add(&bar[XB_XCNT(b.x)], 1u);
  return b;
}
DI void xcd_barrier_complete(unsigned* bar, unsigned x, unsigned& nloc, unsigned& nx) {
  const unsigned G = gridDim.x * gridDim.y * gridDim.z;
  unsigned sum, cnt, mine, sp = 0u;
  for (;;) {
    sum = 0u; cnt = 0u; mine = 0u;
#pragma unroll
    for (unsigned j = 0; j < 16; ++j) { const unsigned c = xb_ld(&bar[XB_XCNT(j)]); sum += c; cnt += (c > 0u) ? 1u : 0u; mine = (j == x) ? c : mine; }
    if (sum == G) break;
    __builtin_amdgcn_s_sleep(1);
    if ((++sp & 255u) == 0u) { if (xb_ld(&bar[XB_TMO])) break; if (sp > XB_SPIN_CAP) { atomicAdd(&bar[XB_TMO], 1u); break; } }
  }
  nloc = mine > 0u ? mine : 1u; nx = cnt > 0u ? cnt : 1u;
}
DI void xcd_barrier(const XcdBarrier& b) {
  asm volatile("s_waitcnt vmcnt(0)" ::: "memory");
  __syncthreads();
  if (threadIdx.x == 0) {
    unsigned* bar = b.bar;
    __builtin_amdgcn_s_waitcnt(0);
    unsigned nloc = b.st[0], nx = b.st[1];
    if (nloc == 0u) { xcd_barrier_complete(bar, b.x, nloc, nx); b.st[0] = nloc; b.st[1] = nx; }
    const unsigned old = xb_add(&bar[XB_XSUB(b.x)], 1u);
    const unsigned gen = old / nloc;
    if (old + 1u == (gen + 1u) * nloc) {
      __builtin_amdgcn_fence(__ATOMIC_RELEASE, "agent");
      asm volatile("s_waitcnt vmcnt(0)" ::: "memory");
      const unsigned og = xb_add(&bar[XB_TOP], 1u);
      const unsigned tg = og / nx;
      if (og + 1u == (tg + 1u) * nx) xb_add(&bar[XB_TOPGEN], 1u);
      else XB_SPIN(xb_ld(&bar[XB_TOPGEN]) == tg, bar);
      __builtin_amdgcn_fence(__ATOMIC_ACQUIRE, "agent");
      xb_add(&bar[XB_XGEN(b.x)], 1u);
      asm volatile("s_waitcnt vmcnt(0)" ::: "memory");
    } else {
      XB_SPIN(xb_ld(&bar[XB_XGEN(b.x)]) == gen, bar);
      __builtin_amdgcn_fence(__ATOMIC_ACQUIRE, "agent");
      asm volatile("s_waitcnt vmcnt(0)" ::: "memory");
    }
  }
  __syncthreads();
}

DI void phase_a(const Params& p, int l, char* smem) {
  constexpr int NG = 48 * 5;
  bool pre = false;
  for (int it = blockIdx.x; it < NG + 256 + 200; it += gridDim.x) {
    if (it >= NG + 256) {
      const int zj = it - NG - 256, tid = tidx();
#pragma unroll
      for (int i = 0; i < 2; ++i) { const int c = tid + NT * i, row = zj * 64 + (c >> 4), ch = c & 15; *(uint4*)(p.CKV() + (size_t)row * 256 + 128 + ch * 8) = make_uint4(0, 0, 0, 0); }
      continue;
    }
    if (it < NG) {
      int pm, pn, npm = 0, npn = 0; tile_order(it, 48, 5, pm, pn);
      const bool hn = (it + (int)gridDim.x) < NG; if (hn) tile_order(it + gridDim.x, 48, 5, npm, npn);
      auto epi = [&](Acc256& acc, int r0, int c0, int fr, int fq) __attribute__((always_inline)) {
#pragma unroll
        for (int ai = 0; ai < 2; ++ai)
#pragma unroll
          for (int bj = 0; bj < 2; ++bj) {
            const int colbase = c0 + bj * 128;
            if (colbase >= 1440) continue;
            const int cb = colbase >> 5;
#pragma unroll
            for (int m = 0; m < 4; ++m) {
              const int rowb = r0 + ai * 128 + m * 16 + fq * 4;
              const bool ctx = rowb < TC;
              const f32x4 a0 = acc[ai][bj][m][0], a1 = acc[ai][bj][m][1];
              if (cb < 16 || cb == 44) {
#pragma unroll
                for (int j = 0; j < 4; ++j) {
                  const int row = rowb + j;
                  float v0 = a0[j], v1 = a1[j];
                  const float raw0 = v0, raw1 = v1;
                  if (!ctx) {
                    float2 cs = p.rope()[tok_pos(row) * 16 + fr];
                    float t0 = v0 * cs.x - v1 * cs.y, t1 = v1 * cs.x + v0 * cs.y;
                    v0 = t0; v1 = t1;
                  }
                  if (cb < 8) {
                    u16* q = p.Qd() + (size_t)row * 256 + colbase + fr;
                    q[0] = f2bf(v0 * QS_D); q[16] = f2bf(v1 * QS_D);
                  } else if (cb < 16) {
                    const int cc = colbase - 256 + fr;
                    if (ctx) { float* o = p.out + O_DK + ((size_t)((row >> 8) * 2 + l) * 256 + (row & 255)) * 256 + cc; o[0] = raw0; o[16] = raw1; }
                    u16* k = p.Kd() + (size_t)tok_key(row) * 256 + cc;
                    k[0] = f2bf(v0); k[16] = f2bf(v1);
                  } else {
                    if (ctx) { float* o = p.out + O_KR + ((size_t)((row >> 8) * 2 + l) * 256 + (row & 255)) * 32 + fr; o[0] = raw0; o[16] = raw1; }
                    u16* k = p.KR() + (size_t)tok_key(row) * 32 + fr;
                    k[0] = f2bf(v0); k[16] = f2bf(v1);
                  }
                }
              } else if (cb < 24) {
                const int cc = colbase - 512 + fr;
                if (ctx) {
#pragma unroll
                  for (int j = 0; j < 4; ++j) {
                    float* o = p.out + O_DV + ((size_t)(((rowb + j) >> 8) * 2 + l) * 256 + ((rowb + j) & 255)) * 256 + cc;
                    o[0] = a0[j]; o[16] = a1[j];
                  }
                }
                const size_t key = tok_key(rowb);
                *(uint2*)(p.VdT() + (size_t)cc * KA + key) = make_uint2(pk2(a0[0], a0[1]), pk2(a0[2], a0[3]));
                *(uint2*)(p.VdT() + (size_t)(cc + 16) * KA + key) = make_uint2(pk2(a1[0], a1[1]), pk2(a1[2], a1[3]));
              } else {
                float* dst; int ld, c2;
                if (cb < 32) { dst = p.U(); ld = 256; c2 = colbase - 768 + fr; }
                else if (cb < 40) { dst = p.QL(); ld = 256; c2 = colbase - 1024 + fr; }
                else { dst = p.KVL(); ld = 128; c2 = colbase - 1280 + fr; }
#pragma unroll
                for (int j = 0; j < 4; ++j) { float* o = dst + (size_t)(rowb + j) * ld + c2; o[0] = a0[j]; o[16] = a1[j]; }
              }
              SCHED;
            }
          }
      };
      gemm256<4>(p.H(), p.Wt_in() + (size_t)l * 1572864, 1024, pm * 256, pn * 256, smem, epi, pre, hn, npm * 256, npn * 256); pre = hn;
    } else {
      const int tid = tidx();
      const int ci = (it - NG) * 2 + (tid >> 8), t8 = tid & 255, b = ci >> 8, j = ci & 255;
      const size_t key = TC + b * 4352 + 4096 + j;
      const size_t src = (size_t)((b * 2 + l) * 256 + j);
      p.Kd()[key * 256 + t8] = f2bf(p.cache_k[src * 256 + t8]);
      p.VdT()[(size_t)t8 * KA + key] = f2bf(p.cache_v[src * 256 + t8]);
      if (t8 < 128) p.CKV()[key * 256 + t8] = f2bf(p.cache_ckv[src * 128 + t8]);
      if (t8 < 32) p.KR()[key * 32 + t8] = f2bf(p.cache_kr[src * 32 + t8]);
    }
  }
}

DI void s5_bu_to_lds(const Params& p, int e0, int tok0, int g, char* img, int lane) {
  const int n = lane & 15, q4 = lane >> 4;
  bf16x8 af[2];
#pragma unroll
  for (int mt = 0; mt < 2; ++mt) {
    uint4 z = make_uint4(0, 0, 0, 0);
    if (q4 < 2) {
      const float* up = p.U() + (size_t)(tok0 + 16 * mt + n) * 256 + g * 16 + 8 * q4;
      float4 x = *(const float4*)up, y = *(const float4*)(up + 4);
      z = make_uint4(pk2(x.x, x.y), pk2(x.z, x.w), pk2(y.x, y.y), pk2(y.z, y.w));
    }
    af[mt] = __builtin_bit_cast(bf16x8, z);
  }
#pragma unroll
  for (int nt = 0; nt < 8; ++nt) {
    uint4 z = make_uint4(0, 0, 0, 0);
    if (q4 < 2) {
      const float* bp = ((nt < 4) ? p.s5bre() : p.s5bim()) + (size_t)(e0 + 16 * (nt & 3) + n) * 16 + 8 * q4;
      float4 x = *(const float4*)bp, y = *(const float4*)(bp + 4);
      z = make_uint4(pk2(x.x, x.y), pk2(x.z, x.w), pk2(y.x, y.y), pk2(y.z, y.w));
    }
    const bf16x8 bfr = __builtin_bit_cast(bf16x8, z);
#pragma unroll
    for (int mt = 0; mt < 2; ++mt) {
      f32x4 d = {0.f, 0.f, 0.f, 0.f};
      d = MFMA16(af[mt], bfr, d);
#pragma unroll
      for (int reg = 0; reg < 4; ++reg) *(float*)(img + (16 * mt + 4 * q4 + reg) * 528 + (16 * nt + n) * 4) = d[reg];
    }
  }
}

DI void s5_pass1(const Params& p, int l, int witem, char* img) {
  const int lane = tidx() & 63;
  int d, g, c, nch, qbase, cbase;
  if (witem < 8192) { c = witem & 127; g = (witem >> 7) & 15; d = (witem >> 11) & 1; int b = witem >> 12; nch = 128; qbase = TC + b * 4096; cbase = 128 + b * 128; }
  else { int x = witem - 8192; c = x & 7; g = (x >> 3) & 15; d = (x >> 7) & 1; int b = x >> 8; nch = 8; qbase = b * 256; cbase = b * 8; }
  const int e0 = ((l * 2 + d) * 16 + g) * 64;
  const int tok0 = qbase + (d ? (nch - 1 - c) : c) * 32;
  s5_bu_to_lds(p, e0, tok0, g, img, lane);
  lds_fence();
  const float2 a = p.s5a()[e0 + lane];
  float hr = 0.f, hi = 0.f;
#pragma unroll 4
  for (int j = 0; j < 32; ++j) {
    const int row = d ? (31 - j) : j;
    const float bur = *(const float*)(img + row * 528 + lane * 4), bui = *(const float*)(img + row * 528 + 256 + lane * 4);
    float nr = a.x * hr - a.y * hi + bur, ni = a.x * hi + a.y * hr + bui;
    hr = nr; hi = ni;
  }
  p.FIN()[(size_t)(((cbase + c) * 2 + d) * 16 + g) * 64 + lane] = make_float2(hr, hi);
  lds_fence();
}

DI void s5_carry(const Params& p, int l, int witem) {
  const int lane = tidx() & 63;
  int g, d, b, nch, cbase; bool isctx;
  if (witem < 64) { g = witem & 15; d = (witem >> 4) & 1; b = witem >> 5; nch = 128; cbase = 128 + b * 128; isctx = false; }
  else { int x = witem - 64; g = x & 15; d = (x >> 4) & 1; b = x >> 5; nch = 8; cbase = b * 8; isctx = true; }
  const int e = ((l * 2 + d) * 16 + g) * 64 + lane;
  const float2 a = p.s5a()[e];
  float tr = a.x, ti = a.y;
#pragma unroll
  for (int s = 0; s < 5; ++s) { float nr = tr * tr - ti * ti, ni = 2.f * tr * ti; tr = nr; ti = ni; }
  float hr = 0.f, hi = 0.f;
  if (!isctx) { const float* s = p.state_s5 + ((size_t)(((b * 2 + l) * 2 + d) * 16 + g) * 64 + lane) * 2; hr = s[0]; hi = s[1]; }
  const size_t base = (size_t)((cbase * 2 + d) * 16 + g) * 64 + lane;
  if (isctx) {
    float2 f[8];
#pragma unroll
    for (int i = 0; i < 8; ++i) f[i] = p.FIN()[base + (size_t)i * 2048];
#pragma unroll
    for (int i = 0; i < 8; ++i) {
      p.CIN()[base + (size_t)i * 2048] = make_float2(hr, hi);
      float nr = tr * hr - ti * hi + f[i].x, ni = tr * hi + ti * hr + f[i].y;
      hr = nr; hi = ni;
    }
  } else {
    for (int c = 0; c < 128; c += 32) {
      float2 f[32];
#pragma unroll
      for (int i = 0; i < 32; ++i) f[i] = p.FIN()[base + (size_t)(c + i) * 2048];
#pragma unroll
      for (int i = 0; i < 32; ++i) {
        p.CIN()[base + (size_t)(c + i) * 2048] = make_float2(hr, hi);
        float nr = tr * hr - ti * hi + f[i].x, ni = tr * hi + ti * hr + f[i].y;
        hr = nr; hi = ni;
      }
    }
  }
  if (isctx) {
    float* o = p.out + O_S5 + ((size_t)(((b * 2 + l) * 2 + d) * 16 + g) * 64 + lane) * 2;
    o[0] = hr; o[1] = hi;
  }
}

DI float gelu_tanh(float x) {
  float z = 0.7978845608028654f * (x + 0.044715f * x * x * x);
  float t = 1.f - 2.f / (1.f + __expf(2.f * z));
  return 0.5f * x * (1.f + t);
}

DI void s5_pass3(const Params& p, int l, int witem, char* img) {
  const int lane = tidx() & 63;
  int tc, g, b, nch, qbase, cbase;
  if (witem < 4096) { tc = witem & 127; g = (witem >> 7) & 15; b = witem >> 11; nch = 128; qbase = TC + b * 4096; cbase = 128 + b * 128; }
  else { int x = witem - 4096; tc = x & 7; g = (x >> 3) & 15; b = x >> 7; nch = 8; qbase = b * 256; cbase = b * 8; }
  const int tok0 = qbase + tc * 32;
  f32x4 acc0 = {0.f, 0.f, 0.f, 0.f}, acc1 = {0.f, 0.f, 0.f, 0.f};
  const int n = lane & 15, q4 = lane >> 4;
#pragma unroll 1
  for (int d = 0; d < 2; ++d) {
    const int pc = d ? (nch - 1 - tc) : tc;
    const int e0 = ((l * 2 + d) * 16 + g) * 64;
    s5_bu_to_lds(p, e0, tok0, g, img, lane);
    lds_fence();
    const float2 a = p.s5a()[e0 + lane];
    const float2 h0 = p.CIN()[(size_t)(((cbase + pc) * 2 + d) * 16 + g) * 64 + lane];
    float hr = h0.x, hi = h0.y;
#pragma unroll 4
    for (int j = 0; j < 32; ++j) {
      const int row = d ? (31 - j) : j;
      const float bur = *(const float*)(img + row * 528 + lane * 4), bui = *(const float*)(img + row * 528 + 256 + lane * 4);
      float nr = a.x * hr - a.y * hi + bur, ni = a.x * hi + a.y * hr + bui;
      hr = nr; hi = ni;
      *(u16*)(img + row * 528 + lane * 2) = f2bf(hr);
      *(u16*)(img + row * 528 + 128 + lane * 2) = f2bf(hi);
    }
    lds_fence();
#pragma unroll
    for (int s = 0; s < 4; ++s) {
      const float* cp = ((s < 2) ? p.s5_cre : p.s5_cim) + ((size_t)(((l * 2 + d) * 16 + g) * 16 + n)) * 64 + 32 * (s & 1) + 8 * q4;
      float4 c0 = *(const float4*)cp, c1 = *(const float4*)(cp + 4);
      const float sg = (s < 2) ? 1.f : -1.f;
      bf16x8 bfrag = __builtin_bit_cast(bf16x8, make_uint4(pk2(sg * c0.x, sg * c0.y), pk2(sg * c0.z, sg * c0.w), pk2(sg * c1.x, sg * c1.y), pk2(sg * c1.z, sg * c1.w)));
      bf16x8 a0 = *(const bf16x8*)(img + (n) * 528 + (32 * s + 8 * q4) * 2);
      bf16x8 a1 = *(const bf16x8*)(img + (16 + n) * 528 + (32 * s + 8 * q4) * 2);
      acc0 = MFMA16(a0, bfrag, acc0);
      acc1 = MFMA16(a1, bfrag, acc1);
    }
    lds_fence();
  }
  const float dsk = p.s5_d[(l * 16 + g) * 16 + n];
#pragma unroll
  for (int reg = 0; reg < 4; ++reg) {
    const int row0 = 4 * q4 + reg, row1 = 16 + 4 * q4 + reg;
    const float u0 = p.U()[(size_t)(tok0 + row0) * 256 + g * 16 + n], u1 = p.U()[(size_t)(tok0 + row1) * 256 + g * 16 + n];
    p.YG()[(size_t)(tok0 + row0) * 256 + g * 16 + n] = f2bf(gelu_tanh(u0 * dsk + acc0[reg]));
    p.YG()[(size_t)(tok0 + row1) * 256 + g * 16 + n] = f2bf(gelu_tanh(u1 * dsk + acc1[reg]));
  }
}

DI void phase_b(const Params& p, int l, char* smem) {
  for (int it = blockIdx.x; it < 96; it += gridDim.x) {
    const int pm = it;
    auto epi = [&](Acc128& acc, int r0, int c0, int fr, int fq) __attribute__((always_inline)) {
      const int tid = tidx(), wid = tid >> 6, wr = wid >> 2, wc = wid & 3, brow = pm * 128;
      const bool ctx = brow < TC;
      float* part = (float*)(smem + 98304);
      float* stat = part + 1024;
      int rb2 = wr * 32 + fq * 4; asm volatile("" : "+v"(rb2));
#pragma unroll
      for (int ai = 0; ai < 2; ++ai)
#pragma unroll
        for (int m = 0; m < 2; ++m)
#pragma unroll
          for (int j = 0; j < 4; ++j) {
            const float v0 = acc[ai][0][m][0][j], v1 = acc[ai][0][m][1][j];
            float s2 = v0 * v0 + v1 * v1;
            s2 = row16_sum(s2);
            if (fr == 0) part[(rb2 + ai * 64 + m * 16 + j) * 4 + wc] = s2;
          }
      __syncthreads();
      if (tid < 128) stat[tid] = rsqrtf((part[tid * 4] + part[tid * 4 + 1] + part[tid * 4 + 2] + part[tid * 4 + 3]) * (1.f / 128.f) + 1e-6f);
      __syncthreads();
      int rb4 = wr * 32 + fq * 4; asm volatile("" : "+v"(rb4));
      const int kc = wc * 32 + fr;
      const float g0 = p.kv_g[l * 128 + kc], g1 = p.kv_g[l * 128 + kc + 16];
#pragma unroll
      for (int ai = 0; ai < 2; ++ai)
#pragma unroll
        for (int m = 0; m < 2; ++m)
#pragma unroll
          for (int j = 0; j < 4; ++j) {
            const int rowl = rb4 + ai * 64 + m * 16 + j, row = brow + rowl;
            const float rs = stat[rowl];
            const float c0v = acc[ai][0][m][0][j] * rs * g0, c1v = acc[ai][0][m][1][j] * rs * g1;
            if (ctx) { float* o = p.out + O_CKV + ((size_t)((row >> 8) * 2 + l) * 256 + (row & 255)) * 128 + kc; o[0] = c0v; o[16] = c1v; }
            u16* ck = p.CKV() + (size_t)tok_key(row) * 256 + kc;
            ck[0] = f2bf(c0v); ck[16] = f2bf(c1v);
            if (wc == 0) {
              float v0 = acc[ai][1][m][0][j], v1 = acc[ai][1][m][1][j];
              if (ctx) { float* o = p.out + O_KR + ((size_t)((row >> 8) * 2 + l) * 256 + (row & 255)) * 32 + fr; o[0] = v0; o[16] = v1; }
              else {
                const float2 cs = p.rope()[tok_pos(row) * 16 + fr];
                const float t0 = v0 * cs.x - v1 * cs.y, t1 = v1 * cs.x + v0 * cs.y;
                v0 = t0; v1 = t1;
              }
              u16* k = p.KR() + (size_t)tok_key(row) * 32 + fr;
              k[0] = f2bf(v0); k[16] = f2bf(v1);
            }
          }
      __syncthreads();
    };
    gemm256<2>(p.H(), p.Wt_in() + (size_t)l * 1572864, 1024, pm * 128, 1280, smem, epi);
  }
  constexpr int NS = 12288 / 8, NR = TA / 8;
  idle_block_jobs(NS + NR, 96, [&](int e) __attribute__((always_inline)) {
    const int lane = tidx() & 63, w = tidx() >> 6;
    if (e < NS) { s5_pass1(p, l, e * 8 + w, smem + w * 16896); return; }
    const int t = (e - NS) * 8 + w;
    float4 x = *(const float4*)(p.QL() + (size_t)t * 256 + lane * 4);
    float rs = rsqrtf(wave_sum(x.x * x.x + x.y * x.y + x.z * x.z + x.w * x.w) * (1.f / 256.f) + 1e-6f);
    float4 g = *(const float4*)(p.q_g + l * 256 + lane * 4);
    uint2 o; o.x = pk2(x.x * rs * g.x, x.y * rs * g.y); o.y = pk2(x.z * rs * g.z, x.w * rs * g.w);
    *(uint2*)(p.QLN() + (size_t)t * 256 + lane * 4) = o;
  });
}

DI void phase_c(const Params& p, int l, char* smem) {
  constexpr int N3 = 50 * 4, N2 = 48 * 3, NCAR = 72;
  for (int it = blockIdx.x; it < N3 + N2 + NCAR; it += gridDim.x) {
    if (it >= N3 + N2) { s5_carry(p, l, (it - N3 - N2) * 8 + (tidx() >> 6)); continue; }
    if (it < N3) {
      int pm, pn; tile_order(it, 50, 4, pm, pn);
      auto epi = [&](Acc256& acc, int r0, int c0, int fr, int fq) __attribute__((always_inline)) {
#pragma unroll
        for (int ai = 0; ai < 2; ++ai)
#pragma unroll
          for (int bj = 0; bj < 2; ++bj) {
            const int colbase = c0 + bj * 128;
#pragma unroll
            for (int m = 0; m < 4; ++m) {
              const int rowb = r0 + ai * 128 + m * 16 + fq * 4;
#pragma unroll
              for (int n = 0; n < 2; ++n) {
                const int col = colbase + n * 16 + fr;
                const f32x4 a = acc[ai][bj][m][n];
                if (colbase < 512) {
#pragma unroll
                  for (int j = 0; j < 4; ++j) p.Km()[(size_t)(rowb + j) * 512 + col] = f2bf(a[j]);
                } else {
                  *(uint2*)(p.VmT() + (size_t)(col - 512) * KA + rowb) = make_uint2(pk2(a[0], a[1]), pk2(a[2], a[3]));
                }
              }
            }
          }
      };
      gemm256<4>(p.CKV(), p.Wt_ukv() + (size_t)l * 262144, 256, pm * 256, pn * 256, smem, epi);
    } else {
      const int j = it - N3;
      int pm, pn; tile_order(j, 48, 3, pm, pn);
      auto epi = [&](Acc256& acc, int r0, int c0, int fr, int fq) __attribute__((always_inline)) {
#pragma unroll
        for (int ai = 0; ai < 2; ++ai)
#pragma unroll
          for (int bj = 0; bj < 2; ++bj) {
            const int colbase = c0 + bj * 128;
            const bool ropecol = ((colbase >> 5) % 3 == 2);
#pragma unroll
            for (int m = 0; m < 4; ++m) {
              const int rowb = r0 + ai * 128 + m * 16 + fq * 4;
              const bool rp = ropecol && (rowb >= TC);
#pragma unroll
              for (int j2 = 0; j2 < 4; ++j2) {
                const int row = rowb + j2;
                float v0 = acc[ai][bj][m][0][j2], v1 = acc[ai][bj][m][1][j2];
                if (rp) {
                  float2 cs = p.rope()[tok_pos(row) * 16 + fr];
                  float t0 = v0 * cs.x - v1 * cs.y, t1 = v1 * cs.x + v0 * cs.y;
                  v0 = t0; v1 = t1;
                }
                u16* q = p.Qm() + (size_t)row * 768 + colbase + fr;
                q[0] = f2bf(v0 * QS_M); q[16] = f2bf(v1 * QS_M);
              }
            }
          }
      };
      gemm256<4>(p.QLN(), p.Wt_uq() + (size_t)l * 196608, 256, pm * 256, pn * 256, smem, epi);
    }
  }
}

template <int DQK, int NQ>
DI void attn_item(const Params& p, int seq, int hs, int qb, char* smem) {
  constexpr int KP = DQK * 2 + 16, KS = 64 * KP, VP = 136, VS = 64 * VP, STG = KS + VS;
  constexpr int NKC = DQK / 8, NKTOT = 64 * NKC, NKL = (NKTOT + NT - 1) / NT, NS = DQK / 16;
  const int tid = tidx(), lane = tid & 63, w = tid >> 6, r = lane & 31, h = lane >> 5;
  int qtok0, key0, Lk;
  if (seq < 16) { qtok0 = seq * 256; key0 = seq * 256; Lk = 256; }
  else { int b = seq - 16; qtok0 = TC + b * 4096; key0 = TC + b * 4352; Lk = 4352; }
  const u16 *qp, *k1, *vt; int qld, k1ld;
  if (DQK == 32) { int head = hs >> 1, c = hs & 1; qp = p.Qd() + head * 64 + c * 32; qld = 256; k1 = p.Kd() + head * 64 + c * 32; k1ld = 256; vt = p.VdT() + (size_t)(head * 64) * KA; }
  else { int hh = hs - 8; qp = p.Qm() + hh * 96; qld = 768; k1 = p.Km() + hh * 64; k1ld = 512; vt = p.VmT() + (size_t)(hh * 64) * KA; }
  const int t0 = qtok0 + qb * (256 * NQ) + w * (32 * NQ) + r;
  bf16x8 qf[NQ][NS];
#pragma unroll
  for (int qi = 0; qi < NQ; ++qi)
#pragma unroll
    for (int s = 0; s < NS; ++s) qf[qi][s] = *(const bf16x8*)(qp + (size_t)(t0 + 32 * qi) * qld + 16 * s + 8 * h);
  uint4 rkA0 = make_uint4(0, 0, 0, 0), rkA1 = make_uint4(0, 0, 0, 0), rvA, rkB0 = make_uint4(0, 0, 0, 0), rkB1 = make_uint4(0, 0, 0, 0), rvB;
  const int key_0 = tid / NKC, ch_0 = tid % NKC, key_1 = (tid + NT) / NKC, ch_1 = (tid + NT) % NKC;
  const bool has0 = tid < NKTOT, has1 = (tid + NT) < NKTOT;
  auto kload = [&](int kb, int key, int ch) __attribute__((always_inline)) {
    return (DQK == 32 || ch < 8) ? *(const uint4*)(k1 + (size_t)(kb + key) * k1ld + ch * 8) : *(const uint4*)(p.KR() + (size_t)(kb + key) * 32 + (ch - 8) * 8);
  };
  auto gload = [&](int kt, uint4& r0, uint4& r1, uint4& rv) __attribute__((always_inline)) {
    const int kb = key0 + kt * 64;
    if (has0) r0 = kload(kb, key_0, ch_0);
    if (NKL > 1) { if (has1) r1 = kload(kb, key_1, ch_1); }
    { int dv = tid >> 3, ch = tid & 7; rv = *(const uint4*)(vt + (size_t)dv * KA + kb + ch * 8); }
  };
  auto lstore = [&](int buf, const uint4& r0, const uint4& r1, const uint4& rv) __attribute__((always_inline)) {
    char* sk = smem + buf * STG; char* sv = sk + KS;
    if (has0) *(uint4*)(sk + key_0 * KP + ch_0 * 16) = r0;
    if (NKL > 1) { if (has1) *(uint4*)(sk + key_1 * KP + ch_1 * 16) = r1; }
    { int dv = tid >> 3, ch = tid & 7; uint2* d = (uint2*)(sv + dv * VP + ch * 16); d[0] = make_uint2(rv.x, rv.y); d[1] = make_uint2(rv.z, rv.w); }
  };
  f32x16 O[NQ][2];
  float m[NQ], lsum[NQ];
#pragma unroll
  for (int qi = 0; qi < NQ; ++qi) {
    m[qi] = 0.f; lsum[qi] = 0.f;
#pragma unroll
    for (int e = 0; e < 16; ++e) { O[qi][0][e] = 0.f; O[qi][1][e] = 0.f; }
  }
  const int nkt = Lk >> 6;
  auto compute = [&](int buf, bool first) __attribute__((always_inline)) {
    const char* sk = smem + buf * STG; const char* sv = sk + KS;
    f32x16 S[NQ][2];
#pragma unroll
    for (int st = 0; st < 2; ++st) {
#pragma unroll
      for (int qi = 0; qi < NQ; ++qi) {
        const float nm = -m[qi];
#pragma unroll
        for (int e = 0; e < 16; ++e) S[qi][st][e] = nm;
      }
#pragma unroll
      for (int s = 0; s < NS; ++s) {
        bf16x8 kf = *(const bf16x8*)(sk + (32 * st + r) * KP + (16 * s + 8 * h) * 2);
#pragma unroll
        for (int qi = 0; qi < NQ; ++qi) S[qi][st] = MFMA32(kf, qf[qi][s], S[qi][st]);
      }
    }
    float psv[NQ];
#pragma unroll
    for (int qi = 0; qi < NQ; ++qi) {
      if (first) {
        float mx = fmaxf(fmaxf(S[qi][0][0], S[qi][0][1]), fmaxf(S[qi][1][0], S[qi][1][1]));
#pragma unroll
        for (int e = 2; e < 16; e += 2) { mx = fmaxf(fmaxf(mx, S[qi][0][e]), S[qi][0][e + 1]); mx = fmaxf(fmaxf(mx, S[qi][1][e]), S[qi][1][e + 1]); }
        {
          const unsigned mb = __float_as_uint(mx);
          auto sw = __builtin_amdgcn_permlane32_swap(mb, mb, false, false);
          mx = fmaxf(__uint_as_float(sw[0]), __uint_as_float(sw[1]));
        }
        m[qi] += mx;
#pragma unroll
        for (int e = 0; e < 16; ++e) { S[qi][0][e] -= mx; S[qi][1][e] -= mx; }
      }
      float ps = 0.f;
#pragma unroll
      for (int st = 0; st < 2; ++st)
#pragma unroll
        for (int e = 0; e < 16; ++e) { const float pe = __builtin_amdgcn_exp2f(S[qi][st][e]); S[qi][st][e] = pe; ps += pe; }
      lsum[qi] += ps;
      psv[qi] = ps;
    }
#pragma unroll
    for (int st = 0; st < 2; ++st)
#pragma unroll
      for (int s2 = 0; s2 < 2; ++s2) {
        bf16x8 pf[NQ];
#pragma unroll
        for (int qi = 0; qi < NQ; ++qi) {
          uint4 pu = make_uint4(pk2(S[qi][st][8 * s2], S[qi][st][8 * s2 + 1]), pk2(S[qi][st][8 * s2 + 2], S[qi][st][8 * s2 + 3]),
                                pk2(S[qi][st][8 * s2 + 4], S[qi][st][8 * s2 + 5]), pk2(S[qi][st][8 * s2 + 6], S[qi][st][8 * s2 + 7]));
          pf[qi] = __builtin_bit_cast(bf16x8, pu);
        }
#pragma unroll
        for (int md = 0; md < 2; ++md) {
          const char* va = sv + (32 * md + r) * VP + (32 * st + 16 * s2 + 4 * h) * 2;
          uint2 lo = *(const uint2*)va, hi = *(const uint2*)(va + 16);
          bf16x8 vf = __builtin_bit_cast(bf16x8, make_uint4(lo.x, lo.y, hi.x, hi.y));
#pragma unroll
          for (int qi = 0; qi < NQ; ++qi) O[qi][md] = MFMA32(vf, pf[qi], O[qi][md]);
        }
      }
#pragma unroll
    for (int qi = 0; qi < NQ; ++qi) {
      if (__builtin_amdgcn_ballot_w64(psv[qi] > 1048576.f) != 0) {
        float dlt = (psv[qi] > 1048576.f) ? __log2f(psv[qi]) : 0.f;
        {
          const unsigned mb = __float_as_uint(dlt);
          auto sw = __builtin_amdgcn_permlane32_swap(mb, mb, false, false);
          dlt = fmaxf(__uint_as_float(sw[0]), __uint_as_float(sw[1]));
        }
        const float alpha = __builtin_amdgcn_exp2f(-dlt);
        m[qi] += dlt; lsum[qi] *= alpha;
#pragma unroll
        for (int e = 0; e < 16; ++e) { O[qi][0][e] *= alpha; O[qi][1][e] *= alpha; }
      }
    }
  };
  constexpr bool DEEP = !(NQ == 2 && DQK == 96);
  if (!DEEP) {
    gload(0, rkA0, rkA1, rvA); lstore(0, rkA0, rkA1, rvA);
    __syncthreads();
    for (int kt = 0; kt < nkt; ++kt) {
      if (kt + 1 < nkt) gload(kt + 1, rkA0, rkA1, rvA);
      compute(kt & 1, kt == 0);
      if (kt + 1 < nkt) lstore((kt + 1) & 1, rkA0, rkA1, rvA);
      __syncthreads();
    }
  } else {
  gload(0, rkA0, rkA1, rvA); lstore(0, rkA0, rkA1, rvA); gload(1, rkA0, rkA1, rvA);
  __syncthreads();
  for (int kt = 0; kt < nkt; kt += 2) {
    if (kt + 2 < nkt) gload(kt + 2, rkB0, rkB1, rvB);
    compute(0, kt == 0);
    lstore(1, rkA0, rkA1, rvA);
    __syncthreads();
    if (kt + 3 < nkt) gload(kt + 3, rkA0, rkA1, rvA);
    compute(1, false);
    if (kt + 2 < nkt) lstore(0, rkB0, rkB1, rvB);
    __syncthreads();
  }
  }
#pragma unroll
  for (int qi = 0; qi < NQ; ++qi) {
    const float inv = 1.f / (lsum[qi] + __shfl_xor(lsum[qi], 32));
    const int t = t0 + 32 * qi;
#pragma unroll
    for (int md = 0; md < 2; ++md)
#pragma unroll
      for (int g4 = 0; g4 < 4; ++g4) {
        const int dv0 = 32 * md + 8 * g4 + 4 * h;
        float o0 = O[qi][md][4 * g4] * inv, o1 = O[qi][md][4 * g4 + 1] * inv, o2 = O[qi][md][4 * g4 + 2] * inv, o3 = O[qi][md][4 * g4 + 3] * inv;
        if (DQK == 32) *(float4*)(p.ODIFF() + (size_t)t * 512 + hs * 64 + dv0) = make_float4(o0, o1, o2, o3);
        else *(uint2*)(p.CC() + (size_t)t * 1024 + 512 + (hs - 8) * 64 + dv0) = make_uint2(pk2(o0, o1), pk2(o2, o3));
      }
  }
}

#define XB_S5CTR(l) (3800 + 64 * (l))
DI void phase_d(const Params& p, int l, char* smem, int sub = 0) {
  constexpr int NAD = 2 * 8 * 16, NAC = 16 * 16, NS = 6144 / 8;
  if (sub != 2) {
    for (int it = blockIdx.x; it < NAD + NAC; it += gridDim.x) {
      if (it < NAD) {
        int hs = it & 15, qb = (it >> 4) & 7, b = it >> 7;
        if (hs < 8) attn_item<32, 2>(p, 16 + b, hs, qb, smem); else attn_item<96, 2>(p, 16 + b, hs, qb, smem);
      } else {
        int j = it - NAD, hs = j & 15, b = j >> 4;
        if (hs < 8) attn_item<32, 1>(p, b, hs, 0, smem); else attn_item<96, 1>(p, b, hs, 0, smem);
      }
    }
  }
  if (sub == 1) return;
  if (sub == 2) {
    for (int it = blockIdx.x; it < NS; it += gridDim.x) s5_pass3(p, l, it * 8 + (tidx() >> 6), smem + (tidx() >> 6) * 16896);
    return;
  }
  volatile unsigned* bw = (volatile unsigned*)(smem + 147456 - 16);
  unsigned* ctr = p.bar() + XB_S5CTR(l);
  for (;;) {
    __syncthreads();
    if (threadIdx.x == 0) *bw = xb_add(ctr, 1u);
    __syncthreads();
    const unsigned e = *bw;
    const unsigned nx = (l == 0) ? (unsigned)(NS + WJ_G + WJ_U) : (unsigned)NS;
    if (e >= nx) break;
    if (e >= (unsigned)NS) { weight_job(p, 0, WJ_EARLY + WJ_OUT + (int)(e - NS), (float*)smem); continue; }
    const int w = tidx() >> 6;
    s5_pass3(p, l, (int)e * 8 + w, smem + w * 16896);
  }
}

DI void phase_e(const Params& p, int l, char* smem) {
  constexpr int NG = 96, NR = TA / 8;
  for (int it = blockIdx.x; it < NG; it += gridDim.x) {
    {
      auto epi = [&](Acc128& acc, int r0, int c0, int fr, int fq) __attribute__((always_inline)) {
#pragma unroll
        for (int ai = 0; ai < 2; ++ai)
#pragma unroll
          for (int bj = 0; bj < 2; ++bj)
#pragma unroll
            for (int m = 0; m < 2; ++m) {
#pragma unroll
              for (int n = 0; n < 2; ++n)
#pragma unroll
                for (int j = 0; j < 4; ++j) {
                  const int row = r0 + ai * 64 + m * 16 + fq * 4 + j, col = c0 + bj * 128 + n * 16 + fr;
                  float y = bf2f(p.YG()[(size_t)row * 256 + col]);
                  p.CC()[(size_t)row * 1024 + 256 + col] = f2bf(y * sigmoidf(acc[ai][bj][m][n][j]));
                }
              SCHED;
            }
      };
      gemm256<2>(p.YG(), p.Wt_glu() + (size_t)l * 65536, 256, it * 128, 0, smem, epi);
    }
  }
  idle_block_jobs(NR, NG, [&](int e) __attribute__((always_inline)) {
    {
      const int lane = tidx() & 63, w = tidx() >> 6;
      const int t = e * 8 + w;
      float a1 = 0.f, a2 = 0.f;
      if (lane < 32) { a1 = p.lq1[l * 32 + lane] * p.lk1[l * 32 + lane]; a2 = p.lq2[l * 32 + lane] * p.lk2[l * 32 + lane]; }
      const float lam_init = 0.8f - 0.6f * expf(-0.3f * (float)l);
      const float lam = expf(wave_sum(a1)) - expf(wave_sum(a2)) + lam_init;
      const float gg = p.diff_g[l * 64 + lane] * (1.f - lam_init);
#pragma unroll
      for (int hd = 0; hd < 4; ++hd) {
        float o0 = p.ODIFF()[(size_t)t * 512 + (2 * hd) * 64 + lane], o1 = p.ODIFF()[(size_t)t * 512 + (2 * hd + 1) * 64 + lane];
        float o = o0 - lam * o1;
        float rs = rsqrtf(wave_sum(o * o) * (1.f / 64.f) + 1e-6f);
        p.CC()[(size_t)t * 1024 + hd * 64 + lane] = f2bf(o * rs * gg);
      }
    }
  });
}


#define XB_LNCNT(i) (3520 + (i))
template <int WHICH>
DI void epi_res_ln(const Params& p, const int l, Acc256& acc, int r0, int c0, int fr, int fq, char* smem, int pm, int pn) {
  const int tid = tidx(), wid = tid >> 6, wr = wid >> 2, wc = wid & 3;
  const int brow = pm * 256, cond = tok_cond(brow), slot = (l * 2 + (WHICH - 1)) * 48 + pm;
  const float* mb = p.mods() + (size_t)(l * 3 + cond) * 6144;
  {
    const float* xb = ((WHICH == 1 && l == 0) ? ((brow < TC) ? p.x_prompt + (size_t)brow * 1024 : p.x_sample + (size_t)(brow - TC) * 1024) : p.out + (size_t)brow * 1024) + c0;
    int rb1 = wr * 64 + fq * 4; asm volatile("" : "+v"(rb1));
    float gt[2][2];
#pragma unroll
    for (int bj = 0; bj < 2; ++bj)
#pragma unroll
      for (int n = 0; n < 2; ++n) gt[bj][n] = mb[(WHICH == 1 ? 2048 : 5120) + c0 + bj * 128 + n * 16 + fr];
#pragma unroll
    for (int ai = 0; ai < 2; ++ai)
#pragma unroll
      for (int m = 0; m < 4; ++m) {
        int zz = 0;
        { constexpr int PA = 0; const int pa = (ai * 4 + m + 4) / 4 % 2, pm4 = (ai * 4 + m + 4) % 4; (void)PA;
          const f32x4 d0 = acc[pa][0][pm4][0], d1 = acc[pa][0][pm4][1], d2 = acc[pa][1][pm4][0], d3 = acc[pa][1][pm4][1];
          asm volatile("" : "+v"(zz) : "v"(d0[0]), "v"(d0[1]), "v"(d0[2]), "v"(d0[3]), "v"(d1[0]), "v"(d1[1]), "v"(d1[2]), "v"(d1[3]),
                                       "v"(d2[0]), "v"(d2[1]), "v"(d2[2]), "v"(d2[3]), "v"(d3[0]), "v"(d3[1]), "v"(d3[2]), "v"(d3[3])); }
#pragma unroll
        for (int j = 0; j < 4; ++j) {
          const int rowl = rb1 + ai * 128 + m * 16 + j;
          const float* xr = xb + (rowl * 1024 + fr + zz);
#pragma unroll
          for (int bj = 0; bj < 2; ++bj)
#pragma unroll
            for (int n = 0; n < 2; ++n) acc[ai][bj][m][n][j] = ALPHA * xr[bj * 128 + n * 16] + gt[bj][n] * acc[ai][bj][m][n][j];
        }
        asm volatile("" ::: "memory"); SCHED;
      }
  }
  float* part = (float*)(smem + 98304);
  float* stat = part + 2048;
  int rb2 = wr * 64 + fq * 4; asm volatile("" : "+v"(rb2));
#pragma unroll
  for (int ai = 0; ai < 2; ++ai)
#pragma unroll
    for (int m = 0; m < 4; ++m)
#pragma unroll
      for (int j = 0; j < 4; ++j) {
        float s1 = 0.f, s2 = 0.f;
#pragma unroll
        for (int bj = 0; bj < 2; ++bj)
#pragma unroll
          for (int n = 0; n < 2; ++n) { const float v = acc[ai][bj][m][n][j]; s1 += v; s2 += v * v; }
        s1 = row16_sum(s1); s2 = row16_sum(s2);
        if (fr == 0) {
          const int rowl = rb2 + ai * 128 + m * 16 + j;
          part[(rowl * 4 + wc) * 2] = s1; part[(rowl * 4 + wc) * 2 + 1] = s2;
        }
      }
  __syncthreads();
  float2* xch = p.XCH() + (size_t)slot * 1024;
  if (tid < 256) {
    float a = 0.f, b = 0.f;
#pragma unroll
    for (int w4 = 0; w4 < 4; ++w4) { a += part[(tid * 4 + w4) * 2]; b += part[(tid * 4 + w4) * 2 + 1]; }
    xch[tid * 4 + pn] = make_float2(a, b);
  }
  asm volatile("s_waitcnt vmcnt(0)" ::: "memory");
  __syncthreads();
  if (tid == 0) {
    unsigned* cnt = p.bar() + XB_LNCNT(slot);
    __builtin_amdgcn_fence(__ATOMIC_RELEASE, "agent");
    asm volatile("s_waitcnt vmcnt(0)" ::: "memory");
    xb_add(cnt, 1u);
    unsigned sp = 0;
    while (xb_ld(cnt) < 4u) { __builtin_amdgcn_s_sleep(1); if (++sp > (1u << 22)) break; }
    __builtin_amdgcn_fence(__ATOMIC_ACQUIRE, "agent");
    asm volatile("s_waitcnt vmcnt(0)" ::: "memory");
  }
  __syncthreads();
  if (tid < 256) {
    float a = 0.f, b = 0.f;
#pragma unroll
    for (int t4 = 0; t4 < 4; ++t4) { const float2 q = xch[tid * 4 + t4]; a += q.x; b += q.y; }
    const float mean = a * (1.f / 1024.f);
    stat[tid * 2] = mean; stat[tid * 2 + 1] = rsqrtf(fmaxf(b * (1.f / 1024.f) - mean * mean, 0.f) + 1e-5f);
  }
  __syncthreads();
  const float* gp = (WHICH == 1 ? p.ln1g : p.ln2g) + l * 1024;
  const float* bp = (WHICH == 1 ? p.ln1b : p.ln2b) + l * 1024;
  const bool hasH = (WHICH == 1) || (l + 1 < 2);
  const float* mh = (WHICH == 1) ? mb : p.mods() + (size_t)((l + 1 < 2 ? l + 1 : l) * 3 + cond) * 6144;
  const int scc = (WHICH == 1) ? 4 : 1, shc = (WHICH == 1) ? 3 : 0;
  int rb4 = wr * 64 + fq * 4; asm volatile("" : "+v"(rb4));
  float gam[2][2], bet[2][2], sc1[2][2], sh1[2][2];
#pragma unroll
  for (int bj = 0; bj < 2; ++bj)
#pragma unroll
    for (int n = 0; n < 2; ++n) {
      const int col = c0 + bj * 128 + n * 16 + fr;
      gam[bj][n] = gp[col]; bet[bj][n] = bp[col];
      sc1[bj][n] = hasH ? 1.f + mh[scc * 1024 + col] : 0.f; sh1[bj][n] = hasH ? mh[shc * 1024 + col] : 0.f;
    }
#pragma unroll
  for (int ai = 0; ai < 2; ++ai)
#pragma unroll
    for (int m = 0; m < 4; ++m) {
#pragma unroll
      for (int j = 0; j < 4; ++j) {
        const int rowl = rb4 + ai * 128 + m * 16 + j, row = brow + rowl;
        const float mean = stat[rowl * 2], rs = stat[rowl * 2 + 1];
#pragma unroll
        for (int bj = 0; bj < 2; ++bj)
#pragma unroll
          for (int n = 0; n < 2; ++n) {
            const int col = c0 + bj * 128 + n * 16 + fr;
            const float x = (acc[ai][bj][m][n][j] - mean) * rs * gam[bj][n] + bet[bj][n];
            p.out[(size_t)row * 1024 + col] = x;
            if (hasH) p.H()[(size_t)row * 1024 + col] = f2bf(x * sc1[bj][n] + sh1[bj][n]);
          }
      }
      asm volatile("" ::: "memory"); SCHED;
    }
  __syncthreads();
}

DI void phase_f(const Params& p, int l, char* smem) {
  for (int it = blockIdx.x; it < 48 * 4; it += gridDim.x) {
    int pm, pn; tile_order(it, 48, 4, pm, pn);
    auto epi = [&](Acc256& acc, int r0, int c0, int fr, int fq) __attribute__((always_inline)) {
      if (l == 0) epi_res_ln<1>(p, 0, acc, r0, c0, fr, fq, smem, pm, pn); else epi_res_ln<1>(p, 1, acc, r0, c0, fr, fq, smem, pm, pn);
    };
    const float* xt = ((l == 0) ? ((pm * 256 < TC) ? p.x_prompt + (size_t)(pm * 256) * 1024 : p.x_sample + (size_t)(pm * 256 - TC) * 1024) : p.out + (size_t)(pm * 256) * 1024) + pn * 256;
    gemm256<4>(p.CC(), p.Wt_out() + (size_t)l * 1048576, 1024, pm * 256, pn * 256, smem, epi, false, false, 0, 0, xt);
  }
  if (l == 0)
    idle_block_jobs(WJ_D, 48 * 4, [&](int e) __attribute__((always_inline)) { weight_job(p, 0, WJ_EARLY + WJ_OUT + WJ_G + WJ_U + e, (float*)smem); });
}

template <int MT, class AccT>
DI void epi_swiglu(const Params& p, AccT& acc, int r0, int c0, int fr, int fq) {
#pragma unroll
  for (int ai = 0; ai < 2; ++ai)
#pragma unroll
    for (int bj = 0; bj < 2; ++bj) {
      const int unit = ((c0 + bj * 128) >> 5) * 16 + fr;
#pragma unroll
      for (int m = 0; m < MT; ++m)
#pragma unroll
        for (int j = 0; j < 4; ++j) {
          const int row = r0 + ai * (32 * MT) + m * 16 + fq * 4 + j;
          float g = acc[ai][bj][m][0][j], u = acc[ai][bj][m][1][j];
          p.ACT()[(size_t)row * 2816 + unit] = f2bf(g * sigmoidf(g) * u);
        }
    }
}
DI void phase_h(const Params& p, int l, char* smem) {
  constexpr int NFULL = 1024, NTOT = 48 * 22;
  bool pre = false;
  for (int it = blockIdx.x; it < NFULL + 2 * (NTOT - NFULL); it += gridDim.x) {
    if (it < NFULL) {
      int pm, pn, npm = 0, npn = 0; tile_order(it, 48, 22, pm, pn);
      const bool hn = (it + (int)gridDim.x) < NFULL; if (hn) tile_order(it + gridDim.x, 48, 22, npm, npn);
      auto epi = [&](Acc256& acc, int r0, int c0, int fr, int fq) __attribute__((always_inline)) { epi_swiglu<4>(p, acc, r0, c0, fr, fq); };
      gemm256<4>(p.H(), p.Wt_gu() + (size_t)l * 5767168, 1024, pm * 256, pn * 256, smem, epi, pre, hn, npm * 256, npn * 256); pre = hn;
    } else {
      const int hidx = it - NFULL;
      int pm, pn; tile_order(NFULL + (hidx >> 1), 48, 22, pm, pn);
      auto epi = [&](Acc128& acc, int r0, int c0, int fr, int fq) __attribute__((always_inline)) { epi_swiglu<2>(p, acc, r0, c0, fr, fq); };
      gemm256<2>(p.H(), p.Wt_gu() + (size_t)l * 5767168, 1024, pm * 256 + (hidx & 1) * 128, pn * 256, smem, epi);
    }
  }
}

DI void phase_i(const Params& p, int l, char* smem) {
  for (int it = blockIdx.x; it < 48 * 4; it += gridDim.x) {
    int pm, pn; tile_order(it, 48, 4, pm, pn);
    auto epi = [&](Acc256& acc, int r0, int c0, int fr, int fq) __attribute__((always_inline)) {
      if (l == 0) epi_res_ln<2>(p, 0, acc, r0, c0, fr, fq, smem, pm, pn); else epi_res_ln<2>(p, 1, acc, r0, c0, fr, fq, smem, pm, pn);
    };
    gemm256<4>(p.ACT(), p.Wt_dn() + (size_t)l * 2883584, 2816, pm * 256, pn * 256, smem, epi, false, false, 0, 0, p.out + (size_t)(pm * 256) * 1024 + pn * 256);
  }
  if (l == 0)
    idle_block_jobs(WJ_ALL, 48 * 4, [&](int e) __attribute__((always_inline)) { weight_job(p, 1, e, (float*)smem); });
}

#define GSYNC() xcd_barrier(xb)
DI void run_layer(const Params& p, const int l, char* smem, const XcdBarrier& xb, bool last) {
  phase_a(p, l, smem); GSYNC();
#if REP_K == 0
  phase_a(p, l, smem); GSYNC();
#endif
  phase_b(p, l, smem); GSYNC();
#if REP_K == 1
  phase_b(p, l, smem); GSYNC();
#endif
  phase_c(p, l, smem); GSYNC();
#if REP_K == 2
  phase_c(p, l, smem); GSYNC();
#endif
  phase_d(p, l, smem);
#if REP_K == 3
  GSYNC(); phase_d(p, l, smem, REP_SUB);
#endif
  GSYNC();
  phase_e(p, l, smem); GSYNC();
#if REP_K == 4
  phase_e(p, l, smem); GSYNC();
#endif
  phase_f(p, l, smem); GSYNC();
#if REP_K == 5
  if (l == 0) { phase_f(p, l, smem); GSYNC(); }
#endif
  phase_h(p, l, smem);
#if REP_K == 7
  GSYNC(); phase_h(p, l, smem);
#endif
  GSYNC();
  phase_i(p, l, smem);
  if (!last) GSYNC();
}

__global__ void __launch_bounds__(NT) __attribute__((target("no-packed-fp32-ops"))) mega(Params p) {
  extern __shared__ __attribute__((aligned(16))) char smem[];
  volatile LAS unsigned* xst = (volatile LAS unsigned*)(LAS char*)(smem + LDS_BYTES - 16);
  if (threadIdx.x == 0) { xst[0] = 0u; xst[1] = 0u; xst[2] = 0u; xst[3] = 0u; }
  __syncthreads();
  const XcdBarrier xb = xcd_barrier_post(p.bar(), xst);
  if (p.out == nullptr) cg::this_grid().sync();
  phase_pre1(p, smem); GSYNC();
#if REP_K == 10
  phase_pre1(p, smem); GSYNC();
#endif
  phase_pre2(p); GSYNC();
  run_layer(p, 0, smem, xb, false);
  run_layer(p, 1, smem, xb, true);
}

extern "C" void kernel_launch(void* const* d_in, const int* in_sizes, int n_in, void* d_out, int out_size, void* d_ws, size_t ws_size,
                              hipStream_t stream) {
  static int grid_blocks = 0;
  if (!grid_blocks) {
    int dev = 0, cus = 0, per_cu = 0;
    (void)hipGetDevice(&dev);
    (void)hipDeviceGetAttribute(&cus, hipDeviceAttributeMultiprocessorCount, dev);
    (void)hipFuncSetAttribute((const void*)mega, hipFuncAttributeMaxDynamicSharedMemorySize, LDS_BYTES);
    (void)hipOccupancyMaxActiveBlocksPerMultiprocessor(&per_cu, (const void*)mega, NT, LDS_BYTES);
    if (per_cu < 1) per_cu = 1;
    if (per_cu > 1) per_cu = 1;
    grid_blocks = cus * per_cu;
  }
  Params p{};
  const float** pin = (const float**)&p;
  for (int i = 0; i < 39; ++i) pin[i] = (const float*)d_in[i];
  p.out = (float*)d_out;
  p.ws = (char*)d_ws;
  if (WS_END > ws_size) { fprintf(stderr, "kernel_launch: workspace too small (%zu > %zu)\n", (size_t)WS_END, ws_size); return; }
  (void)hipMemsetAsync(p.ws + OFF_bar, 0, 16384, stream);
  void* args[] = {&p};
  hipError_t e = hipLaunchCooperativeKernel((const void*)mega, dim3(grid_blocks), dim3(NT), args, LDS_BYTES, stream);
  if (e != hipSuccess) fprintf(stderr, "cooperative launch failed: %s (grid %d)\n", hipGetErrorString(e), grid_blocks);
}
```

```cpp
#include <hip/hip_runtime.h>
#include <hip/hip_cooperative_groups.h>
#include <cstdio>
namespace cg = cooperative_groups;

#ifndef REP_K
#define REP_K -1
#endif
#ifndef REP_SUB
#define REP_SUB 0
#endif

typedef unsigned short u16;
typedef __bf16 bf2_t __attribute__((ext_vector_type(2)));
typedef float f2_t __attribute__((ext_vector_type(2)));
using bf16x8 = __attribute__((ext_vector_type(8))) short;
using f32x16 = __attribute__((ext_vector_type(16))) float;
using f32x4 = __attribute__((ext_vector_type(4))) float;
#define DI __device__ __forceinline__

DI unsigned pk2(float a, float b) { f2_t v = {a, b}; return __builtin_bit_cast(unsigned, __builtin_convertvector(v, bf2_t)); }
DI u16 f2bf(float a) { return (u16)(pk2(a, 0.f) & 0xffffu); }
DI float bf2f(u16 v) { return __uint_as_float(((unsigned)v) << 16); }
#define MFMA32(a, b, c) __builtin_amdgcn_mfma_f32_32x32x16_bf16((a), (b), (c), 0, 0, 0)
#define MFMA16(a, b, c) __builtin_amdgcn_mfma_f32_16x16x32_bf16((a), (b), (c), 0, 0, 0)

constexpr int TC = 4096, TD = 8192, TA = 12288, KA = 12800;
constexpr int NPH = 22;
constexpr int LDS_BYTES = 147456 + 16;
constexpr int NT = 512;
constexpr float ALPHA = 1.41421356237309515f;
constexpr float LOG2E = 1.44269504088896341f;
constexpr float QS_D = 0.17677669529663689f * LOG2E;
constexpr float QS_M = 0.10206207261596575f * LOG2E;
constexpr size_t O_DK = 12582912, O_DV = 14680064, O_CKV = 16777216, O_KR = 17825792, O_S5 = 18087936;

constexpr size_t al256(size_t x) { return (x + 255) & ~(size_t)255; }
constexpr size_t OFF_bar = 0;
constexpr size_t OFF_Wt_in = OFF_bar + al256(16384);
constexpr size_t OFF_Wt_out = OFF_Wt_in + al256(2ull*1572864*2);
constexpr size_t OFF_Wt_uq = OFF_Wt_out + al256(2ull*1048576*2);
constexpr size_t OFF_Wt_ukv = OFF_Wt_uq + al256(2ull*196608*2);
constexpr size_t OFF_Wt_glu = OFF_Wt_ukv + al256(2ull*262144*2);
constexpr size_t OFF_Wt_gu = OFF_Wt_glu + al256(2ull*65536*2);
constexpr size_t OFF_Wt_dn = OFF_Wt_gu + al256(2ull*5767168*2);
constexpr size_t OFF_mods = OFF_Wt_dn + al256(2ull*2883584*2);
constexpr size_t OFF_rope = OFF_mods + al256(2ull*3*6144*4);
constexpr size_t OFF_s5a = OFF_rope + al256(4096ull*16*8);
constexpr size_t OFF_s5bre = OFF_s5a + al256(4096ull*8);
constexpr size_t OFF_s5bim = OFF_s5bre + al256(4096ull*16*4);
constexpr size_t OFF_H = OFF_s5bim + al256(4096ull*16*4);
constexpr size_t OFF_CC = OFF_H + al256((size_t)TA*1024*2);
constexpr size_t OFF_Qd = OFF_CC + al256((size_t)TA*1024*2);
constexpr size_t OFF_Kd = OFF_Qd + al256((size_t)TA*256*2);
constexpr size_t OFF_VdT = OFF_Kd + al256((size_t)KA*256*2);
constexpr size_t OFF_QLN = OFF_VdT + al256((size_t)KA*256*2);
constexpr size_t OFF_CKV = OFF_QLN + al256((size_t)TA*256*2);
constexpr size_t OFF_KR = OFF_CKV + al256((size_t)KA*256*2);
constexpr size_t OFF_YG = OFF_KR + al256((size_t)KA*32*2);
constexpr size_t OFF_U = OFF_YG + al256((size_t)TA*256*2);
constexpr size_t OFF_QL = OFF_U + al256((size_t)TA*256*4);
constexpr size_t OFF_KVL = OFF_QL + al256((size_t)TA*256*4);
constexpr size_t OFF_FIN = OFF_KVL + al256((size_t)TA*128*4);
constexpr size_t OFF_CIN = OFF_FIN + al256(384ull*2*16*64*8);
constexpr size_t OFF_XCH = OFF_CIN + al256(384ull*2*16*64*8);
constexpr size_t OFF_Qm = OFF_XCH + al256(4ull*48*256*4*8);
constexpr size_t OFF_Km = OFF_Qm + al256((size_t)TA*768*2);
constexpr size_t OFF_VmT = OFF_Km + al256((size_t)KA*512*2);
constexpr size_t OFF_ODIFF = OFF_VmT + al256((size_t)KA*512*2);
constexpr size_t WS_END = OFF_ODIFF + al256((size_t)TA*512*4);
constexpr size_t OFF_ACT = OFF_Qm;
static_assert(OFF_ACT + (size_t)TA * 2816 * 2 <= WS_END, "ACT alias region too small");
static_assert(WS_END <= 268435456ull, "workspace exceeds 256 MiB");

struct Params {
  const float *x_prompt, *x_sample, *c, *cache_k, *cache_v, *cache_ckv, *cache_kr, *state_s5, *c_ctx;
  const float *w_ada, *b_ada, *w_in, *w_out, *lq1, *lk1, *lq2, *lk2, *diff_g;
  const float *s5_lre, *s5_lim, *s5_ldt, *s5_bre, *s5_bim, *s5_cre, *s5_cim, *s5_d, *w_glu;
  const float *q_g, *w_uq, *kv_g, *w_uk, *w_uv, *ln1g, *ln1b, *ln2g, *ln2b, *w_gate, *w_up, *w_down;
  float* out;
  char* ws;
  DI unsigned* bar() const { return (unsigned*)(ws + OFF_bar); }
  DI u16* Wt_in() const { return (u16*)(ws + OFF_Wt_in); }
  DI u16* Wt_out() const { return (u16*)(ws + OFF_Wt_out); }
  DI u16* Wt_uq() const { return (u16*)(ws + OFF_Wt_uq); }
  DI u16* Wt_ukv() const { return (u16*)(ws + OFF_Wt_ukv); }
  DI u16* Wt_glu() const { return (u16*)(ws + OFF_Wt_glu); }
  DI u16* Wt_gu() const { return (u16*)(ws + OFF_Wt_gu); }
  DI u16* Wt_dn() const { return (u16*)(ws + OFF_Wt_dn); }
  DI float* mods() const { return (float*)(ws + OFF_mods); }
  DI float2* rope() const { return (float2*)(ws + OFF_rope); }
  DI float2* s5a() const { return (float2*)(ws + OFF_s5a); }
  DI float* s5bre() const { return (float*)(ws + OFF_s5bre); }
  DI float* s5bim() const { return (float*)(ws + OFF_s5bim); }
  DI u16* H() const { return (u16*)(ws + OFF_H); }
  DI u16* CC() const { return (u16*)(ws + OFF_CC); }
  DI u16* Qd() const { return (u16*)(ws + OFF_Qd); }
  DI u16* Kd() const { return (u16*)(ws + OFF_Kd); }
  DI u16* VdT() const { return (u16*)(ws + OFF_VdT); }
  DI u16* QLN() const { return (u16*)(ws + OFF_QLN); }
  DI u16* CKV() const { return (u16*)(ws + OFF_CKV); }
  DI u16* KR() const { return (u16*)(ws + OFF_KR); }
  DI u16* YG() const { return (u16*)(ws + OFF_YG); }
  DI float* U() const { return (float*)(ws + OFF_U); }
  DI float* QL() const { return (float*)(ws + OFF_QL); }
  DI float* KVL() const { return (float*)(ws + OFF_KVL); }
  DI float2* FIN() const { return (float2*)(ws + OFF_FIN); }
  DI float2* CIN() const { return (float2*)(ws + OFF_CIN); }
  DI float2* XCH() const { return (float2*)(ws + OFF_XCH); }
  DI u16* Qm() const { return (u16*)(ws + OFF_Qm); }
  DI u16* Km() const { return (u16*)(ws + OFF_Km); }
  DI u16* VmT() const { return (u16*)(ws + OFF_VmT); }
  DI float* ODIFF() const { return (float*)(ws + OFF_ODIFF); }
  DI u16* ACT() const { return (u16*)(ws + OFF_ACT); }
};

DI int tidx() { int t = threadIdx.x; asm volatile("" : "+v"(t)); return t; }
DI int tok_cond(int t) { return t < TC ? 0 : 1 + ((t - TC) >> 12); }
DI int tok_pos(int t) { return t < TC ? (t & 255) : ((t - TC) & 4095); }
DI int tok_key(int t) { return t < TC ? t : TC + ((t - TC) >> 12) * 4352 + ((t - TC) & 4095); }
DI float wave_sum(float v) {
#pragma unroll
  for (int o = 32; o; o >>= 1) v += __shfl_xor(v, o);
  return v;
}
DI float row16_sum(float v) {
  v += __builtin_bit_cast(float, __builtin_amdgcn_update_dpp(0, __builtin_bit_cast(int, v), 0xB1, 0xF, 0xF, true));
  v += __builtin_bit_cast(float, __builtin_amdgcn_update_dpp(0, __builtin_bit_cast(int, v), 0x4E, 0xF, 0xF, true));
  v += __builtin_bit_cast(float, __builtin_amdgcn_update_dpp(0, __builtin_bit_cast(int, v), 0x141, 0xF, 0xF, true));
  v += __builtin_bit_cast(float, __builtin_amdgcn_update_dpp(0, __builtin_bit_cast(int, v), 0x140, 0xF, 0xF, true));
  return v;
}
DI int crow(int reg, int h) { return (reg & 3) + 8 * (reg >> 2) + 4 * h; }
DI void lds_fence() { asm volatile("s_waitcnt lgkmcnt(0)" ::: "memory"); }
DI float sigmoidf(float x) { return 1.f / (1.f + __expf(-x)); }

DI void sincos_d(double x, float& s, float& c) {
  const double TWO_PI = 6.283185307179586476925;
  double k = rint(x / TWO_PI);
  double r = x - k * TWO_PI;
  double r2 = r * r, ss = 1.0, cc = 1.0;
#pragma unroll
  for (int n = 13; n >= 1; --n) {
    ss = 1.0 - r2 * (1.0 / (double)((2 * n) * (2 * n + 1))) * ss;
    cc = 1.0 - r2 * (1.0 / (double)((2 * n - 1) * (2 * n))) * cc;
  }
  s = (float)(r * ss); c = (float)cc;
}

#define LAS __attribute__((address_space(3)))
DI int lds_byte(int r, int c) { int st = (r >> 4) * 2 + (c >> 5), rr = r & 15, cc = c & 31, ob = rr * 64 + cc * 2; return st * 1024 + (ob ^ (((ob >> 9) & 1) << 5)); }
DI void stage_rc(int b, int& R, int& C) { int st = b / 1024, sb = b % 1024, swz = sb ^ (((sb >> 9) & 1) << 5); R = (st >> 1) * 16 + swz / 64; C = (st & 1) * 32 + (swz % 64) / 2; }
DI void tile_order(int L, int nM, int nN, int& pm, int& pn) {
  const int nwg = nM * nN; int wgid = L;
  { const int q = nwg / 8, r = nwg % 8, xcd = wgid % 8, off = wgid / 8; wgid = (xcd < r ? xcd * (q + 1) : r * (q + 1) + (xcd - r) * q) + off; }
  const int nig = 8 * nN, gid = wgid / nig, fm = gid * 8, gsz = min(nM - fm, 8);
  pm = fm + ((wgid % nig) % gsz); pn = (wgid % nig) / gsz;
}
template <int MT, class Epi>
DI void gemm256(const u16* A, const u16* Bt, int Kc, int brow, int bcol, char* smem, Epi epi, bool prestaged = false, bool has_next = false, int nbrow = 0, int nbcol = 0,
                const float* pf_tile = nullptr) {
  constexpr int HTB = 16384;
  const int K = Kc;
  LAS char* lds = (LAS char*)smem;
  const int tid = tidx(), wid = tid >> 6, lane = tid & 63, wr = wid >> 2, wc = wid & 3, fr = lane & 15, fq = lane >> 4;
  unsigned voff[2];
#pragma unroll
  for (int i = 0; i < 2; ++i) { int R, C; stage_rc(tid * 16 + i * 8192, R, C); voff[i] = (unsigned)(R * K + C) * 2u; }
  const unsigned ldsw = (unsigned)wid * 1024u;
  const int aoff = lds_byte(wr * (16 * MT) + fr, fq * 8), boff = lds_byte(wc * 32 + fr, fq * 8);
  const char* Ab = (const char*)(A + (size_t)brow * K);
  const char* Bb = (const char*)(Bt + (size_t)bcol * K);
  const size_t hstepA = (size_t)(32 * MT) * K * 2, hstepB = (size_t)128 * K * 2;
#define G_SA(b, h) (((b) * 2 + (h)) * HTB)
#define G_SB(b, h) ((4 + (b) * 2 + (h)) * HTB)
#define G_STAGE_(bufoff, gbase, hh, kt, hs) do { const char* _g = (gbase) + (hh) * (hs) + (size_t)(kt) * 128; _Pragma("unroll") for (int _i = 0; _i < 2; ++_i) \
    __builtin_amdgcn_global_load_lds((const unsigned*)(_g + voff[_i]), (LAS unsigned*)(lds + (bufoff) + ldsw + _i * 8192), 16, 0, 0); } while (0)
#define G_LDA(dst, b, h) do { _Pragma("unroll") for (int m = 0; m < MT; ++m) _Pragma("unroll") for (int k = 0; k < 2; ++k) dst[m][k] = *(const LAS bf16x8*)(lds + G_SA(b, h) + aoff + m * 2048 + k * 1024); } while (0)
#define G_LDB(dst, b, h) do { _Pragma("unroll") for (int n = 0; n < 2; ++n) _Pragma("unroll") for (int k = 0; k < 2; ++k) dst[n][k] = *(const LAS bf16x8*)(lds + G_SB(b, h) + boff + n * 2048 + k * 1024); } while (0)
#define G_MMA(ai, bj, At, Bq) do { __builtin_amdgcn_s_setprio(1); _Pragma("unroll") for (int m = 0; m < MT; ++m) _Pragma("unroll") for (int n = 0; n < 2; ++n) _Pragma("unroll") for (int k = 0; k < 2; ++k) \
    acc[ai][bj][m][n] = MFMA16(At[m][k], Bq[n][k], acc[ai][bj][m][n]); __builtin_amdgcn_s_setprio(0); } while (0)
#define WAIT_V(n) asm volatile("s_waitcnt vmcnt(" #n ")" ::: "memory")
#define WAIT_L(n) asm volatile("s_waitcnt lgkmcnt(" #n ")" ::: "memory")
#define BAR __builtin_amdgcn_s_barrier()
#define SCHED __builtin_amdgcn_sched_barrier(0)
  f32x4 acc[2][2][MT][2];
#pragma unroll
  for (int a = 0; a < 2; ++a)
#pragma unroll
    for (int b = 0; b < 2; ++b)
#pragma unroll
      for (int m = 0; m < MT; ++m)
#pragma unroll
        for (int n = 0; n < 2; ++n) acc[a][b][m][n] = f32x4{0.f, 0.f, 0.f, 0.f};
  bf16x8 At[MT][2], B0[2][2], B1[2][2];
  const int nt = K / 64;
  if (!prestaged) {
    G_STAGE_(G_SB(0, 0), Bb, 0, 0, hstepB); G_STAGE_(G_SA(0, 0), Ab, 0, 0, hstepA);
    G_STAGE_(G_SB(0, 1), Bb, 1, 0, hstepB); G_STAGE_(G_SA(0, 1), Ab, 1, 0, hstepA);
  }
  if (wr == 1) BAR;
  WAIT_V(4); BAR;
  G_STAGE_(G_SB(1, 0), Bb, 0, 1, hstepB); G_STAGE_(G_SA(1, 0), Ab, 0, 1, hstepA); G_STAGE_(G_SB(1, 1), Bb, 1, 1, hstepB);
  WAIT_V(6); BAR;
  for (int t = 0; t < nt - 2; t += 2) {
    G_LDB(B0, 0, 0); SCHED; G_LDA(At, 0, 0); G_STAGE_(G_SA(1, 1), Ab, 1, t + 1, hstepA);
    if (MT == 4) WAIT_L(8); else WAIT_L(4); BAR; WAIT_L(0); G_MMA(0, 0, At, B0); BAR; SCHED;
    G_LDB(B1, 0, 1); G_STAGE_(G_SB(0, 0), Bb, 0, t + 2, hstepB);
    BAR; WAIT_L(0); G_MMA(0, 1, At, B1); BAR;
    G_LDA(At, 0, 1); G_STAGE_(G_SA(0, 0), Ab, 0, t + 2, hstepA);
    BAR; WAIT_L(0); G_MMA(1, 0, At, B0); BAR; SCHED;
    G_STAGE_(G_SB(0, 1), Bb, 1, t + 2, hstepB);
    WAIT_V(6); BAR; G_MMA(1, 1, At, B1); BAR;
    G_LDB(B0, 1, 0); SCHED; G_LDA(At, 1, 0); G_STAGE_(G_SA(0, 1), Ab, 1, t + 2, hstepA);
    if (MT == 4) WAIT_L(8); else WAIT_L(4); BAR; WAIT_L(0); G_MMA(0, 0, At, B0); BAR; SCHED;
    G_LDB(B1, 1, 1); G_STAGE_(G_SB(1, 0), Bb, 0, t + 3, hstepB);
    BAR; WAIT_L(0); G_MMA(0, 1, At, B1); BAR;
    G_LDA(At, 1, 1); G_STAGE_(G_SA(1, 0), Ab, 0, t + 3, hstepA);
    BAR; WAIT_L(0); G_MMA(1, 0, At, B0); BAR; SCHED;
    G_STAGE_(G_SB(1, 1), Bb, 1, t + 3, hstepB);
    WAIT_V(6); BAR; G_MMA(1, 1, At, B1); BAR;
  }
  { G_LDB(B0, 0, 0); G_LDA(At, 0, 0); G_STAGE_(G_SA(1, 1), Ab, 1, nt - 1, hstepA);
    if (pf_tile) {
#pragma unroll
      for (int i = 0; i < 4; ++i) {
        const int line = tid + 512 * i;
        __builtin_amdgcn_global_load_lds((const unsigned*)(pf_tile + (size_t)(line >> 3) * 1024 + (line & 7) * 32), (LAS unsigned*)(lds + 131072 + (i * 8 + wid) * 256), 4, 0, 0);
      }
    }
    BAR; WAIT_L(0); G_MMA(0, 0, At, B0); BAR;
    G_LDB(B1, 0, 1); BAR; WAIT_L(0); G_MMA(0, 1, At, B1); BAR;
    G_LDA(At, 0, 1); WAIT_V(4); BAR; WAIT_L(0); G_MMA(1, 0, At, B0); G_MMA(1, 1, At, B1); BAR; }
  { G_LDB(B0, 1, 0); G_LDA(At, 1, 0); WAIT_V(2); BAR; WAIT_L(0); G_MMA(0, 0, At, B0); BAR;
    G_LDB(B1, 1, 1); WAIT_V(0); BAR; WAIT_L(0); G_MMA(0, 1, At, B1); BAR;
    G_LDA(At, 1, 1); BAR; WAIT_L(0); G_MMA(1, 0, At, B0); G_MMA(1, 1, At, B1); BAR; }
  if (wr == 0) BAR;
  if (has_next) {
    const char* Ab2 = (const char*)(A + (size_t)nbrow * K); const char* Bb2 = (const char*)(Bt + (size_t)nbcol * K);
    G_STAGE_(G_SB(0, 0), Bb2, 0, 0, hstepB); G_STAGE_(G_SA(0, 0), Ab2, 0, 0, hstepA);
    G_STAGE_(G_SB(0, 1), Bb2, 1, 0, hstepB); G_STAGE_(G_SA(0, 1), Ab2, 1, 0, hstepA);
  }
  epi(acc, brow + wr * (16 * MT), bcol + wc * 32, fr, fq);
}

DI void transpose_strip(const float* src, int N, int k0, int n0, u16* dst, int ldd, int mode, int rowoff, float* tl) {
  const int tid = tidx(), c = tid & 63, r0 = tid >> 6;
  float v[4][8];
#pragma unroll
  for (int q = 0; q < 4; ++q)
#pragma unroll
    for (int i = 0; i < 8; ++i) {
      const int n = n0 + 64 * q + c;
      v[q][i] = (n < N) ? __builtin_nontemporal_load(src + (size_t)(k0 + r0 + 8 * i) * N + n) : 0.f;
    }
#pragma unroll
  for (int q = 0; q < 4; ++q)
#pragma unroll
    for (int i = 0; i < 8; ++i) tl[q * 4160 + (r0 + 8 * i) * 65 + c] = v[q][i];
  __syncthreads();
  const int nl = tid >> 3, kq = tid & 7;
#pragma unroll
  for (int q = 0; q < 4; ++q) {
    const int n = n0 + 64 * q + nl;
    if (n < N) {
      int drow = (mode == 0) ? (n + rowoff) : ((n >> 4) * 32 + (n & 15) + (mode == 2 ? 16 : 0));
      unsigned pk[4];
#pragma unroll
      for (int j = 0; j < 4; ++j) pk[j] = pk2(tl[q * 4160 + (8 * kq + 2 * j) * 65 + nl], tl[q * 4160 + (8 * kq + 2 * j + 1) * 65 + nl]);
      *(uint4*)(dst + (size_t)drow * ldd + k0 + 8 * kq) = make_uint4(pk[0], pk[1], pk[2], pk[3]);
    }
  }
  __syncthreads();
}

constexpr int WJ_IN = 16 * 6, WJ_UQ = 4 * 3, WJ_UK = 2 * 2, WJ_UV = 2 * 2, WJ_GLU = 4 * 1, WJ_OUT = 16 * 4, WJ_G = 16 * 11, WJ_U = 16 * 11, WJ_D = 44 * 4;
constexpr int WJ_EARLY = WJ_IN + WJ_UQ + WJ_UK + WJ_UV + WJ_GLU, WJ_ALL = WJ_EARLY + WJ_OUT + WJ_G + WJ_U + WJ_D;
DI void weight_job(const Params& p, int l, int j, float* tl) {
  if (j < WJ_IN) { transpose_strip(p.w_in + (size_t)l * 1024 * 1440, 1440, (j % 16) * 64, (j / 16) * 256, p.Wt_in() + (size_t)l * 1572864, 1024, 0, 0, tl); return; }
  j -= WJ_IN;
  if (j < WJ_UQ) { transpose_strip(p.w_uq + (size_t)l * 196608, 768, (j % 4) * 64, (j / 4) * 256, p.Wt_uq() + (size_t)l * 196608, 256, 0, 0, tl); return; }
  j -= WJ_UQ;
  if (j < WJ_UK) { transpose_strip(p.w_uk + (size_t)l * 65536, 512, (j % 2) * 64, (j / 2) * 256, p.Wt_ukv() + (size_t)l * 262144, 256, 0, 0, tl); return; }
  j -= WJ_UK;
  if (j < WJ_UV) { transpose_strip(p.w_uv + (size_t)l * 65536, 512, (j % 2) * 64, (j / 2) * 256, p.Wt_ukv() + (size_t)l * 262144, 256, 0, 512, tl); return; }
  j -= WJ_UV;
  if (j < WJ_GLU) { transpose_strip(p.w_glu + (size_t)l * 65536, 256, (j % 4) * 64, (j / 4) * 256, p.Wt_glu() + (size_t)l * 65536, 256, 0, 0, tl); return; }
  j -= WJ_GLU;
  if (j < WJ_OUT) { transpose_strip(p.w_out + (size_t)l * 1048576, 1024, (j % 16) * 64, (j / 16) * 256, p.Wt_out() + (size_t)l * 1048576, 1024, 0, 0, tl); return; }
  j -= WJ_OUT;
  if (j < WJ_G) { transpose_strip(p.w_gate + (size_t)l * 2883584, 2816, (j % 16) * 64, (j / 16) * 256, p.Wt_gu() + (size_t)l * 5767168, 1024, 1, 0, tl); return; }
  j -= WJ_G;
  if (j < WJ_U) { transpose_strip(p.w_up + (size_t)l * 2883584, 2816, (j % 16) * 64, (j / 16) * 256, p.Wt_gu() + (size_t)l * 5767168, 1024, 2, 0, tl); return; }
  j -= WJ_U;
  transpose_strip(p.w_down + (size_t)l * 2883584, 1024, (j % 44) * 64, (j / 44) * 256, p.Wt_dn() + (size_t)l * 2883584, 2816, 0, 0, tl);
}
template <class F>
DI void idle_block_jobs(int n, int first_idle, F f) {
  const int G = gridDim.x, nidle = G - first_idle;
  if (nidle > 0) { if ((int)blockIdx.x >= first_idle) for (int e = blockIdx.x - first_idle; e < n; e += nidle) f(e); }
  else for (int e = blockIdx.x; e < n; e += G) f(e);
}

DI void phase_pre1(const Params& p, char* smem) {
  const int tid = tidx();
  float* tl = (float*)smem;
  constexpr int N_T = WJ_EARLY + WJ_OUT, N_MODS = 192, N_ROPE = 128, N_S5 = 8, N_ZP = 32;
  for (int it = blockIdx.x; it < N_T + N_MODS + N_ROPE + N_S5 + N_ZP; it += gridDim.x) {
    if (it >= N_T + N_MODS + N_ROPE + N_S5) {
      const int zj = it - (N_T + N_MODS + N_ROPE + N_S5);
#pragma unroll
      for (int i = 0; i < 2; ++i) { const int c = tid + NT * i, row = zj * 64 + (c >> 4), ch = c & 15; *(uint4*)(p.Wt_ukv() + (size_t)row * 256 + 128 + ch * 8) = make_uint4(0, 0, 0, 0); }
      continue;
    }
    if (it >= N_MODS && it < N_MODS + N_T) { weight_job(p, 0, it - N_MODS, tl); continue; }
    if (it < N_MODS) {
      const int j = it, l = j / 96, cg0 = (j % 96) * 64;
      float* sil = (float*)smem;
      float* red = sil + 3072;
      for (int i = tid; i < 3072; i += NT) {
        int ci = i >> 10, k = i & 1023;
        float cv = (ci == 0) ? p.c_ctx[k] : p.c[(ci - 1) * 1024 + k];
        sil[i] = cv * sigmoidf(cv);
      }
      __syncthreads();
      const int w = tid >> 6, lane = tid & 63, n = cg0 + lane;
      float a0 = 0.f, a1 = 0.f, a2 = 0.f;
      const float* wp = p.w_ada + (size_t)l * 1024 * 6144 + n;
#pragma unroll 32
      for (int k = w * 128; k < w * 128 + 128; ++k) {
        float wv = __builtin_nontemporal_load(wp + (size_t)k * 6144);
        a0 += sil[k] * wv; a1 += sil[1024 + k] * wv; a2 += sil[2048 + k] * wv;
      }
      red[(w * 3 + 0) * 64 + lane] = a0; red[(w * 3 + 1) * 64 + lane] = a1; red[(w * 3 + 2) * 64 + lane] = a2;
      __syncthreads();
      if (tid < 192) {
        int ci = tid >> 6, ln = tid & 63;
        float sm = 0.f;
#pragma unroll
        for (int ww = 0; ww < 8; ++ww) sm += red[(ww * 3 + ci) * 64 + ln];
        p.mods()[(size_t)(l * 3 + ci) * 6144 + cg0 + ln] = sm + p.b_ada[l * 6144 + cg0 + ln];
      }
      __syncthreads();
      continue;
    }
    int j = it - N_MODS - N_T;
    if (j < N_ROPE) {
      int idx = j * NT + tid, pos = idx >> 4, i = idx & 15, f = i & 7;
      double v = 1.0;
      for (int q = 0; q < (f >> 1); ++q) v *= 0.1;
      if (f & 1) v *= 0.31622776601683794;
      float inv = (float)v;
      float ang = (float)((i < 8) ? (pos >> 6) : (pos & 63)) * inv;
      float sn, cs; sincos_d((double)ang, sn, cs);
      p.rope()[idx] = make_float2(cs, sn);
      continue;
    }
    j -= N_ROPE;
    {
      int e = j * NT + tid;
      float lre = p.s5_lre[e], lim = p.s5_lim[e], dt = expf(p.s5_ldt[e >> 6]);
      float mag = expf(lre * dt), ang = lim * dt, sn, cs;
      sincos_d((double)ang, sn, cs);
      float are = mag * cs, aim = mag * sn;
      float den = lre * lre + lim * lim, nre = are - 1.f, nim = aim;
      float fre = (nre * lre + nim * lim) / den, fim = (nim * lre - nre * lim) / den;
      p.s5a()[e] = make_float2(are, aim);
#pragma unroll
      for (int ch = 0; ch < 16; ++ch) {
        float br = p.s5_bre[(size_t)e * 16 + ch], bi = p.s5_bim[(size_t)e * 16 + ch];
        p.s5bre()[(size_t)e * 16 + ch] = fre * br - fim * bi;
        p.s5bim()[(size_t)e * 16 + ch] = fre * bi + fim * br;
      }
    }
  }
}

DI void store_h(const Params& p, int t, int lm, int scc, int shc, const float* v, int lane) {
  const float* mb = p.mods() + (size_t)(lm * 3 + tok_cond(t)) * 6144;
#pragma unroll
  for (int j = 0; j < 4; ++j) {
    int col = lane * 4 + 256 * j;
    float4 sc = *(const float4*)(mb + scc * 1024 + col), sh = *(const float4*)(mb + shc * 1024 + col);
    uint2 o;
    o.x = pk2(v[4 * j] * (1.f + sc.x) + sh.x, v[4 * j + 1] * (1.f + sc.y) + sh.y);
    o.y = pk2(v[4 * j + 2] * (1.f + sc.z) + sh.z, v[4 * j + 3] * (1.f + sc.w) + sh.w);
    *(uint2*)(p.H() + (size_t)t * 1024 + col) = o;
  }
}

DI void phase_pre2(const Params& p) {
  const int lane = tidx() & 63, w = tidx() >> 6;
  for (int it = blockIdx.x; it < TA / 8; it += gridDim.x) {
    int t = it * 8 + w;
    const float* xr = (t < TC) ? p.x_prompt + (size_t)t * 1024 : p.x_sample + (size_t)(t - TC) * 1024;
    float v[16];
#pragma unroll
    for (int j = 0; j < 4; ++j) { float4 x = *(const float4*)(xr + lane * 4 + 256 * j); v[4 * j] = x.x; v[4 * j + 1] = x.y; v[4 * j + 2] = x.z; v[4 * j + 3] = x.w; }
    store_h(p, t, 0, 1, 0, v, lane);
  }
}

DI void phase_ln(const Params& p, int l, int which) {
  const int lane = tidx() & 63, w = tidx() >> 6;
  const float* gp = (which == 1 ? p.ln1g : p.ln2g) + l * 1024;
  const float* bp = (which == 1 ? p.ln1b : p.ln2b) + l * 1024;
  for (int it = blockIdx.x; it < TA / 8; it += gridDim.x) {
    int t = it * 8 + w;
    float* xr = p.out + (size_t)t * 1024;
    float v[16]; float s = 0.f;
#pragma unroll
    for (int j = 0; j < 4; ++j) { float4 x = *(const float4*)(xr + lane * 4 + 256 * j); v[4 * j] = x.x; v[4 * j + 1] = x.y; v[4 * j + 2] = x.z; v[4 * j + 3] = x.w; s += x.x + x.y + x.z + x.w; }
    float mean = wave_sum(s) * (1.f / 1024.f);
    float q = 0.f;
#pragma unroll
    for (int i = 0; i < 16; ++i) { float d = v[i] - mean; q += d * d; }
    float rs = rsqrtf(wave_sum(q) * (1.f / 1024.f) + 1e-5f);
#pragma unroll
    for (int j = 0; j < 4; ++j) {
      int col = lane * 4 + 256 * j;
      float4 g = *(const float4*)(gp + col), b = *(const float4*)(bp + col);
      v[4 * j] = (v[4 * j] - mean) * rs * g.x + b.x; v[4 * j + 1] = (v[4 * j + 1] - mean) * rs * g.y + b.y;
      v[4 * j + 2] = (v[4 * j + 2] - mean) * rs * g.z + b.z; v[4 * j + 3] = (v[4 * j + 3] - mean) * rs * g.w + b.w;
      *(float4*)(xr + col) = make_float4(v[4 * j], v[4 * j + 1], v[4 * j + 2], v[4 * j + 3]);
    }
    if (which == 1) store_h(p, t, l, 4, 3, v, lane);
    else if (l + 1 < 2) store_h(p, t, l + 1, 1, 0, v, lane);
  }
}

typedef f32x4 Acc256[2][2][4][2];
typedef f32x4 Acc128[2][2][2][2];

#define XB_TMO      128
#define XB_XCNT(j)  (256  + 64 * (j))
#define XB_XSUB(j)  (1280 + 64 * (j))
#define XB_XGEN(j)  (2304 + 64 * (j))
#define XB_TOP      3328
#define XB_TOPGEN   3392
#define XCD_BAR_WORDS 3456
#define XB_SPIN_CAP (1u << 18)
DI unsigned xb_ld(unsigned* p) { return __hip_atomic_load(p, __ATOMIC_RELAXED, __HIP_MEMORY_SCOPE_AGENT); }
DI unsigned xb_add(unsigned* p, unsigned v) { return __hip_atomic_fetch_add(p, v, __ATOMIC_RELAXED, __HIP_MEMORY_SCOPE_AGENT); }
DI unsigned xb_xcc_id() { return (unsigned)__builtin_amdgcn_s_getreg((3 << 11) | 20) & 0xFu; }
#define XB_SPIN(cond, bar) do { unsigned _sp = 0; while (cond) { __builtin_amdgcn_s_sleep(1); \
    if ((++_sp & 255u) == 0u) { if (xb_ld(&(bar)[XB_TMO])) break; if (_sp > XB_SPIN_CAP) { atomicAdd(&(bar)[XB_TMO], 1u); break; } } } } while (0)
struct XcdBarrier { unsigned* bar; unsigned x; volatile LAS unsigned* st; };
DI XcdBarrier xcd_barrier_post(unsigned* bar, volatile LAS unsigned* st) {
  XcdBarrier b; b.bar = bar; b.x = xb_xcc_id(); b.st = st;
  if (threadIdx.x == 0) (void)xb_add(&bar[XB_XCNT(b.x)], 1u);
  return b;
}
DI void xcd_barrier_complete(unsigned* bar, unsigned x, unsigned& nloc, unsigned& nx) {
  const unsigned G = gridDim.x * gridDim.y * gridDim.z;
  unsigned sum, cnt, mine, sp = 0u;
  for (;;) {
    sum = 0u; cnt = 0u; mine = 0u;
#pragma unroll
    for (unsigned j = 0; j < 16; ++j) { const unsigned c = xb_ld(&bar[XB_XCNT(j)]); sum += c; cnt += (c > 0u) ? 1u : 0u; mine = (j == x) ? c : mine; }
    if (sum == G) break;
    __builtin_amdgcn_s_sleep(1);
    if ((++sp & 255u) == 0u) { if (xb_ld(&bar[XB_TMO])) break; if (sp > XB_SPIN_CAP) { atomicAdd(&bar[XB_TMO], 1u); break; } }
  }
  nloc = mine > 0u ? mine : 1u; nx = cnt > 0u ? cnt : 1u;
}
DI void xcd_barrier(const XcdBarrier& b) {
  asm volatile("s_waitcnt vmcnt(0)" ::: "memory");
  __syncthreads();
  if (threadIdx.x == 0) {
    unsigned* bar = b.bar;
    __builtin_amdgcn_s_waitcnt(0);
    unsigned nloc = b.st[0], nx = b.st[1];
    if (nloc == 0u) { xcd_barrier_complete(bar, b.x, nloc, nx); b.st[0] = nloc; b.st[1] = nx; }
    const unsigned old = xb_add(&bar[XB_XSUB(b.x)], 1u);
    const unsigned gen = old / nloc;
    if (old + 1u == (gen + 1u) * nloc) {
      __builtin_amdgcn_fence(__ATOMIC_RELEASE, "agent");
      asm volatile("s_waitcnt vmcnt(0)" ::: "memory");
      const unsigned og = xb_add(&bar[XB_TOP], 1u);
      const unsigned tg = og / nx;
      if (og + 1u == (tg + 1u) * nx) xb_add(&bar[XB_TOPGEN], 1u);
      else XB_SPIN(xb_ld(&bar[XB_TOPGEN]) == tg, bar);
      __builtin_amdgcn_fence(__ATOMIC_ACQUIRE, "agent");
      xb_add(&bar[XB_XGEN(b.x)], 1u);
      asm volatile("s_waitcnt vmcnt(0)" ::: "memory");
    } else {
      XB_SPIN(xb_ld(&bar[XB_XGEN(b.x)]) == gen, bar);
      __builtin_amdgcn_fence(__ATOMIC_ACQUIRE, "agent");
      asm volatile("s_waitcnt vmcnt(0)" ::: "memory");
    }
  }
  __syncthreads();
}

DI void phase_a(const Params& p, int l, char* smem) {
  constexpr int NG = 48 * 5;
  bool pre = false;
  for (int it = blockIdx.x; it < NG + 256 + 200; it += gridDim.x) {
    if (it >= NG + 256) {
      const int zj = it - NG - 256, tid = tidx();
#pragma unroll
      for (int i = 0; i < 2; ++i) { const int c = tid + NT * i, row = zj * 64 + (c >> 4), ch = c & 15; *(uint4*)(p.CKV() + (size_t)row * 256 + 128 + ch * 8) = make_uint4(0, 0, 0, 0); }
      continue;
    }
    if (it < NG) {
      int pm, pn, npm = 0, npn = 0; tile_order(it, 48, 5, pm, pn);
      const bool hn = (it + (int)gridDim.x) < NG; if (hn) tile_order(it + gridDim.x, 48, 5, npm, npn);
      auto epi = [&](Acc256& acc, int r0, int c0, int fr, int fq) __attribute__((always_inline)) {
#pragma unroll
        for (int ai = 0; ai < 2; ++ai)
#pragma unroll
          for (int bj = 0; bj < 2; ++bj) {
            const int colbase = c0 + bj * 128;
            if (colbase >= 1440) continue;
            const int cb = colbase >> 5;
#pragma unroll
            for (int m = 0; m < 4; ++m) {
              const int rowb = r0 + ai * 128 + m * 16 + fq * 4;
              const bool ctx = rowb < TC;
              const f32x4 a0 = acc[ai][bj][m][0], a1 = acc[ai][bj][m][1];
              if (cb < 16 || cb == 44) {
#pragma unroll
                for (int j = 0; j < 4; ++j) {
                  const int row = rowb + j;
                  float v0 = a0[j], v1 = a1[j];
                  const float raw0 = v0, raw1 = v1;
                  if (!ctx) {
                    float2 cs = p.rope()[tok_pos(row) * 16 + fr];
                    float t0 = v0 * cs.x - v1 * cs.y, t1 = v1 * cs.x + v0 * cs.y;
                    v0 = t0; v1 = t1;
                  }
                  if (cb < 8) {
                    u16* q = p.Qd() + (size_t)row * 256 + colbase + fr;
                    q[0] = f2bf(v0 * QS_D); q[16] = f2bf(v1 * QS_D);
                  } else if (cb < 16) {
                    const int cc = colbase - 256 + fr;
                    if (ctx) { float* o = p.out + O_DK + ((size_t)((row >> 8) * 2 + l) * 256 + (row & 255)) * 256 + cc; __builtin_nontemporal_store(raw0, o); __builtin_nontemporal_store(raw1, o + 16); }
                    u16* k = p.Kd() + (size_t)tok_key(row) * 256 + cc;
                    k[0] = f2bf(v0); k[16] = f2bf(v1);
                  } else {
                    if (ctx) { float* o = p.out + O_KR + ((size_t)((row >> 8) * 2 + l) * 256 + (row & 255)) * 32 + fr; o[0] = raw0; o[16] = raw1; }
                    u16* k = p.KR() + (size_t)tok_key(row) * 32 + fr;
                    k[0] = f2bf(v0); k[16] = f2bf(v1);
                  }
                }
              } else if (cb < 24) {
                const int cc = colbase - 512 + fr;
                if (ctx) {
#pragma unroll
                  for (int j = 0; j < 4; ++j) {
                    float* o = p.out + O_DV + ((size_t)(((rowb + j) >> 8) * 2 + l) * 256 + ((rowb + j) & 255)) * 256 + cc;
                    __builtin_nontemporal_store(a0[j], o); __builtin_nontemporal_store(a1[j], o + 16);
                  }
                }
                const size_t key = tok_key(rowb);
                *(uint2*)(p.VdT() + (size_t)cc * KA + key) = make_uint2(pk2(a0[0], a0[1]), pk2(a0[2], a0[3]));
                *(uint2*)(p.VdT() + (size_t)(cc + 16) * KA + key) = make_uint2(pk2(a1[0], a1[1]), pk2(a1[2], a1[3]));
              } else {
                float* dst; int ld, c2;
                if (cb < 32) { dst = p.U(); ld = 256; c2 = colbase - 768 + fr; }
                else if (cb < 40) { dst = p.QL(); ld = 256; c2 = colbase - 1024 + fr; }
                else { dst = p.KVL(); ld = 128; c2 = colbase - 1280 + fr; }
#pragma unroll
                for (int j = 0; j < 4; ++j) { float* o = dst + (size_t)(rowb + j) * ld + c2; o[0] = a0[j]; o[16] = a1[j]; }
              }
              SCHED;
            }
          }
      };
      gemm256<4>(p.H(), p.Wt_in() + (size_t)l * 1572864, 1024, pm * 256, pn * 256, smem, epi, pre, hn, npm * 256, npn * 256); pre = hn;
    } else {
      const int tid = tidx();
      const int ci = (it - NG) * 2 + (tid >> 8), t8 = tid & 255, b = ci >> 8, j = ci & 255;
      const size_t key = TC + b * 4352 + 4096 + j;
      const size_t src = (size_t)((b * 2 + l) * 256 + j);
      p.Kd()[key * 256 + t8] = f2bf(p.cache_k[src * 256 + t8]);
      p.VdT()[(size_t)t8 * KA + key] = f2bf(p.cache_v[src * 256 + t8]);
      if (t8 < 128) p.CKV()[key * 256 + t8] = f2bf(p.cache_ckv[src * 128 + t8]);
      if (t8 < 32) p.KR()[key * 32 + t8] = f2bf(p.cache_kr[src * 32 + t8]);
    }
  }
}

DI void s5_bu_to_lds(const Params& p, int e0, int tok0, int g, char* img, int lane) {
  const int n = lane & 15, q4 = lane >> 4;
  bf16x8 af[2];
#pragma unroll
  for (int mt = 0; mt < 2; ++mt) {
    uint4 z = make_uint4(0, 0, 0, 0);
    if (q4 < 2) {
      const float* up = p.U() + (size_t)(tok0 + 16 * mt + n) * 256 + g * 16 + 8 * q4;
      float4 x = *(const float4*)up, y = *(const float4*)(up + 4);
      z = make_uint4(pk2(x.x, x.y), pk2(x.z, x.w), pk2(y.x, y.y), pk2(y.z, y.w));
    }
    af[mt] = __builtin_bit_cast(bf16x8, z);
  }
#pragma unroll
  for (int nt = 0; nt < 8; ++nt) {
    uint4 z = make_uint4(0, 0, 0, 0);
    if (q4 < 2) {
      const float* bp = ((nt < 4) ? p.s5bre() : p.s5bim()) + (size_t)(e0 + 16 * (nt & 3) + n) * 16 + 8 * q4;
      float4 x = *(const float4*)bp, y = *(const float4*)(bp + 4);
      z = make_uint4(pk2(x.x, x.y), pk2(x.z, x.w), pk2(y.x, y.y), pk2(y.z, y.w));
    }
    const bf16x8 bfr = __builtin_bit_cast(bf16x8, z);
#pragma unroll
    for (int mt = 0; mt < 2; ++mt) {
      f32x4 d = {0.f, 0.f, 0.f, 0.f};
      d = MFMA16(af[mt], bfr, d);
#pragma unroll
      for (int reg = 0; reg < 4; ++reg) *(float*)(img + (16 * mt + 4 * q4 + reg) * 528 + (16 * nt + n) * 4) = d[reg];
    }
  }
}

DI void s5_pass1(const Params& p, int l, int witem, char* img) {
  const int lane = tidx() & 63;
  int d, g, c, nch, qbase, cbase;
  if (witem < 8192) { c = witem & 127; g = (witem >> 7) & 15; d = (witem >> 11) & 1; int b = witem >> 12; nch = 128; qbase = TC + b * 4096; cbase = 128 + b * 128; }
  else { int x = witem - 8192; c = x & 7; g = (x >> 3) & 15; d = (x >> 7) & 1; int b = x >> 8; nch = 8; qbase = b * 256; cbase = b * 8; }
  const int e0 = ((l * 2 + d) * 16 + g) * 64;
  const int tok0 = qbase + (d ? (nch - 1 - c) : c) * 32;
  s5_bu_to_lds(p, e0, tok0, g, img, lane);
  lds_fence();
  const float2 a = p.s5a()[e0 + lane];
  float hr = 0.f, hi = 0.f;
#pragma unroll 4
  for (int j = 0; j < 32; ++j) {
    const int row = d ? (31 - j) : j;
    const float bur = *(const float*)(img + row * 528 + lane * 4), bui = *(const float*)(img + row * 528 + 256 + lane * 4);
    float nr = a.x * hr - a.y * hi + bur, ni = a.x * hi + a.y * hr + bui;
    hr = nr; hi = ni;
  }
  p.FIN()[(size_t)(((cbase + c) * 2 + d) * 16 + g) * 64 + lane] = make_float2(hr, hi);
  lds_fence();
}

DI void s5_carry(const Params& p, int l, int witem) {
  const int lane = tidx() & 63;
  int g, d, b, nch, cbase; bool isctx;
  if (witem < 64) { g = witem & 15; d = (witem >> 4) & 1; b = witem >> 5; nch = 128; cbase = 128 + b * 128; isctx = false; }
  else { int x = witem - 64; g = x & 15; d = (x >> 4) & 1; b = x >> 5; nch = 8; cbase = b * 8; isctx = true; }
  const int e = ((l * 2 + d) * 16 + g) * 64 + lane;
  const float2 a = p.s5a()[e];
  float tr = a.x, ti = a.y;
#pragma unroll
  for (int s = 0; s < 5; ++s) { float nr = tr * tr - ti * ti, ni = 2.f * tr * ti; tr = nr; ti = ni; }
  float hr = 0.f, hi = 0.f;
  if (!isctx) { const float* s = p.state_s5 + ((size_t)(((b * 2 + l) * 2 + d) * 16 + g) * 64 + lane) * 2; hr = s[0]; hi = s[1]; }
  const size_t base = (size_t)((cbase * 2 + d) * 16 + g) * 64 + lane;
  if (isctx) {
    float2 f[8];
#pragma unroll
    for (int i = 0; i < 8; ++i) f[i] = p.FIN()[base + (size_t)i * 2048];
#pragma unroll
    for (int i = 0; i < 8; ++i) {
      p.CIN()[base + (size_t)i * 2048] = make_float2(hr, hi);
      float nr = tr * hr - ti * hi + f[i].x, ni = tr * hi + ti * hr + f[i].y;
      hr = nr; hi = ni;
    }
  } else {
    for (int c = 0; c < 128; c += 32) {
      float2 f[32];
#pragma unroll
      for (int i = 0; i < 32; ++i) f[i] = p.FIN()[base + (size_t)(c + i) * 2048];
#pragma unroll
      for (int i = 0; i < 32; ++i) {
        p.CIN()[base + (size_t)(c + i) * 2048] = make_float2(hr, hi);
        float nr = tr * hr - ti * hi + f[i].x, ni = tr * hi + ti * hr + f[i].y;
        hr = nr; hi = ni;
      }
    }
  }
  if (isctx) {
    float* o = p.out + O_S5 + ((size_t)(((b * 2 + l) * 2 + d) * 16 + g) * 64 + lane) * 2;
    o[0] = hr; o[1] = hi;
  }
}

DI float gelu_tanh(float x) {
  float z = 0.7978845608028654f * (x + 0.044715f * x * x * x);
  float t = 1.f - 2.f / (1.f + __expf(2.f * z));
  return 0.5f * x * (1.f + t);
}

DI void s5_pass3(const Params& p, int l, int witem, char* img) {
  const int lane = tidx() & 63;
  int tc, g, b, nch, qbase, cbase;
  if (witem < 4096) { tc = witem & 127; g = (witem >> 7) & 15; b = witem >> 11; nch = 128; qbase = TC + b * 4096; cbase = 128 + b * 128; }
  else { int x = witem - 4096; tc = x & 7; g = (x >> 3) & 15; b = x >> 7; nch = 8; qbase = b * 256; cbase = b * 8; }
  const int tok0 = qbase + tc * 32;
  f32x4 acc0 = {0.f, 0.f, 0.f, 0.f}, acc1 = {0.f, 0.f, 0.f, 0.f};
  const int n = lane & 15, q4 = lane >> 4;
#pragma unroll 1
  for (int d = 0; d < 2; ++d) {
    const int pc = d ? (nch - 1 - tc) : tc;
    const int e0 = ((l * 2 + d) * 16 + g) * 64;
    s5_bu_to_lds(p, e0, tok0, g, img, lane);
    lds_fence();
    const float2 a = p.s5a()[e0 + lane];
    const float2 h0 = p.CIN()[(size_t)(((cbase + pc) * 2 + d) * 16 + g) * 64 + lane];
    float hr = h0.x, hi = h0.y;
#pragma unroll 4
    for (int j = 0; j < 32; ++j) {
      const int row = d ? (31 - j) : j;
      const float bur = *(const float*)(img + row * 528 + lane * 4), bui = *(const float*)(img + row * 528 + 256 + lane * 4);
      float nr = a.x * hr - a.y * hi + bur, ni = a.x * hi + a.y * hr + bui;
      hr = nr; hi = ni;
      *(u16*)(img + row * 528 + lane * 2) = f2bf(hr);
      *(u16*)(img + row * 528 + 128 + lane * 2) = f2bf(hi);
    }
    lds_fence();
#pragma unroll
    for (int s = 0; s < 4; ++s) {
      const float* cp = ((s < 2) ? p.s5_cre : p.s5_cim) + ((size_t)(((l * 2 + d) * 16 + g) * 16 + n)) * 64 + 32 * (s & 1) + 8 * q4;
      float4 c0 = *(const float4*)cp, c1 = *(const float4*)(cp + 4);
      const float sg = (s < 2) ? 1.f : -1.f;
      bf16x8 bfrag = __builtin_bit_cast(bf16x8, make_uint4(pk2(sg * c0.x, sg * c0.y), pk2(sg * c0.z, sg * c0.w), pk2(sg * c1.x, sg * c1.y), pk2(sg * c1.z, sg * c1.w)));
      bf16x8 a0 = *(const bf16x8*)(img + (n) * 528 + (32 * s + 8 * q4) * 2);
      bf16x8 a1 = *(const bf16x8*)(img + (16 + n) * 528 + (32 * s + 8 * q4) * 2);
      acc0 = MFMA16(a0, bfrag, acc0);
      acc1 = MFMA16(a1, bfrag, acc1);
    }
    lds_fence();
  }
  const float dsk = p.s5_d[(l * 16 + g) * 16 + n];
#pragma unroll
  for (int reg = 0; reg < 4; ++reg) {
    const int row0 = 4 * q4 + reg, row1 = 16 + 4 * q4 + reg;
    const float u0 = p.U()[(size_t)(tok0 + row0) * 256 + g * 16 + n], u1 = p.U()[(size_t)(tok0 + row1) * 256 + g * 16 + n];
    p.YG()[(size_t)(tok0 + row0) * 256 + g * 16 + n] = f2bf(gelu_tanh(u0 * dsk + acc0[reg]));
    p.YG()[(size_t)(tok0 + row1) * 256 + g * 16 + n] = f2bf(gelu_tanh(u1 * dsk + acc1[reg]));
  }
}

DI void phase_b(const Params& p, int l, char* smem) {
  for (int it = blockIdx.x; it < 96; it += gridDim.x) {
    const int pm = it;
    auto epi = [&](Acc128& acc, int r0, int c0, int fr, int fq) __attribute__((always_inline)) {
      const int tid = tidx(), wid = tid >> 6, wr = wid >> 2, wc = wid & 3, brow = pm * 128;
      const bool ctx = brow < TC;
      float* part = (float*)(smem + 98304);
      float* stat = part + 1024;
      int rb2 = wr * 32 + fq * 4; asm volatile("" : "+v"(rb2));
#pragma unroll
      for (int ai = 0; ai < 2; ++ai)
#pragma unroll
        for (int m = 0; m < 2; ++m)
#pragma unroll
          for (int j = 0; j < 4; ++j) {
            const float v0 = acc[ai][0][m][0][j], v1 = acc[ai][0][m][1][j];
            float s2 = v0 * v0 + v1 * v1;
            s2 = row16_sum(s2);
            if (fr == 0) part[(rb2 + ai * 64 + m * 16 + j) * 4 + wc] = s2;
          }
      __syncthreads();
      if (tid < 128) stat[tid] = rsqrtf((part[tid * 4] + part[tid * 4 + 1] + part[tid * 4 + 2] + part[tid * 4 + 3]) * (1.f / 128.f) + 1e-6f);
      __syncthreads();
      int rb4 = wr * 32 + fq * 4; asm volatile("" : "+v"(rb4));
      const int kc = wc * 32 + fr;
      const float g0 = p.kv_g[l * 128 + kc], g1 = p.kv_g[l * 128 + kc + 16];
#pragma unroll
      for (int ai = 0; ai < 2; ++ai)
#pragma unroll
        for (int m = 0; m < 2; ++m)
#pragma unroll
          for (int j = 0; j < 4; ++j) {
            const int rowl = rb4 + ai * 64 + m * 16 + j, row = brow + rowl;
            const float rs = stat[rowl];
            const float c0v = acc[ai][0][m][0][j] * rs * g0, c1v = acc[ai][0][m][1][j] * rs * g1;
            if (ctx) { float* o = p.out + O_CKV + ((size_t)((row >> 8) * 2 + l) * 256 + (row & 255)) * 128 + kc; __builtin_nontemporal_store(c0v, o); __builtin_nontemporal_store(c1v, o + 16); }
            u16* ck = p.CKV() + (size_t)tok_key(row) * 256 + kc;
            ck[0] = f2bf(c0v); ck[16] = f2bf(c1v);
            if (wc == 0) {
              float v0 = acc[ai][1][m][0][j], v1 = acc[ai][1][m][1][j];
              if (ctx) { float* o = p.out + O_KR + ((size_t)((row >> 8) * 2 + l) * 256 + (row & 255)) * 32 + fr; o[0] = v0; o[16] = v1; }
              else {
                const float2 cs = p.rope()[tok_pos(row) * 16 + fr];
                const float t0 = v0 * cs.x - v1 * cs.y, t1 = v1 * cs.x + v0 * cs.y;
                v0 = t0; v1 = t1;
              }
              u16* k = p.KR() + (size_t)tok_key(row) * 32 + fr;
              k[0] = f2bf(v0); k[16] = f2bf(v1);
            }
          }
      __syncthreads();
    };
    gemm256<2>(p.H(), p.Wt_in() + (size_t)l * 1572864, 1024, pm * 128, 1280, smem, epi);
  }
  constexpr int NS = 12288 / 8, NR = TA / 8;
  idle_block_jobs(NS + NR, 96, [&](int e) __attribute__((always_inline)) {
    const int lane = tidx() & 63, w = tidx() >> 6;
    if (e < NS) { s5_pass1(p, l, e * 8 + w, smem + w * 16896); return; }
    const int t = (e - NS) * 8 + w;
    float4 x = *(const float4*)(p.QL() + (size_t)t * 256 + lane * 4);
    float rs = rsqrtf(wave_sum(x.x * x.x + x.y * x.y + x.z * x.z + x.w * x.w) * (1.f / 256.f) + 1e-6f);
    float4 g = *(const float4*)(p.q_g + l * 256 + lane * 4);
    uint2 o; o.x = pk2(x.x * rs * g.x, x.y * rs * g.y); o.y = pk2(x.z * rs * g.z, x.w * rs * g.w);
    *(uint2*)(p.QLN() + (size_t)t * 256 + lane * 4) = o;
  });
}

DI void phase_c(const Params& p, int l, char* smem) {
  constexpr int N3 = 50 * 4, N2 = 48 * 3, NCAR = 72;
  for (int it = blockIdx.x; it < N3 + N2 + NCAR; it += gridDim.x) {
    if (it >= N3 + N2) { s5_carry(p, l, (it - N3 - N2) * 8 + (tidx() >> 6)); continue; }
    if (it < N3) {
      int pm, pn; tile_order(it, 50, 4, pm, pn);
      auto epi = [&](Acc256& acc, int r0, int c0, int fr, int fq) __attribute__((always_inline)) {
#pragma unroll
        for (int ai = 0; ai < 2; ++ai)
#pragma unroll
          for (int bj = 0; bj < 2; ++bj) {
            const int colbase = c0 + bj * 128;
#pragma unroll
            for (int m = 0; m < 4; ++m) {
              const int rowb = r0 + ai * 128 + m * 16 + fq * 4;
#pragma unroll
              for (int n = 0; n < 2; ++n) {
                const int col = colbase + n * 16 + fr;
                const f32x4 a = acc[ai][bj][m][n];
                if (colbase < 512) {
#pragma unroll
                  for (int j = 0; j < 4; ++j) p.Km()[(size_t)(rowb + j) * 512 + col] = f2bf(a[j]);
                } else {
                  *(uint2*)(p.VmT() + (size_t)(col - 512) * KA + rowb) = make_uint2(pk2(a[0], a[1]), pk2(a[2], a[3]));
                }
              }
            }
          }
      };
      gemm256<4>(p.CKV(), p.Wt_ukv() + (size_t)l * 262144, 256, pm * 256, pn * 256, smem, epi);
    } else {
      const int j = it - N3;
      int pm, pn; tile_order(j, 48, 3, pm, pn);
      auto epi = [&](Acc256& acc, int r0, int c0, int fr, int fq) __attribute__((always_inline)) {
#pragma unroll
        for (int ai = 0; ai < 2; ++ai)
#pragma unroll
          for (int bj = 0; bj < 2; ++bj) {
            const int colbase = c0 + bj * 128;
            const bool ropecol = ((colbase >> 5) % 3 == 2);
#pragma unroll
            for (int m = 0; m < 4; ++m) {
              const int rowb = r0 + ai * 128 + m * 16 + fq * 4;
              const bool rp = ropecol && (rowb >= TC);
#pragma unroll
              for (int j2 = 0; j2 < 4; ++j2) {
                const int row = rowb + j2;
                float v0 = acc[ai][bj][m][0][j2], v1 = acc[ai][bj][m][1][j2];
                if (rp) {
                  float2 cs = p.rope()[tok_pos(row) * 16 + fr];
                  float t0 = v0 * cs.x - v1 * cs.y, t1 = v1 * cs.x + v0 * cs.y;
                  v0 = t0; v1 = t1;
                }
                u16* q = p.Qm() + (size_t)row * 768 + colbase + fr;
                q[0] = f2bf(v0 * QS_M); q[16] = f2bf(v1 * QS_M);
              }
            }
          }
      };
      gemm256<4>(p.QLN(), p.Wt_uq() + (size_t)l * 196608, 256, pm * 256, pn * 256, smem, epi);
    }
  }
}

template <int DQK, int NQ>
DI void attn_item(const Params& p, int seq, int hs, int qb, char* smem) {
  constexpr int KP = DQK * 2 + 16, KS = 64 * KP, VP = 136, VS = 64 * VP, STG = KS + VS;
  constexpr int NKC = DQK / 8, NKTOT = 64 * NKC, NKL = (NKTOT + NT - 1) / NT, NS = DQK / 16;
  const int tid = tidx(), lane = tid & 63, w = tid >> 6, r = lane & 31, h = lane >> 5;
  int qtok0, key0, Lk;
  if (seq < 16) { qtok0 = seq * 256; key0 = seq * 256; Lk = 256; }
  else { int b = seq - 16; qtok0 = TC + b * 4096; key0 = TC + b * 4352; Lk = 4352; }
  const u16 *qp, *k1, *vt; int qld, k1ld;
  if (DQK == 32) { int head = hs >> 1, c = hs & 1; qp = p.Qd() + head * 64 + c * 32; qld = 256; k1 = p.Kd() + head * 64 + c * 32; k1ld = 256; vt = p.VdT() + (size_t)(head * 64) * KA; }
  else { int hh = hs - 8; qp = p.Qm() + hh * 96; qld = 768; k1 = p.Km() + hh * 64; k1ld = 512; vt = p.VmT() + (size_t)(hh * 64) * KA; }
  const int t0 = qtok0 + qb * (256 * NQ) + w * (32 * NQ) + r;
  bf16x8 qf[NQ][NS];
#pragma unroll
  for (int qi = 0; qi < NQ; ++qi)
#pragma unroll
    for (int s = 0; s < NS; ++s) qf[qi][s] = *(const bf16x8*)(qp + (size_t)(t0 + 32 * qi) * qld + 16 * s + 8 * h);
  uint4 rkA0 = make_uint4(0, 0, 0, 0), rkA1 = make_uint4(0, 0, 0, 0), rvA, rkB0 = make_uint4(0, 0, 0, 0), rkB1 = make_uint4(0, 0, 0, 0), rvB;
  const int key_0 = tid / NKC, ch_0 = tid % NKC, key_1 = (tid + NT) / NKC, ch_1 = (tid + NT) % NKC;
  const bool has0 = tid < NKTOT, has1 = (tid + NT) < NKTOT;
  auto kload = [&](int kb, int key, int ch) __attribute__((always_inline)) {
    return (DQK == 32 || ch < 8) ? *(const uint4*)(k1 + (size_t)(kb + key) * k1ld + ch * 8) : *(const uint4*)(p.KR() + (size_t)(kb + key) * 32 + (ch - 8) * 8);
  };
  auto gload = [&](int kt, uint4& r0, uint4& r1, uint4& rv) __attribute__((always_inline)) {
    const int kb = key0 + kt * 64;
    if (has0) r0 = kload(kb, key_0, ch_0);
    if (NKL > 1) { if (has1) r1 = kload(kb, key_1, ch_1); }
    { int dv = tid >> 3, ch = tid & 7; rv = *(const uint4*)(vt + (size_t)dv * KA + kb + ch * 8); }
  };
  auto lstore = [&](int buf, const uint4& r0, const uint4& r1, const uint4& rv) __attribute__((always_inline)) {
    char* sk = smem + buf * STG; char* sv = sk + KS;
    if (has0) *(uint4*)(sk + key_0 * KP + ch_0 * 16) = r0;
    if (NKL > 1) { if (has1) *(uint4*)(sk + key_1 * KP + ch_1 * 16) = r1; }
    { int dv = tid >> 3, ch = tid & 7; uint2* d = (uint2*)(sv + dv * VP + ch * 16); d[0] = make_uint2(rv.x, rv.y); d[1] = make_uint2(rv.z, rv.w); }
  };
  f32x16 O[NQ][2];
  float m[NQ], lsum[NQ];
#pragma unroll
  for (int qi = 0; qi < NQ; ++qi) {
    m[qi] = 0.f; lsum[qi] = 0.f;
#pragma unroll
    for (int e = 0; e < 16; ++e) { O[qi][0][e] = 0.f; O[qi][1][e] = 0.f; }
  }
  const int nkt = Lk >> 6;
  auto compute = [&](int buf, bool first) __attribute__((always_inline)) {
    const char* sk = smem + buf * STG; const char* sv = sk + KS;
    f32x16 S[NQ][2];
#pragma unroll
    for (int st = 0; st < 2; ++st) {
#pragma unroll
      for (int qi = 0; qi < NQ; ++qi) {
        const float nm = -m[qi];
#pragma unroll
        for (int e = 0; e < 16; ++e) S[qi][st][e] = nm;
      }
#pragma unroll
      for (int s = 0; s < NS; ++s) {
        bf16x8 kf = *(const bf16x8*)(sk + (32 * st + r) * KP + (16 * s + 8 * h) * 2);
#pragma unroll
        for (int qi = 0; qi < NQ; ++qi) S[qi][st] = MFMA32(kf, qf[qi][s], S[qi][st]);
      }
    }
    float psv[NQ];
#pragma unroll
    for (int qi = 0; qi < NQ; ++qi) {
      if (first) {
        float mx = fmaxf(fmaxf(S[qi][0][0], S[qi][0][1]), fmaxf(S[qi][1][0], S[qi][1][1]));
#pragma unroll
        for (int e = 2; e < 16; e += 2) { mx = fmaxf(fmaxf(mx, S[qi][0][e]), S[qi][0][e + 1]); mx = fmaxf(fmaxf(mx, S[qi][1][e]), S[qi][1][e + 1]); }
        {
          const unsigned mb = __float_as_uint(mx);
          auto sw = __builtin_amdgcn_permlane32_swap(mb, mb, false, false);
          mx = fmaxf(__uint_as_float(sw[0]), __uint_as_float(sw[1]));
        }
        m[qi] += mx;
#pragma unroll
        for (int e = 0; e < 16; ++e) { S[qi][0][e] -= mx; S[qi][1][e] -= mx; }
      }
      float ps = 0.f;
#pragma unroll
      for (int st = 0; st < 2; ++st)
#pragma unroll
        for (int e = 0; e < 16; ++e) { const float pe = __builtin_amdgcn_exp2f(S[qi][st][e]); S[qi][st][e] = pe; ps += pe; }
      lsum[qi] += ps;
      psv[qi] = ps;
    }
#pragma unroll
    for (int st = 0; st < 2; ++st)
#pragma unroll
      for (int s2 = 0; s2 < 2; ++s2) {
        bf16x8 pf[NQ];
#pragma unroll
        for (int qi = 0; qi < NQ; ++qi) {
          uint4 pu = make_uint4(pk2(S[qi][st][8 * s2], S[qi][st][8 * s2 + 1]), pk2(S[qi][st][8 * s2 + 2], S[qi][st][8 * s2 + 3]),
                                pk2(S[qi][st][8 * s2 + 4], S[qi][st][8 * s2 + 5]), pk2(S[qi][st][8 * s2 + 6], S[qi][st][8 * s2 + 7]));
          pf[qi] = __builtin_bit_cast(bf16x8, pu);
        }
#pragma unroll
        for (int md = 0; md < 2; ++md) {
          const char* va = sv + (32 * md + r) * VP + (32 * st + 16 * s2 + 4 * h) * 2;
          uint2 lo = *(const uint2*)va, hi = *(const uint2*)(va + 16);
          bf16x8 vf = __builtin_bit_cast(bf16x8, make_uint4(lo.x, lo.y, hi.x, hi.y));
#pragma unroll
          for (int qi = 0; qi < NQ; ++qi) O[qi][md] = MFMA32(vf, pf[qi], O[qi][md]);
        }
      }
#pragma unroll
    for (int qi = 0; qi < NQ; ++qi) {
      if (__builtin_amdgcn_ballot_w64(psv[qi] > 1048576.f) != 0) {
        float dlt = (psv[qi] > 1048576.f) ? __log2f(psv[qi]) : 0.f;
        {
          const unsigned mb = __float_as_uint(dlt);
          auto sw = __builtin_amdgcn_permlane32_swap(mb, mb, false, false);
          dlt = fmaxf(__uint_as_float(sw[0]), __uint_as_float(sw[1]));
        }
        const float alpha = __builtin_amdgcn_exp2f(-dlt);
        m[qi] += dlt; lsum[qi] *= alpha;
#pragma unroll
        for (int e = 0; e < 16; ++e) { O[qi][0][e] *= alpha; O[qi][1][e] *= alpha; }
      }
    }
  };
  constexpr bool DEEP = !(NQ == 2 && DQK == 96);
  if (!DEEP) {
    gload(0, rkA0, rkA1, rvA); lstore(0, rkA0, rkA1, rvA);
    __syncthreads();
    for (int kt = 0; kt < nkt; ++kt) {
      if (kt + 1 < nkt) gload(kt + 1, rkA0, rkA1, rvA);
      compute(kt & 1, kt == 0);
      if (kt + 1 < nkt) lstore((kt + 1) & 1, rkA0, rkA1, rvA);
      __syncthreads();
    }
  } else {
  gload(0, rkA0, rkA1, rvA); lstore(0, rkA0, rkA1, rvA); gload(1, rkA0, rkA1, rvA);
  __syncthreads();
  for (int kt = 0; kt < nkt; kt += 2) {
    if (kt + 2 < nkt) gload(kt + 2, rkB0, rkB1, rvB);
    compute(0, kt == 0);
    lstore(1, rkA0, rkA1, rvA);
    __syncthreads();
    if (kt + 3 < nkt) gload(kt + 3, rkA0, rkA1, rvA);
    compute(1, false);
    if (kt + 2 < nkt) lstore(0, rkB0, rkB1, rvB);
    __syncthreads();
  }
  }
#pragma unroll
  for (int qi = 0; qi < NQ; ++qi) {
    const float inv = 1.f / (lsum[qi] + __shfl_xor(lsum[qi], 32));
    const int t = t0 + 32 * qi;
#pragma unroll
    for (int md = 0; md < 2; ++md)
#pragma unroll
      for (int g4 = 0; g4 < 4; ++g4) {
        const int dv0 = 32 * md + 8 * g4 + 4 * h;
        float o0 = O[qi][md][4 * g4] * inv, o1 = O[qi][md][4 * g4 + 1] * inv, o2 = O[qi][md][4 * g4 + 2] * inv, o3 = O[qi][md][4 * g4 + 3] * inv;
        if (DQK == 32) *(float4*)(p.ODIFF() + (size_t)t * 512 + hs * 64 + dv0) = make_float4(o0, o1, o2, o3);
        else *(uint2*)(p.CC() + (size_t)t * 1024 + 512 + (hs - 8) * 64 + dv0) = make_uint2(pk2(o0, o1), pk2(o2, o3));
      }
  }
}

#define XB_S5CTR(l) (3800 + 64 * (l))
DI void phase_d(const Params& p, int l, char* smem, int sub = 0) {
  constexpr int NAD = 2 * 8 * 16, NAC = 16 * 16, NS = 6144 / 8;
  if (sub != 2) {
    for (int it = blockIdx.x; it < NAD + NAC; it += gridDim.x) {
      if (it < NAD) {
        int hs = it & 15, qb = (it >> 4) & 7, b = it >> 7;
        if (hs < 8) attn_item<32, 2>(p, 16 + b, hs, qb, smem); else attn_item<96, 2>(p, 16 + b, hs, qb, smem);
      } else {
        int j = it - NAD, hs = j & 15, b = j >> 4;
        if (hs < 8) attn_item<32, 1>(p, b, hs, 0, smem); else attn_item<96, 1>(p, b, hs, 0, smem);
      }
    }
  }
  if (sub == 1) return;
  if (sub == 2) {
    for (int it = blockIdx.x; it < NS; it += gridDim.x) s5_pass3(p, l, it * 8 + (tidx() >> 6), smem + (tidx() >> 6) * 16896);
    return;
  }
  volatile unsigned* bw = (volatile unsigned*)(smem + 147456 - 16);
  unsigned* ctr = p.bar() + XB_S5CTR(l);
  for (;;) {
    __syncthreads();
    if (threadIdx.x == 0) *bw = xb_add(ctr, 1u);
    __syncthreads();
    const unsigned e = *bw;
    const unsigned nx = (l == 0) ? (unsigned)(NS + WJ_G + WJ_U) : (unsigned)NS;
    if (e >= nx) break;
    if (e >= (unsigned)NS) { weight_job(p, 0, WJ_EARLY + WJ_OUT + (int)(e - NS), (float*)smem); continue; }
    const int w = tidx() >> 6;
    s5_pass3(p, l, (int)e * 8 + w, smem + w * 16896);
  }
}

DI void phase_e(const Params& p, int l, char* smem) {
  constexpr int NG = 96, NR = TA / 8;
  for (int it = blockIdx.x; it < NG; it += gridDim.x) {
    {
      auto epi = [&](Acc128& acc, int r0, int c0, int fr, int fq) __attribute__((always_inline)) {
#pragma unroll
        for (int ai = 0; ai < 2; ++ai)
#pragma unroll
          for (int bj = 0; bj < 2; ++bj)
#pragma unroll
            for (int m = 0; m < 2; ++m) {
#pragma unroll
              for (int n = 0; n < 2; ++n)
#pragma unroll
                for (int j = 0; j < 4; ++j) {
                  const int row = r0 + ai * 64 + m * 16 + fq * 4 + j, col = c0 + bj * 128 + n * 16 + fr;
                  float y = bf2f(p.YG()[(size_t)row * 256 + col]);
                  p.CC()[(size_t)row * 1024 + 256 + col] = f2bf(y * sigmoidf(acc[ai][bj][m][n][j]));
                }
              SCHED;
            }
      };
      gemm256<2>(p.YG(), p.Wt_glu() + (size_t)l * 65536, 256, it * 128, 0, smem, epi);
    }
  }
  idle_block_jobs(NR, NG, [&](int e) __attribute__((always_inline)) {
    {
      const int lane = tidx() & 63, w = tidx() >> 6;
      const int t = e * 8 + w;
      float a1 = 0.f, a2 = 0.f;
      if (lane < 32) { a1 = p.lq1[l * 32 + lane] * p.lk1[l * 32 + lane]; a2 = p.lq2[l * 32 + lane] * p.lk2[l * 32 + lane]; }
      const float lam_init = 0.8f - 0.6f * expf(-0.3f * (float)l);
      const float lam = expf(wave_sum(a1)) - expf(wave_sum(a2)) + lam_init;
      const float gg = p.diff_g[l * 64 + lane] * (1.f - lam_init);
#pragma unroll
      for (int hd = 0; hd < 4; ++hd) {
        float o0 = p.ODIFF()[(size_t)t * 512 + (2 * hd) * 64 + lane], o1 = p.ODIFF()[(size_t)t * 512 + (2 * hd + 1) * 64 + lane];
        float o = o0 - lam * o1;
        float rs = rsqrtf(wave_sum(o * o) * (1.f / 64.f) + 1e-6f);
        p.CC()[(size_t)t * 1024 + hd * 64 + lane] = f2bf(o * rs * gg);
      }
    }
  });
}


#define XB_LNCNT(i) (3520 + (i))
template <int WHICH>
DI void epi_res_ln(const Params& p, const int l, Acc256& acc, int r0, int c0, int fr, int fq, char* smem, int pm, int pn) {
  const int tid = tidx(), wid = tid >> 6, wr = wid >> 2, wc = wid & 3;
  const int brow = pm * 256, cond = tok_cond(brow), slot = (l * 2 + (WHICH - 1)) * 48 + pm;
  const float* mb = p.mods() + (size_t)(l * 3 + cond) * 6144;
  {
    const float* xb = ((WHICH == 1 && l == 0) ? ((brow < TC) ? p.x_prompt + (size_t)brow * 1024 : p.x_sample + (size_t)(brow - TC) * 1024) : p.out + (size_t)brow * 1024) + c0;
    int rb1 = wr * 64 + fq * 4; asm volatile("" : "+v"(rb1));
    float gt[2][2];
#pragma unroll
    for (int bj = 0; bj < 2; ++bj)
#pragma unroll
      for (int n = 0; n < 2; ++n) gt[bj][n] = mb[(WHICH == 1 ? 2048 : 5120) + c0 + bj * 128 + n * 16 + fr];
#pragma unroll
    for (int ai = 0; ai < 2; ++ai)
#pragma unroll
      for (int m = 0; m < 4; ++m) {
        int zz = 0;
        { constexpr int PA = 0; const int pa = (ai * 4 + m + 4) / 4 % 2, pm4 = (ai * 4 + m + 4) % 4; (void)PA;
          const f32x4 d0 = acc[pa][0][pm4][0], d1 = acc[pa][0][pm4][1], d2 = acc[pa][1][pm4][0], d3 = acc[pa][1][pm4][1];
          asm volatile("" : "+v"(zz) : "v"(d0[0]), "v"(d0[1]), "v"(d0[2]), "v"(d0[3]), "v"(d1[0]), "v"(d1[1]), "v"(d1[2]), "v"(d1[3]),
                                       "v"(d2[0]), "v"(d2[1]), "v"(d2[2]), "v"(d2[3]), "v"(d3[0]), "v"(d3[1]), "v"(d3[2]), "v"(d3[3])); }
#pragma unroll
        for (int j = 0; j < 4; ++j) {
          const int rowl = rb1 + ai * 128 + m * 16 + j;
          const float* xr = xb + (rowl * 1024 + fr + zz);
#pragma unroll
          for (int bj = 0; bj < 2; ++bj)
#pragma unroll
            for (int n = 0; n < 2; ++n) acc[ai][bj][m][n][j] = ALPHA * xr[bj * 128 + n * 16] + gt[bj][n] * acc[ai][bj][m][n][j];
        }
        asm volatile("" ::: "memory"); SCHED;
      }
  }
  float* part = (float*)(smem + 98304);
  float* stat = part + 2048;
  int rb2 = wr * 64 + fq * 4; asm volatile("" : "+v"(rb2));
#pragma unroll
  for (int ai = 0; ai < 2; ++ai)
#pragma unroll
    for (int m = 0; m < 4; ++m)
#pragma unroll
      for (int j = 0; j < 4; ++j) {
        float s1 = 0.f, s2 = 0.f;
#pragma unroll
        for (int bj = 0; bj < 2; ++bj)
#pragma unroll
          for (int n = 0; n < 2; ++n) { const float v = acc[ai][bj][m][n][j]; s1 += v; s2 += v * v; }
        s1 = row16_sum(s1); s2 = row16_sum(s2);
        if (fr == 0) {
          const int rowl = rb2 + ai * 128 + m * 16 + j;
          part[(rowl * 4 + wc) * 2] = s1; part[(rowl * 4 + wc) * 2 + 1] = s2;
        }
      }
  __syncthreads();
  float2* xch = p.XCH() + (size_t)slot * 1024;
  if (tid < 256) {
    float a = 0.f, b = 0.f;
#pragma unroll
    for (int w4 = 0; w4 < 4; ++w4) { a += part[(tid * 4 + w4) * 2]; b += part[(tid * 4 + w4) * 2 + 1]; }
    xch[tid * 4 + pn] = make_float2(a, b);
  }
  asm volatile("s_waitcnt vmcnt(0)" ::: "memory");
  __syncthreads();
  if (tid == 0) {
    unsigned* cnt = p.bar() + XB_LNCNT(slot);
    __builtin_amdgcn_fence(__ATOMIC_RELEASE, "agent");
    asm volatile("s_waitcnt vmcnt(0)" ::: "memory");
    xb_add(cnt, 1u);
    unsigned sp = 0;
    while (xb_ld(cnt) < 4u) { __builtin_amdgcn_s_sleep(1); if (++sp > (1u << 22)) break; }
    __builtin_amdgcn_fence(__ATOMIC_ACQUIRE, "agent");
    asm volatile("s_waitcnt vmcnt(0)" ::: "memory");
  }
  __syncthreads();
  if (tid < 256) {
    float a = 0.f, b = 0.f;
#pragma unroll
    for (int t4 = 0; t4 < 4; ++t4) { const float2 q = xch[tid * 4 + t4]; a += q.x; b += q.y; }
    const float mean = a * (1.f / 1024.f);
    stat[tid * 2] = mean; stat[tid * 2 + 1] = rsqrtf(fmaxf(b * (1.f / 1024.f) - mean * mean, 0.f) + 1e-5f);
  }
  __syncthreads();
  const float* gp = (WHICH == 1 ? p.ln1g : p.ln2g) + l * 1024;
  const float* bp = (WHICH == 1 ? p.ln1b : p.ln2b) + l * 1024;
  const bool hasH = (WHICH == 1) || (l + 1 < 2);
  const float* mh = (WHICH == 1) ? mb : p.mods() + (size_t)((l + 1 < 2 ? l + 1 : l) * 3 + cond) * 6144;
  const int scc = (WHICH == 1) ? 4 : 1, shc = (WHICH == 1) ? 3 : 0;
  int rb4 = wr * 64 + fq * 4; asm volatile("" : "+v"(rb4));
  float gam[2][2], bet[2][2], sc1[2][2], sh1[2][2];
#pragma unroll
  for (int bj = 0; bj < 2; ++bj)
#pragma unroll
    for (int n = 0; n < 2; ++n) {
      const int col = c0 + bj * 128 + n * 16 + fr;
      gam[bj][n] = gp[col]; bet[bj][n] = bp[col];
      sc1[bj][n] = hasH ? 1.f + mh[scc * 1024 + col] : 0.f; sh1[bj][n] = hasH ? mh[shc * 1024 + col] : 0.f;
    }
#pragma unroll
  for (int ai = 0; ai < 2; ++ai)
#pragma unroll
    for (int m = 0; m < 4; ++m) {
#pragma unroll
      for (int j = 0; j < 4; ++j) {
        const int rowl = rb4 + ai * 128 + m * 16 + j, row = brow + rowl;
        const float mean = stat[rowl * 2], rs = stat[rowl * 2 + 1];
#pragma unroll
        for (int bj = 0; bj < 2; ++bj)
#pragma unroll
          for (int n = 0; n < 2; ++n) {
            const int col = c0 + bj * 128 + n * 16 + fr;
            const float x = (acc[ai][bj][m][n][j] - mean) * rs * gam[bj][n] + bet[bj][n];
            p.out[(size_t)row * 1024 + col] = x;
            if (hasH) p.H()[(size_t)row * 1024 + col] = f2bf(x * sc1[bj][n] + sh1[bj][n]);
          }
      }
      asm volatile("" ::: "memory"); SCHED;
    }
  __syncthreads();
}

DI void phase_f(const Params& p, int l, char* smem) {
  for (int it = blockIdx.x; it < 48 * 4; it += gridDim.x) {
    int pm, pn; tile_order(it, 48, 4, pm, pn);
    auto epi = [&](Acc256& acc, int r0, int c0, int fr, int fq) __attribute__((always_inline)) {
      if (l == 0) epi_res_ln<1>(p, 0, acc, r0, c0, fr, fq, smem, pm, pn); else epi_res_ln<1>(p, 1, acc, r0, c0, fr, fq, smem, pm, pn);
    };
    const float* xt = ((l == 0) ? ((pm * 256 < TC) ? p.x_prompt + (size_t)(pm * 256) * 1024 : p.x_sample + (size_t)(pm * 256 - TC) * 1024) : p.out + (size_t)(pm * 256) * 1024) + pn * 256;
    gemm256<4>(p.CC(), p.Wt_out() + (size_t)l * 1048576, 1024, pm * 256, pn * 256, smem, epi, false, false, 0, 0, xt);
  }
  if (l == 0)
    idle_block_jobs(WJ_D, 48 * 4, [&](int e) __attribute__((always_inline)) { weight_job(p, 0, WJ_EARLY + WJ_OUT + WJ_G + WJ_U + e, (float*)smem); });
}

template <int MT, class AccT>
DI void epi_swiglu(const Params& p, AccT& acc, int r0, int c0, int fr, int fq) {
#pragma unroll
  for (int ai = 0; ai < 2; ++ai)
#pragma unroll
    for (int bj = 0; bj < 2; ++bj) {
      const int unit = ((c0 + bj * 128) >> 5) * 16 + fr;
#pragma unroll
      for (int m = 0; m < MT; ++m)
#pragma unroll
        for (int j = 0; j < 4; ++j) {
          const int row = r0 + ai * (32 * MT) + m * 16 + fq * 4 + j;
          float g = acc[ai][bj][m][0][j], u = acc[ai][bj][m][1][j];
          p.ACT()[(size_t)row * 2816 + unit] = f2bf(g * sigmoidf(g) * u);
        }
    }
}
DI void phase_h(const Params& p, int l, char* smem) {
  constexpr int NFULL = 1024, NTOT = 48 * 22;
  bool pre = false;
  for (int it = blockIdx.x; it < NFULL + 2 * (NTOT - NFULL); it += gridDim.x) {
    if (it < NFULL) {
      int pm, pn, npm = 0, npn = 0; tile_order(it, 48, 22, pm, pn);
      const bool hn = (it + (int)gridDim.x) < NFULL; if (hn) tile_order(it + gridDim.x, 48, 22, npm, npn);
      auto epi = [&](Acc256& acc, int r0, int c0, int fr, int fq) __attribute__((always_inline)) { epi_swiglu<4>(p, acc, r0, c0, fr, fq); };
      gemm256<4>(p.H(), p.Wt_gu() + (size_t)l * 5767168, 1024, pm * 256, pn * 256, smem, epi, pre, hn, npm * 256, npn * 256); pre = hn;
    } else {
      const int hidx = it - NFULL;
      int pm, pn; tile_order(NFULL + (hidx >> 1), 48, 22, pm, pn);
      auto epi = [&](Acc128& acc, int r0, int c0, int fr, int fq) __attribute__((always_inline)) { epi_swiglu<2>(p, acc, r0, c0, fr, fq); };
      gemm256<2>(p.H(), p.Wt_gu() + (size_t)l * 5767168, 1024, pm * 256 + (hidx & 1) * 128, pn * 256, smem, epi);
    }
  }
}

DI void phase_i(const Params& p, int l, char* smem) {
  for (int it = blockIdx.x; it < 48 * 4; it += gridDim.x) {
    int pm, pn; tile_order(it, 48, 4, pm, pn);
    auto epi = [&](Acc256& acc, int r0, int c0, int fr, int fq) __attribute__((always_inline)) {
      if (l == 0) epi_res_ln<2>(p, 0, acc, r0, c0, fr, fq, smem, pm, pn); else epi_res_ln<2>(p, 1, acc, r0, c0, fr, fq, smem, pm, pn);
    };
    gemm256<4>(p.ACT(), p.Wt_dn() + (size_t)l * 2883584, 2816, pm * 256, pn * 256, smem, epi, false, false, 0, 0, p.out + (size_t)(pm * 256) * 1024 + pn * 256);
  }
  if (l == 0)
    idle_block_jobs(WJ_ALL, 48 * 4, [&](int e) __attribute__((always_inline)) { weight_job(p, 1, e, (float*)smem); });
}

#define GSYNC() xcd_barrier(xb)
DI void run_layer(const Params& p, const int l, char* smem, const XcdBarrier& xb, bool last) {
  phase_a(p, l, smem); GSYNC();
#if REP_K == 0
  phase_a(p, l, smem); GSYNC();
#endif
  phase_b(p, l, smem); GSYNC();
#if REP_K == 1
  phase_b(p, l, smem); GSYNC();
#endif
  phase_c(p, l, smem); GSYNC();
#if REP_K == 2
  phase_c(p, l, smem); GSYNC();
#endif
  phase_d(p, l, smem);
#if REP_K == 3
  GSYNC(); phase_d(p, l, smem, REP_SUB);
#endif
  GSYNC();
  phase_e(p, l, smem); GSYNC();
#if REP_K == 4
  phase_e(p, l, smem); GSYNC();
#endif
  phase_f(p, l, smem); GSYNC();
#if REP_K == 5
  if (l == 0) { phase_f(p, l, smem); GSYNC(); }
#endif
  phase_h(p, l, smem);
#if REP_K == 7
  GSYNC(); phase_h(p, l, smem);
#endif
  GSYNC();
  phase_i(p, l, smem);
  if (!last) GSYNC();
}

__global__ void __launch_bounds__(NT) __attribute__((target("no-packed-fp32-ops"))) mega(Params p) {
  extern __shared__ __attribute__((aligned(16))) char smem[];
  volatile LAS unsigned* xst = (volatile LAS unsigned*)(LAS char*)(smem + LDS_BYTES - 16);
  if (threadIdx.x == 0) { xst[0] = 0u; xst[1] = 0u; xst[2] = 0u; xst[3] = 0u; }
  __syncthreads();
  const XcdBarrier xb = xcd_barrier_post(p.bar(), xst);
  if (p.out == nullptr) cg::this_grid().sync();
  phase_pre1(p, smem); GSYNC();
#if REP_K == 10
  phase_pre1(p, smem); GSYNC();
#endif
  phase_pre2(p); GSYNC();
  run_layer(p, 0, smem, xb, false);
  run_layer(p, 1, smem, xb, true);
}

extern "C" void kernel_launch(void* const* d_in, const int* in_sizes, int n_in, void* d_out, int out_size, void* d_ws, size_t ws_size,
                              hipStream_t stream) {
  static int grid_blocks = 0;
  if (!grid_blocks) {
    int dev = 0, cus = 0, per_cu = 0;
    (void)hipGetDevice(&dev);
    (void)hipDeviceGetAttribute(&cus, hipDeviceAttributeMultiprocessorCount, dev);
    (void)hipFuncSetAttribute((const void*)mega, hipFuncAttributeMaxDynamicSharedMemorySize, LDS_BYTES);
    (void)hipOccupancyMaxActiveBlocksPerMultiprocessor(&per_cu, (const void*)mega, NT, LDS_BYTES);
    if (per_cu < 1) per_cu = 1;
    if (per_cu > 1) per_cu = 1;
    grid_blocks = cus * per_cu;
  }
  Params p{};
  const float** pin = (const float**)&p;
  for (int i = 0; i < 39; ++i) pin[i] = (const float*)d_in[i];
  p.out = (float*)d_out;
  p.ws = (char*)d_ws;
  if (WS_END > ws_size) { fprintf(stderr, "kernel_launch: workspace too small (%zu > %zu)\n", (size_t)WS_END, ws_size); return; }
  (void)hipMemsetAsync(p.ws + OFF_bar, 0, 16384, stream);
  void* args[] = {&p};
  hipError_t e = hipLaunchCooperativeKernel((const void*)mega, dim3(grid_blocks), dim3(NT), args, LDS_BYTES, stream);
  if (e != hipSuccess) fprintf(stderr, "cooperative launch failed: %s (grid %d)\n", hipGetErrorString(e), grid_blocks);
}
```
